# Optimizing an MI355X kernel written in HIP

```python
import jax, jax.numpy as jnp
from jax import lax
import numpy as np

D_MODEL = 1024
BATCH = 8
SEQ = 2048
DEPTH = 1
DEC_BATCH = 16
DEC_SEQ = 16
PAST_LEN = 2048

CHUNK = 64
QBLOCK = 128
EPS = 1e-6
NEG_INF = -1e30

GDN_HEADS = 8
GDN_DK = 64
GDN_DV = 64
CONV_W = 4
GDN_QK_DIM = GDN_HEADS * GDN_DK
GDN_V_DIM = GDN_HEADS * GDN_DV
GDN_CONV_DIM = 2 * GDN_QK_DIM + GDN_V_DIM

MLA_HEADS = 8
QK_NOPE = 64
QK_ROPE = 32
QK_HEAD = QK_NOPE + QK_ROPE
V_HEAD = 64
Q_LORA = 384
KV_LORA = 256
ROPE_THETA = 10000.0
MLA_V_DIM = MLA_HEADS * V_HEAD

D_FF = 4 * D_MODEL
ADA_DIM = 6 * D_MODEL

IN_SIZES = (GDN_QK_DIM, GDN_QK_DIM, GDN_V_DIM, GDN_V_DIM, GDN_HEADS, GDN_HEADS,
            Q_LORA, KV_LORA, QK_ROPE, D_MODEL, D_MODEL)
IN_DIM = sum(IN_SIZES)

kernel_name = 'chunk_streaming_gdn_mla_hybrid_step'


def rmsnorm(x, g):
    xf = x.astype(jnp.float32)
    y = xf * lax.rsqrt(jnp.mean(xf * xf, axis=-1, keepdims=True) + EPS)
    return (y * g.astype(jnp.float32)).astype(x.dtype)


def l2norm(x):
    xf = x.astype(jnp.float32)
    return xf * lax.rsqrt(jnp.sum(xf * xf, axis=-1, keepdims=True) + EPS)


def split_cols(t, sizes):
    return jnp.split(t, np.cumsum(sizes)[:-1].tolist(), axis=-1)


def rope_tables(pos):
    inv = ROPE_THETA ** (-jnp.arange(0, QK_ROPE, 2, dtype=jnp.float32) / QK_ROPE)
    ang = pos.astype(jnp.float32)[:, None] * inv[None, :]
    return jnp.cos(ang), jnp.sin(ang)


def rope(x, cos, sin):
    x1, x2 = jnp.split(x.astype(jnp.float32), 2, axis=-1)
    return jnp.concatenate([x1 * cos - x2 * sin, x2 * cos + x1 * sin], axis=-1).astype(x.dtype)


def causal_conv_silu(x, buf, w):
    L = x.shape[1]
    xp = jnp.concatenate([buf.astype(x.dtype), x], axis=1)
    y = sum(xp[:, i:i + L, :] * w[i] for i in range(CONV_W))
    return jax.nn.silu(y), xp[:, -(CONV_W - 1):, :]


def to_blocks(t, n, chunk):
    B, L, H = t.shape[:3]
    t = t.reshape((B, n, chunk, H) + t.shape[3:])
    return jnp.moveaxis(t, (1, 3), (0, 2))


def gated_delta_rule(q, k, v, g, beta, state0, chunk):
    B, L, H, DK = q.shape
    DV = v.shape[-1]
    n = L // chunk
    qc, kc, vc = to_blocks(q, n, chunk), to_blocks(k, n, chunk), to_blocks(v, n, chunk)
    gc = jnp.cumsum(to_blocks(g, n, chunk), axis=-1)
    bc = to_blocks(beta, n, chunk)
    idx = jnp.arange(chunk)
    causal = idx[:, None] >= idx[None, :]
    strict = idx[:, None] > idx[None, :]
    gdiff = gc[..., :, None] - gc[..., None, :]
    decay = jnp.where(causal, jnp.exp(jnp.where(causal, gdiff, 0.0)), 0.0)
    kk = jnp.einsum('nbhid,nbhjd->nbhij', kc, kc)
    a_mat = jnp.where(strict, bc[..., :, None] * kk * decay, 0.0) + jnp.eye(chunk, dtype=kk.dtype)
    u = lax.linalg.triangular_solve(a_mat, vc * bc[..., None], left_side=True, lower=True,
                                    unit_diagonal=True)
    w = lax.linalg.triangular_solve(a_mat, kc * (bc * jnp.exp(gc))[..., None], left_side=True,
                                    lower=True, unit_diagonal=True)
    qk = jnp.einsum('nbhid,nbhjd->nbhij', qc, kc) * decay

    def step(s, inp):
        q_i, k_i, u_i, w_i, g_i, qk_i = inp
        v_new = u_i - jnp.einsum('bhck,bhkv->bhcv', w_i, s)
        o_i = (jnp.einsum('bhck,bhkv->bhcv', q_i * jnp.exp(g_i)[..., None], s)
               + jnp.einsum('bhij,bhjv->bhiv', qk_i, v_new))
        g_last = g_i[..., -1:]
        s = (s * jnp.exp(g_last)[..., None]
             + jnp.einsum('bhck,bhcv->bhkv', k_i * jnp.exp(g_last - g_i)[..., None], v_new))
        return s, o_i

    s_final, o = lax.scan(step, state0, (qc, kc, u, w, gc, qk))
    o = jnp.moveaxis(o, (0, 2), (1, 3)).reshape(B, L, H, DV)
    return o, s_final


def gdn_branch(q, k, v, z, a, b, state0, conv0, lw):
    B, L, _ = q.shape
    dt = q.dtype
    qkv, conv_new = causal_conv_silu(jnp.concatenate([q, k, v], axis=-1), conv0, lw['gdn_conv_w'])
    q, k, v = jnp.split(qkv, [GDN_QK_DIM, 2 * GDN_QK_DIM], axis=-1)
    q = l2norm(q.reshape(B, L, GDN_HEADS, GDN_DK)) * (GDN_DK ** -0.5)
    k = l2norm(k.reshape(B, L, GDN_HEADS, GDN_DK))
    v = v.reshape(B, L, GDN_HEADS, GDN_DV).astype(jnp.float32)
    beta = jax.nn.sigmoid(b.astype(jnp.float32))
    g = -jnp.exp(lw['gdn_a_log'].astype(jnp.float32)) * jax.nn.softplus(
        a.astype(jnp.float32) + lw['gdn_dt_bias'].astype(jnp.float32))
    o, state = gated_delta_rule(q, k, v, g, beta, state0.astype(jnp.float32), min(CHUNK, L))
    o = rmsnorm(o, lw['gdn_norm_g']) * jax.nn.silu(z.reshape(B, L, GDN_HEADS, GDN_DV).astype(jnp.float32))
    y = o.reshape(B, L, GDN_V_DIM).astype(dt) @ lw['w_gdn_out']
    return y, state.astype(state0.dtype), conv_new


def mla_queries_and_latents(c_q, c_kv, k_r, pos, lw):
    B, L, _ = c_q.shape
    cos, sin = rope_tables(pos)
    q = (rmsnorm(c_q, lw['mla_q_norm_g']) @ lw['w_uq']).reshape(B, L, MLA_HEADS, QK_HEAD)
    q = jnp.concatenate([q[..., :QK_NOPE], rope(q[..., QK_NOPE:], cos[:, None, :], sin[:, None, :])], axis=-1)
    q = rmsnorm(q, lw['q_head_norm_g'])
    ckv = rmsnorm(c_kv, lw['mla_kv_norm_g'])
    krope = rope(k_r, cos, sin)
    return q, ckv, krope


def mla_expand_kv(ckv, krope, lw):
    B, L, _ = ckv.shape
    kv = (ckv @ lw['w_ukv']).reshape(B, L, MLA_HEADS, QK_NOPE + V_HEAD)
    k_nope, v = kv[..., :QK_NOPE], kv[..., QK_NOPE:]
    k_pe = jnp.broadcast_to(krope[:, :, None, :], (B, L, MLA_HEADS, QK_ROPE))
    k = rmsnorm(jnp.concatenate([k_nope, k_pe.astype(k_nope.dtype)], axis=-1), lw['k_head_norm_g'])
    return k, v


def chunk_causal_attention(q, k, v):
    B, S, H, Dq = q.shape
    nb = S // QBLOCK
    qb = jnp.moveaxis(q.reshape(B, nb, QBLOCK, H, Dq), 1, 0)
    starts = jnp.arange(nb) * QBLOCK
    key_chunk = jnp.arange(S) // CHUNK

    def one_block(args):
        q_blk, start = args
        q_chunk = (start + jnp.arange(QBLOCK)) // CHUNK
        s = jnp.einsum('bqhd,bkhd->bhqk', q_blk, k).astype(jnp.float32) * (QK_HEAD ** -0.5)
        s = jnp.where(key_chunk[None, :] <= q_chunk[:, None], s, NEG_INF)
        p = jax.nn.softmax(s, axis=-1).astype(v.dtype)
        return jnp.einsum('bhqk,bkhd->bqhd', p, v)

    o = lax.map(one_block, (qb, starts))
    return jnp.moveaxis(o, 0, 1).reshape(B, S, H * v.shape[-1])


def full_attention(q, k, v):
    B, Lq, H, _ = q.shape
    s = jnp.einsum('bqhd,bkhd->bhqk', q, k).astype(jnp.float32) * (QK_HEAD ** -0.5)
    p = jax.nn.softmax(s, axis=-1).astype(v.dtype)
    return jnp.einsum('bhqk,bkhd->bqhd', p, v).reshape(B, Lq, H * v.shape[-1])


def trunk_layer(x, c, pos, gdn_state0, gdn_conv0, ckv_past, krope_past, lw):
    mod = (jax.nn.silu(c) @ lw['ada_w'] + lw['ada_b'])[:, None, :]
    shift1, scale1, gate1, shift2, scale2, gate2 = jnp.split(mod, 6, axis=-1)
    h = rmsnorm(x, lw['norm1_g']) * (1.0 + scale1) + shift1
    (q_a, k_a, v_a, z_a, a_a, b_a, c_q, c_kv, k_r, gl_a, gl_b) = split_cols(h @ lw['w_in'], IN_SIZES)
    y_a, gdn_state, gdn_conv = gdn_branch(q_a, k_a, v_a, z_a, a_a, b_a, gdn_state0, gdn_conv0, lw)
    q, ckv_new, krope_new = mla_queries_and_latents(c_q, c_kv, k_r, pos, lw)
    if ckv_past is None:
        k, v = mla_expand_kv(ckv_new, krope_new, lw)
        o_b = chunk_causal_attention(q, k, v)
    else:
        ckv_all = jnp.concatenate([ckv_past.astype(ckv_new.dtype), ckv_new], axis=1)
        krope_all = jnp.concatenate([krope_past.astype(krope_new.dtype), krope_new], axis=1)
        k, v = mla_expand_kv(ckv_all, krope_all, lw)
        o_b = full_attention(q, k, v)
    y_b = o_b @ lw['w_mla_out']
    merged = jax.nn.sigmoid(gl_a) * y_a + jax.nn.sigmoid(gl_b) * y_b
    x = x + gate1 * (merged @ lw['w_o'])
    h2 = rmsnorm(x, lw['norm2_g']) * (1.0 + scale2) + shift2
    x = x + gate2 * (jnp.square(jax.nn.relu(h2 @ lw['w_ff1'])) @ lw['w_ff2'])
    return x, ckv_new, krope_new, gdn_state, gdn_conv


def setup_inputs(seed: int = 0) -> dict:
    key = jax.random.key(seed)
    ks = jax.random.split(key, 28)
    f32 = jnp.float32

    def nrm(k, shape, scale=1.0):
        return jax.random.normal(k, shape, f32) * scale

    def gain(k, shape):
        return 1.0 + 0.02 * jax.random.normal(k, shape, f32)

    dt = jnp.exp(jax.random.uniform(ks[14], (DEPTH, GDN_HEADS), f32, np.log(1e-3), np.log(1e-1)))
    return {
        'x_prompt': nrm(ks[0], (BATCH, SEQ, D_MODEL)),
        'x_sample': nrm(ks[1], (DEC_BATCH, DEC_SEQ, D_MODEL)),
        'c_prompt': nrm(ks[2], (BATCH, D_MODEL)),
        'c_sample': nrm(ks[3], (DEC_BATCH, D_MODEL)),
        'cache_mla_ckv': nrm(ks[4], (DEPTH, DEC_BATCH, PAST_LEN, KV_LORA)),
        'cache_mla_krope': nrm(ks[5], (DEPTH, DEC_BATCH, PAST_LEN, QK_ROPE)),
        'state_gdn': nrm(ks[6], (DEPTH, DEC_BATCH, GDN_HEADS, GDN_DK, GDN_DV), 0.1),
        'state_gdn_conv': nrm(ks[7], (DEPTH, DEC_BATCH, CONV_W - 1, GDN_CONV_DIM)),
        'ada_w': nrm(ks[8], (DEPTH, D_MODEL, ADA_DIM), 0.5 * D_MODEL ** -0.5),
        'ada_b': nrm(ks[9], (DEPTH, ADA_DIM), 0.01),
        'norm1_g': gain(ks[10], (DEPTH, D_MODEL)),
        'w_in': nrm(ks[11], (DEPTH, D_MODEL, IN_DIM), D_MODEL ** -0.5),
        'gdn_conv_w': nrm(ks[12], (DEPTH, CONV_W, GDN_CONV_DIM), CONV_W ** -0.5),
        'gdn_a_log': jnp.log(jax.random.uniform(ks[13], (DEPTH, GDN_HEADS), f32, 1.0, 16.0)),
        'gdn_dt_bias': dt + jnp.log(-jnp.expm1(-dt)),
        'gdn_norm_g': gain(ks[15], (DEPTH, GDN_DV)),
        'w_gdn_out': nrm(ks[16], (DEPTH, GDN_V_DIM, D_MODEL), GDN_V_DIM ** -0.5),
        'mla_q_norm_g': gain(ks[17], (DEPTH, Q_LORA)),
        'w_uq': nrm(ks[18], (DEPTH, Q_LORA, MLA_HEADS * QK_HEAD), Q_LORA ** -0.5),
        'mla_kv_norm_g': gain(ks[19], (DEPTH, KV_LORA)),
        'w_ukv': nrm(ks[20], (DEPTH, KV_LORA, MLA_HEADS * (QK_NOPE + V_HEAD)), KV_LORA ** -0.5),
        'q_head_norm_g': gain(ks[21], (DEPTH, QK_HEAD)),
        'k_head_norm_g': gain(ks[22], (DEPTH, QK_HEAD)),
        'w_mla_out': nrm(ks[23], (DEPTH, MLA_V_DIM, D_MODEL), MLA_V_DIM ** -0.5),
        'w_o': nrm(ks[24], (DEPTH, D_MODEL, D_MODEL), D_MODEL ** -0.5),
        'norm2_g': gain(ks[25], (DEPTH, D_MODEL)),
        'w_ff1': nrm(ks[26], (DEPTH, D_MODEL, D_FF), D_MODEL ** -0.5),
        'w_ff2': nrm(ks[27], (DEPTH, D_FF, D_MODEL), D_FF ** -0.5),
    }


def reference(x_prompt, x_sample, c_prompt, c_sample, cache_mla_ckv, cache_mla_krope, state_gdn,
              state_gdn_conv, ada_w, ada_b, norm1_g, w_in, gdn_conv_w, gdn_a_log, gdn_dt_bias,
              gdn_norm_g, w_gdn_out, mla_q_norm_g, w_uq, mla_kv_norm_g, w_ukv, q_head_norm_g,
              k_head_norm_g, w_mla_out, w_o, norm2_g, w_ff1, w_ff2):
    b_p, s_p, _ = x_prompt.shape
    s_s = x_sample.shape[1]
    past_len = cache_mla_ckv.shape[2]
    pos_p = jnp.arange(s_p)
    pos_s = past_len + jnp.arange(s_s)
    zero_state = jnp.zeros((b_p, GDN_HEADS, GDN_DK, GDN_DV), x_prompt.dtype)
    zero_conv = jnp.zeros((b_p, CONV_W - 1, GDN_CONV_DIM), x_prompt.dtype)

    xp, xs = x_prompt, x_sample
    ckv_p, kr_p, st_p, cv_p = [], [], [], []
    ckv_s, kr_s, st_s, cv_s = [], [], [], []
    for layer in range(DEPTH):
        lw = {
            'ada_w': ada_w[layer], 'ada_b': ada_b[layer], 'norm1_g': norm1_g[layer],
            'w_in': w_in[layer], 'gdn_conv_w': gdn_conv_w[layer], 'gdn_a_log': gdn_a_log[layer],
            'gdn_dt_bias': gdn_dt_bias[layer], 'gdn_norm_g': gdn_norm_g[layer],
            'w_gdn_out': w_gdn_out[layer], 'mla_q_norm_g': mla_q_norm_g[layer], 'w_uq': w_uq[layer],
            'mla_kv_norm_g': mla_kv_norm_g[layer], 'w_ukv': w_ukv[layer],
            'q_head_norm_g': q_head_norm_g[layer], 'k_head_norm_g': k_head_norm_g[layer],
            'w_mla_out': w_mla_out[layer], 'w_o': w_o[layer], 'norm2_g': norm2_g[layer],
            'w_ff1': w_ff1[layer], 'w_ff2': w_ff2[layer],
        }
        xp, a1, a2, a3, a4 = trunk_layer(xp, c_prompt, pos_p, zero_state, zero_conv, None, None, lw)
        xs, b1, b2, b3, b4 = trunk_layer(xs, c_sample, pos_s, state_gdn[layer], state_gdn_conv[layer],
                                         cache_mla_ckv[layer], cache_mla_krope[layer], lw)
        ckv_p.append(a1); kr_p.append(a2); st_p.append(a3); cv_p.append(a4)
        ckv_s.append(b1); kr_s.append(b2); st_s.append(b3); cv_s.append(b4)

    return (xp, xs, jnp.stack(ckv_p), jnp.stack(kr_p), jnp.stack(st_p), jnp.stack(cv_p),
            jnp.stack(ckv_s), jnp.stack(kr_s), jnp.stack(st_s), jnp.stack(cv_s))
```

```cpp
#include <hip/hip_runtime.h>
#include <hip/hip_cooperative_groups.h>
#include <cstdio>
#include <cstdint>
namespace cg = cooperative_groups;

#ifndef MK_PHMASK
#define MK_PHMASK 0xFFF
#endif
#ifndef MK_SPLIT
#define MK_SPLIT 0
#endif

#define LAS __attribute__((address_space(3)))
typedef unsigned short bf16_t;
typedef short bf16x8 __attribute__((ext_vector_type(8)));
typedef float f32x4 __attribute__((ext_vector_type(4)));
typedef float f32x2 __attribute__((ext_vector_type(2)));
typedef float f32x16 __attribute__((ext_vector_type(16)));
typedef unsigned u32x4 __attribute__((ext_vector_type(4)));
typedef unsigned u32x2 __attribute__((ext_vector_type(2)));

constexpr int DM = 1024, BP = 8, SP = 2048, BS = 16, SS = 16, PAST = 2048;
constexpr int MP = BP * SP, MS = BS * SS, MR = MP + MS;
constexpr int SKV = PAST + SS;
constexpr int KR = MP + BS * SKV;
constexpr int NIN = 4784, NINP = 4864;
constexpr int DFF = 4096;
constexpr float EPS = 1e-6f;

constexpr size_t O_Y = 0, O_CKVP = 17039360, O_KRP = 21233664, O_STP = 21757952, O_CVP = 22020096,
                 O_CKVS = 22056960, O_KRS = 22122496, O_STS = 22130688, O_CVS = 22654976;

constexpr size_t KiB = 1024, MiB = 1024 * 1024;
constexpr size_t WS_CTL = 0;
constexpr size_t WS_MOD = 64 * KiB;
constexpr size_t WS_ROPE = 640 * KiB;
constexpr size_t WS_WIN = 960 * KiB;
constexpr size_t WS_WUQ = WS_WIN + (size_t)NINP * 1024 * 2;
constexpr size_t WS_WUK = WS_WUQ + 768 * 384 * 2;
constexpr size_t WS_WUV = WS_WUK + 512 * 256 * 2;
constexpr size_t WS_WGO = WS_WUV + 512 * 256 * 2;
constexpr size_t WS_WMO = WS_WGO + 1024 * 512 * 2;
constexpr size_t WS_WO = WS_WMO + 1024 * 512 * 2;
constexpr size_t WS_WF1 = WS_WO + 1024 * 1024 * 2;
constexpr size_t WS_WF2 = WS_WF1 + (size_t)4096 * 1024 * 2;
constexpr size_t WS_WEND = WS_WF2 + (size_t)4096 * 1024 * 2;
static_assert(WS_WEND <= 32 * MiB, "weights region");
constexpr size_t WS_H = 32 * MiB;
constexpr size_t WS_CKVROWS = 32 * MiB;
constexpr size_t WS_OMLA = 32 * MiB;
constexpr size_t WS_GQKV = 64 * MiB + 512 * KiB;
constexpr size_t WS_VT = WS_GQKV;
constexpr size_t WS_Z = 113 * MiB + 256 * KiB;
constexpr size_t WS_CQ = 129 * MiB + 512 * KiB;
constexpr size_t WS_CKVRAW = WS_CQ + (size_t)MR * 384 * 2;
constexpr size_t WS_KRRAW = WS_CKVRAW + (size_t)MR * 256 * 2;
constexpr size_t WS_AB = WS_KRRAW + (size_t)MR * 32 * 4;
static_assert(WS_AB + (size_t)MR * 16 * 4 <= 153 * MiB, "small proj outputs");
constexpr size_t WS_PREP = 153 * MiB;
constexpr size_t REC_BYTES = 41024;
static_assert(WS_PREP + (size_t)2048 * REC_BYTES <= 256 * MiB, "prep region");
constexpr size_t WS_KBUF = 153 * MiB;
constexpr size_t WS_QRAW = WS_KBUF + (size_t)KR * 768 * 2;
static_assert(WS_QRAW + (size_t)MR * 768 * 2 <= 256 * MiB, "qraw");
constexpr size_t WS_MERGED = 153 * MiB;
constexpr size_t WS_HID = 64 * MiB + 512 * KiB;
static_assert(WS_HID + (size_t)MR * DFF * 2 <= 256 * MiB, "hid");
constexpr size_t VT_SAMPLE_OFF = (size_t)BP * 8 * 64 * SP;

constexpr int LDS_BYTES = 147456;
constexpr int NPHASE = 12;

__device__ __forceinline__ unsigned cvt_pk_bf16(float lo, float hi) { unsigned r; asm volatile("v_cvt_pk_bf16_f32 %0, %1, %2" : "=v"(r) : "v"(lo), "v"(hi)); return r; }
__device__ __forceinline__ float bflo(unsigned u) { return __uint_as_float(u << 16); }
__device__ __forceinline__ float bfhi(unsigned u) { return __uint_as_float(u & 0xffff0000u); }
__device__ __forceinline__ float bf2f(bf16_t b) { return __uint_as_float((unsigned)b << 16); }
__device__ __forceinline__ bf16_t f2bf(float f) { return (bf16_t)(cvt_pk_bf16(f, 0.f) & 0xffffu); }
__device__ __forceinline__ float wave_sum(float v) {
#pragma unroll
    for (int o = 1; o < 64; o <<= 1) v += __shfl_xor(v, o);
    return v;
}
__device__ __forceinline__ float wave_max(float v) {
#pragma unroll
    for (int o = 1; o < 64; o <<= 1) v = fmaxf(v, __shfl_xor(v, o));
    return v;
}
__device__ __forceinline__ float sigmoidf_(float x) { return 1.f / (1.f + __expf(-x)); }
__device__ __forceinline__ float siluf_(float x) { return x / (1.f + __expf(-x)); }
__device__ __forceinline__ u32x4 pack8(const float* v) { u32x4 w; w.x = cvt_pk_bf16(v[0], v[1]); w.y = cvt_pk_bf16(v[2], v[3]); w.z = cvt_pk_bf16(v[4], v[5]); w.w = cvt_pk_bf16(v[6], v[7]); return w; }
__device__ __forceinline__ int mod_row(int r) { return r < MP ? (r >> 11) : 8 + ((r - MP) >> 4); }

namespace pg8 {
constexpr int BM = 256, BK = 64, HALF = 128, HTB = HALF * BK * 2, STAGE_BYTES = 8 * HTB, NXCD = 8, WGM = 8;
__host__ __device__ __forceinline__ int lds_byte(int r, int c) { const int st = (r >> 4) * 2 + (c >> 5), rr = r & 15, cc = c & 31, ob = rr * 64 + cc * 2; return st * 1024 + (ob ^ (((ob >> 9) & 1) << 5)); }
__host__ __device__ __forceinline__ void stage_rc(int b, int& R, int& C) { const int st = b / 1024, sb = b % 1024, swz = sb ^ (((sb >> 9) & 1) << 5); R = (st >> 1) * 16 + swz / 64; C = (st & 1) * 32 + (swz % 64) / 2; }
__host__ __device__ __forceinline__ int perm32(int rho) { const int n = rho >> 4, i = rho & 15; return 8 * (i >> 2) + 4 * n + (i & 3); }

struct Unit { int pm, pn, sel; };
struct Gemm { const bf16_t* A[2]; const bf16_t* Bt[2]; int lda, ldb, K; };

struct StaticOrder {
    int nM, nN, nwg, G, c;
    __device__ void init(int nM_, int nN_, int G_, int c_) { nM = nM_; nN = nN_; nwg = nM * nN; G = G_; c = c_; }
    __device__ bool next(int i, Unit& u) const {
        const long L = (long)i * G + c; if (L >= nwg) return false;
        int wgid = (int)L; { const int q = nwg / NXCD, r = nwg % NXCD, xcd = wgid % NXCD, off = wgid / NXCD; wgid = (xcd < r ? xcd * (q + 1) : r * (q + 1) + (xcd - r) * q) + off; }
        const int nig = WGM * nN, gid = wgid / nig, fm = gid * WGM, gsz = (nM - fm) < WGM ? (nM - fm) : WGM;
        u.pm = fm + ((wgid % nig) % gsz); u.pn = (wgid % nig) / gsz; u.sel = 0; return true;
    }
};
struct DualOrder {
    StaticOrder S;
    __device__ bool next(int i, Unit& u) const { const bool ok = S.next(i >> 1, u); u.sel = i & 1; return ok; }
};

template <class Epi, class Sched>
__device__ __forceinline__ void gemm_phase(LAS unsigned char* lds, const Gemm g, const Sched& S, const Epi& E) {
    const int tid = threadIdx.x, wid = __builtin_amdgcn_readfirstlane(tid >> 6), lane = tid & 63, wr = wid >> 2, wc = wid & 3, fr = lane & 15, fq = lane >> 4;
    const int K = g.K, nt = K / BK;
    unsigned voffA[2], voffB[2];
#pragma unroll
    for (int i = 0; i < 2; ++i) { int R, C; stage_rc(tid * 16 + i * 8192, R, C); const int Rb = Epi::PERM ? ((R & ~31) + perm32(R & 31)) : R;
        voffA[i] = (unsigned)(R * g.lda + C) * 2u; voffB[i] = (unsigned)(Rb * g.ldb + C) * 2u; }
    const size_t kstep = (size_t)(BK * 2);
    const size_t hstepA = (size_t)HALF * g.lda * 2, hstepB = (size_t)HALF * g.ldb * 2;
    const size_t tstepA = 2 * hstepA, tstepB = 2 * hstepB;
    const unsigned ldsw = (unsigned)wid * 1024u;
    const int aoff = lds_byte(wr * 64 + fr, fq * 8), boff = lds_byte(wc * 32 + fr, fq * 8);
#define PG8_SA(b, h) (((b) * 2 + (h)) * HTB)
#define PG8_SB(b, h) ((4 + (b) * 2 + (h)) * HTB)
#define PG8_STAGE(bufoff, gbase, voff) do { _Pragma("unroll") for (int _i = 0; _i < 2; ++_i) \
        __builtin_amdgcn_global_load_lds((const unsigned*)((const char*)(gbase) + (voff)[_i]), (LAS unsigned*)(lds + (bufoff) + ldsw + _i * 8192), 16, 0, 0); } while (0)
#define PG8_LDA(dst, b, h) do { _Pragma("unroll") for (int m = 0; m < 4; ++m) _Pragma("unroll") for (int k = 0; k < 2; ++k) dst[m][k] = *(const LAS bf16x8*)(lds + PG8_SA(b, h) + aoff + m * 2048 + k * 1024); } while (0)
#define PG8_LDB(dst, b, h) do { _Pragma("unroll") for (int n = 0; n < 2; ++n) _Pragma("unroll") for (int k = 0; k < 2; ++k) dst[n][k] = *(const LAS bf16x8*)(lds + PG8_SB(b, h) + boff + n * 2048 + k * 1024); } while (0)
#define PG8_MMA(ai, bj, At, Bt) do { __builtin_amdgcn_s_setprio(1); _Pragma("unroll") for (int m = 0; m < 4; ++m) _Pragma("unroll") for (int n = 0; n < 2; ++n) _Pragma("unroll") for (int k = 0; k < 2; ++k) \
        acc[ai][bj][m][n] = __builtin_amdgcn_mfma_f32_16x16x32_bf16(Bt[n][k], At[m][k], acc[ai][bj][m][n], 0, 0, 0); __builtin_amdgcn_s_setprio(0); } while (0)
#define PG8_WAIT_V(n) asm volatile("s_waitcnt vmcnt(" #n ")" ::: "memory")
#define PG8_WAIT_L(n) asm volatile("s_waitcnt lgkmcnt(" #n ")" ::: "memory")
#define PG8_BAR __builtin_amdgcn_s_barrier()
#define PG8_SCHED __builtin_amdgcn_sched_barrier(0)
    Unit cur, nxt; int ui = 0;
    if (!S.next(0, cur)) return;
    f32x4 acc[2][2][4][2];
#pragma unroll
    for (int a = 0; a < 2; ++a)
#pragma unroll
        for (int b = 0; b < 2; ++b)
#pragma unroll
            for (int m = 0; m < 4; ++m)
#pragma unroll
                for (int n = 0; n < 2; ++n) acc[a][b][m][n] = (f32x4){0.f, 0.f, 0.f, 0.f};
    bf16x8 At[4][2], B0[2][2], B1[2][2];
    const char* cA = (const char*)(cur.sel ? g.A[1] : g.A[0]) + (size_t)cur.pm * tstepA; const char* cB = (const char*)(cur.sel ? g.Bt[1] : g.Bt[0]) + (size_t)cur.pn * tstepB;
    PG8_STAGE(PG8_SB(0, 0), cB, voffB); PG8_STAGE(PG8_SB(0, 1), cB + hstepB, voffB); PG8_STAGE(PG8_SA(0, 0), cA, voffA); PG8_STAGE(PG8_SA(0, 1), cA + hstepA, voffA);
    if (wr == 1) PG8_BAR;
    PG8_WAIT_V(2); PG8_BAR;
    PG8_STAGE(PG8_SB(1, 0), cB + kstep, voffB); PG8_STAGE(PG8_SA(1, 0), cA + kstep, voffA); PG8_STAGE(PG8_SB(1, 1), cB + hstepB + kstep, voffB);
    PG8_WAIT_V(6); PG8_BAR;
    for (;;) {
        const bool has_next = S.next(ui + 1, nxt);
        const char* nA = has_next ? (const char*)(nxt.sel ? g.A[1] : g.A[0]) + (size_t)nxt.pm * tstepA : cA; const char* nB = has_next ? (const char*)(nxt.sel ? g.Bt[1] : g.Bt[0]) + (size_t)nxt.pn * tstepB : cB;
#pragma unroll 1
        for (int t = 0; t < nt; t += 2) {
            const bool last = (t == nt - 2);
            const char* a1 = cA + (size_t)(t + 1) * kstep;
            const char* a2 = last ? nA : cA + (size_t)(t + 2) * kstep; const char* b2 = last ? nB : cB + (size_t)(t + 2) * kstep;
            const char* a3 = a2 + kstep; const char* b3 = b2 + kstep;
            PG8_LDB(B0, 0, 0); PG8_LDB(B1, 0, 1); PG8_SCHED; PG8_LDA(At, 0, 0); PG8_STAGE(PG8_SA(1, 1), a1 + hstepA, voffA);
            PG8_WAIT_V(8); PG8_WAIT_L(0); PG8_BAR; PG8_MMA(0, 0, At, B0); PG8_MMA(0, 1, At, B1); PG8_BAR; PG8_SCHED;
            PG8_LDA(At, 0, 1); PG8_STAGE(PG8_SB(0, 0), b2, voffB); PG8_STAGE(PG8_SB(0, 1), b2 + hstepB, voffB); PG8_STAGE(PG8_SA(0, 0), a2, voffA);
            PG8_WAIT_V(8); PG8_WAIT_L(0); PG8_BAR; PG8_MMA(1, 0, At, B0); PG8_MMA(1, 1, At, B1); PG8_BAR; PG8_SCHED;
            PG8_LDB(B0, 1, 0); PG8_LDB(B1, 1, 1); PG8_SCHED; PG8_LDA(At, 1, 0); PG8_STAGE(PG8_SA(0, 1), a2 + hstepA, voffA);
            PG8_WAIT_V(8); PG8_WAIT_L(0); PG8_BAR; PG8_MMA(0, 0, At, B0); PG8_MMA(0, 1, At, B1); PG8_BAR; PG8_SCHED;
            PG8_LDA(At, 1, 1); PG8_STAGE(PG8_SB(1, 0), b3, voffB); PG8_STAGE(PG8_SB(1, 1), b3 + hstepB, voffB); PG8_STAGE(PG8_SA(1, 0), a3, voffA);
            PG8_WAIT_V(8); PG8_WAIT_L(0); PG8_BAR; PG8_MMA(1, 0, At, B0); PG8_MMA(1, 1, At, B1); PG8_BAR; PG8_SCHED;
        }
        if (wr == 0) PG8_BAR;
        E(acc, cur, wr, wc, fr, fq);
        if (!has_next) break;
#pragma unroll
        for (int a = 0; a < 2; ++a)
#pragma unroll
            for (int b = 0; b < 2; ++b)
#pragma unroll
                for (int m = 0; m < 4; ++m)
#pragma unroll
                    for (int n = 0; n < 2; ++n) acc[a][b][m][n] = (f32x4){0.f, 0.f, 0.f, 0.f};
        cur = nxt; cA = nA; cB = nB; ++ui;
        if (wr == 1) PG8_BAR;
    }
    PG8_WAIT_V(0);
    PG8_BAR;
#undef PG8_SA
#undef PG8_SB
#undef PG8_STAGE
#undef PG8_LDA
#undef PG8_LDB
#undef PG8_MMA
#undef PG8_WAIT_V
#undef PG8_WAIT_L
#undef PG8_BAR
#undef PG8_SCHED
}
}
using pg8::Unit;

#define EPI_ARGS const f32x4 (&acc)[2][2][4][2], const Unit& u, int wr, int wc, int fr, int fq
__device__ __forceinline__ u32x4 pack_v(const f32x4 v0, const f32x4 v1) { u32x4 w; w.x = cvt_pk_bf16(v0[0], v0[1]); w.y = cvt_pk_bf16(v0[2], v0[3]); w.z = cvt_pk_bf16(v1[0], v1[1]); w.w = cvt_pk_bf16(v1[2], v1[3]); return w; }

struct EpiProj {
    static constexpr bool PERM = true;
    bf16_t *gqkv, *z, *gl, *ckvraw, *cq; float *krraw, *ab;
    __device__ __forceinline__ void operator()(EPI_ARGS) const {
        const int pn = u.pn; bf16_t* base; int pitch;
        if (pn < 6) { base = gqkv + pn * 256; pitch = 1536; } else if (pn < 8) { base = z + (pn - 6) * 256; pitch = 512; }
        else if (pn < 16) { base = gl + (pn - 8) * 256; pitch = 2048; } else if (pn == 16) { base = ckvraw; pitch = 256; }
        else if (pn == 17) { base = cq; pitch = 384; } else { base = cq + 256; pitch = 384; }
#pragma unroll
        for (int ai = 0; ai < 2; ++ai)
#pragma unroll
            for (int m = 0; m < 4; ++m) { const size_t row = (size_t)u.pm * 256 + ai * 128 + wr * 64 + m * 16 + fr;
#pragma unroll
                for (int bj = 0; bj < 2; ++bj) { const int ct = bj * 128 + wc * 32 + 8 * fq; const f32x4 v0 = acc[ai][bj][m][0], v1 = acc[ai][bj][m][1];
                    if (pn < 18 || bj == 0) { *(u32x4*)(base + row * pitch + ct) = pack_v(v0, v1); }
                    else if (wc == 0) { float* d = krraw + row * 32 + 8 * fq; *(f32x4*)d = v0; *(f32x4*)(d + 4) = v1; }
                    else if (wc == 1 && fq < 2) { float* d = ab + row * 16 + 8 * fq; *(f32x4*)d = v0; *(f32x4*)(d + 4) = v1; }
                } }
    }
};
template <int ACT> struct EpiBf16 {
    static constexpr bool PERM = true;
    bf16_t* O; int ldc;
    __device__ __forceinline__ void operator()(EPI_ARGS) const {
#pragma unroll
        for (int ai = 0; ai < 2; ++ai)
#pragma unroll
            for (int m = 0; m < 4; ++m) { const size_t row = (size_t)u.pm * 256 + ai * 128 + wr * 64 + m * 16 + fr;
#pragma unroll
                for (int bj = 0; bj < 2; ++bj) { const int col = u.pn * 256 + bj * 128 + wc * 32 + 8 * fq; f32x4 v0 = acc[ai][bj][m][0], v1 = acc[ai][bj][m][1];
                    if (ACT == 1) {
#pragma unroll
                        for (int e = 0; e < 4; ++e) { const float a = fmaxf(v0[e], 0.f), b = fmaxf(v1[e], 0.f); v0[e] = a * a; v1[e] = b * b; } }
                    *(u32x4*)(O + row * ldc + col) = pack_v(v0, v1); } }
    }
};
struct EpiK {
    static constexpr bool PERM = true;
    bf16_t* K; const float *gk, *krp, *krs, *krcache;
    __device__ __forceinline__ void operator()(EPI_ARGS) const {
        const int head = u.pn * 4 + wc;
        float g0[8], g1[8], g2[8];
#pragma unroll
        for (int e = 0; e < 8; ++e) { g0[e] = gk[8 * fq + e]; g1[e] = gk[32 + 8 * fq + e]; g2[e] = gk[64 + 8 * fq + e]; }
#pragma unroll
        for (int ai = 0; ai < 2; ++ai)
#pragma unroll
            for (int m = 0; m < 4; ++m) { const int R = u.pm * 256 + ai * 128 + wr * 64 + m * 16 + fr;
                const float* kr;
                if (R < MP) kr = krp + (size_t)R * 32;
                else { const int q = R - MP, s = q / SKV, j = q - s * SKV; kr = j < PAST ? krcache + ((size_t)s * PAST + j) * 32 : krs + ((size_t)s * SS + (j - PAST)) * 32; }
                const f32x4 r0 = *(const f32x4*)(kr + 8 * fq), r1 = *(const f32x4*)(kr + 8 * fq + 4);
                const f32x4 a0 = acc[ai][0][m][0], a1 = acc[ai][0][m][1], b0 = acc[ai][1][m][0], b1 = acc[ai][1][m][1];
                float ss = 0.f;
#pragma unroll
                for (int e = 0; e < 4; ++e) ss += a0[e] * a0[e] + a1[e] * a1[e] + b0[e] * b0[e] + b1[e] * b1[e] + r0[e] * r0[e] + r1[e] * r1[e];
                ss += __shfl_xor(ss, 16); ss += __shfl_xor(ss, 32);
                const float rs = rsqrtf(ss * (1.f / 96.f) + EPS);
                float o0[8], o1[8], o2[8];
#pragma unroll
                for (int e = 0; e < 4; ++e) { o0[e] = a0[e] * rs * g0[e]; o0[4 + e] = a1[e] * rs * g0[4 + e]; o1[e] = b0[e] * rs * g1[e]; o1[4 + e] = b1[e] * rs * g1[4 + e];
                    o2[e] = r0[e] * rs * g2[e]; o2[4 + e] = r1[e] * rs * g2[4 + e]; }
                bf16_t* d = K + (size_t)R * 768 + head * 96 + 8 * fq;
                *(u32x4*)d = pack8(o0); *(u32x4*)(d + 32) = pack8(o1); *(u32x4*)(d + 64) = pack8(o2); }
    }
};
struct EpiVT {
    static constexpr bool PERM = true;
    bf16_t* VT;
    __device__ __forceinline__ void operator()(EPI_ARGS) const {
        size_t coff[2]; int pitch[2];
#pragma unroll
        for (int bj = 0; bj < 2; ++bj) { const int R0 = u.pn * 256 + bj * 128 + wc * 32 + 8 * fq;
            if (R0 < MP) { coff[bj] = (size_t)(R0 >> 11) * 8 * 64 * SP + (R0 & 2047); pitch[bj] = SP; }
            else { const int q = R0 - MP, s = q / SKV, j = q - s * SKV; coff[bj] = VT_SAMPLE_OFF + (size_t)s * 8 * 64 * SKV + j; pitch[bj] = SKV; } }
#pragma unroll
        for (int ai = 0; ai < 2; ++ai)
#pragma unroll
            for (int m = 0; m < 4; ++m) { const int f = u.pm * 256 + ai * 128 + wr * 64 + m * 16 + fr;
#pragma unroll
                for (int bj = 0; bj < 2; ++bj) *(u32x4*)(VT + coff[bj] + (size_t)f * pitch[bj]) = pack_v(acc[ai][bj][m][0], acc[ai][bj][m][1]); }
    }
};
struct EpiGate {
    static constexpr bool PERM = true;
    bf16_t* merged; const bf16_t* gl;
    __device__ __forceinline__ void operator()(EPI_ARGS) const {
#pragma unroll
        for (int ai = 0; ai < 2; ++ai)
#pragma unroll
            for (int m = 0; m < 4; ++m) { const size_t row = (size_t)u.pm * 256 + ai * 128 + wr * 64 + m * 16 + fr;
#pragma unroll
                for (int bj = 0; bj < 2; ++bj) { const int col = u.pn * 256 + bj * 128 + wc * 32 + 8 * fq; const f32x4 v0 = acc[ai][bj][m][0], v1 = acc[ai][bj][m][1];
                    const u32x4 gw = *(const u32x4*)(gl + row * 2048 + u.sel * 1024 + col);
                    float o[8];
                    o[0] = sigmoidf_(bflo(gw.x)) * v0[0]; o[1] = sigmoidf_(bfhi(gw.x)) * v0[1]; o[2] = sigmoidf_(bflo(gw.y)) * v0[2]; o[3] = sigmoidf_(bfhi(gw.y)) * v0[3];
                    o[4] = sigmoidf_(bflo(gw.z)) * v1[0]; o[5] = sigmoidf_(bfhi(gw.z)) * v1[1]; o[6] = sigmoidf_(bflo(gw.w)) * v1[2]; o[7] = sigmoidf_(bfhi(gw.w)) * v1[3];
                    bf16_t* d = merged + row * 1024 + col;
                    if (u.sel) { const u32x4 t = *(const u32x4*)d;
                        o[0] += bflo(t.x); o[1] += bfhi(t.x); o[2] += bflo(t.y); o[3] += bfhi(t.y); o[4] += bflo(t.z); o[5] += bfhi(t.z); o[6] += bflo(t.w); o[7] += bfhi(t.w); }
                    *(u32x4*)d = pack8(o); } }
    }
};
struct EpiRes {
    static constexpr bool PERM = false;
    const float *bp, *bs; float* out; const float* mod; int goff;
    __device__ __forceinline__ void operator()(EPI_ARGS) const {
#pragma unroll
        for (int ai = 0; ai < 2; ++ai)
#pragma unroll
            for (int m = 0; m < 4; ++m) { const int row = u.pm * 256 + ai * 128 + wr * 64 + m * 16 + fr;
                const float* br = row < MP ? bp + (size_t)row * 1024 : bs + (size_t)(row - MP) * 1024; const float* gr = mod + mod_row(row) * 6144 + goff;
#pragma unroll
                for (int bj = 0; bj < 2; ++bj)
#pragma unroll
                    for (int n = 0; n < 2; ++n) { const int col = u.pn * 256 + bj * 128 + wc * 32 + 16 * n + 4 * fq;
                        const f32x4 b = *(const f32x4*)(br + col), gt = *(const f32x4*)(gr + col);
                        *(f32x4*)(out + (size_t)row * 1024 + col) = b + gt * acc[ai][bj][m][n]; } }
    }
};

struct Args { const float* in[28]; float* out; unsigned char* ws; int ph_lo, ph_hi; };
enum { I_XP = 0, I_XS, I_CP, I_CS, I_CKV, I_CKR, I_ST, I_CONV, I_ADAW, I_ADAB, I_N1G, I_WIN, I_CONVW, I_ALOG, I_DTB, I_GNG, I_WGO, I_QNG, I_WUQ, I_KVNG, I_WUKV,
       I_QHG, I_KHG, I_WMO, I_WO, I_N2G, I_WF1, I_WF2 };

__device__ __forceinline__ int colmap(int which, int n) {
    switch (which) {
    case 0:
        if (n < 2048) return n; if (n < 4096) return 2736 + (n - 2048); if (n < 4352) return 2448 + (n - 4096); if (n < 4736) return 2064 + (n - 4352);
        if (n < 4768) return 2704 + (n - 4736); if (n < 4776) return 2048 + (n - 4768); if (n < 4784) return 2056 + (n - 4776); return -1;
    case 2: { const int pn = n >> 8, bj = (n >> 7) & 1, wc = (n >> 5) & 3, j = n & 31; return (4 * pn + wc) * 128 + bj * 32 + j; }
    case 3: return (n >> 6) * 128 + 64 + (n & 63);
    default: return n;
    }
}
__device__ __forceinline__ void transpose_item(const float* W, int K, int N, bf16_t* WT, LAS float* scr, int nblk, int which, int item, int lane) {
    const int kb = item / nblk, nb = item - kb * nblk, k0 = 64 * kb, n0 = 32 * nb;
    const int sc = colmap(which, n0 + (lane & 31));
#pragma unroll 8
    for (int i = 0; i < 32; ++i) { const int kk = 2 * i + (lane >> 5); scr[kk * 33 + (lane & 31)] = sc >= 0 ? W[(size_t)(k0 + kk) * N + sc] : 0.f; }
    asm volatile("s_waitcnt lgkmcnt(0)" ::: "memory");
    const int c = lane & 7;
#pragma unroll
    for (int j = 0; j < 4; ++j) { const int n = (lane >> 3) + 8 * j; const LAS float* s = scr + (8 * c) * 33 + n;
        u32x4 o; o.x = cvt_pk_bf16(s[0 * 33], s[1 * 33]); o.y = cvt_pk_bf16(s[2 * 33], s[3 * 33]); o.z = cvt_pk_bf16(s[4 * 33], s[5 * 33]); o.w = cvt_pk_bf16(s[6 * 33], s[7 * 33]);
        *(u32x4*)(WT + (size_t)(n0 + n) * K + k0 + 8 * c) = o; }
    asm volatile("s_waitcnt lgkmcnt(0)" ::: "memory");
}
__device__ __forceinline__ void phase0(const Args& a, LAS unsigned char* lds, int tid, int lane, int wave) {
    unsigned char* ws = a.ws;
    for (int idx = blockIdx.x * 512 + tid; idx < SKV * 16; idx += gridDim.x * 512) {
        const int pos = idx >> 4, i = idx & 15;
        const float inv = exp2f(-(float)i * (13.287712379549449f / 16.f));
        const float ang = (float)pos * inv;
        double t = (double)ang * 0.15915494309189535; t -= floor(t);
        const float rev = (float)t;
        ((f32x2*)(ws + WS_ROPE))[idx] = (f32x2){__builtin_amdgcn_cosf(rev), __builtin_amdgcn_sinf(rev)};
    }
    if (blockIdx.x < 96) {
        LAS float* sc = (LAS float*)lds;
        LAS float* red = (LAS float*)(lds + 98304);
        for (int i = tid; i < 24 * 1024; i += 512) { const int r = i >> 10, k = i & 1023; const float v = r < 8 ? a.in[I_CP][r * 1024 + k] : a.in[I_CS][(r - 8) * 1024 + k]; sc[i] = siluf_(v); }
        __syncthreads();
        const int col = blockIdx.x * 64 + lane; const float* wp = a.in[I_ADAW] + (size_t)(wave * 128) * 6144 + col;
        float acc[24];
#pragma unroll
        for (int r = 0; r < 24; ++r) acc[r] = 0.f;
        for (int k4 = 0; k4 < 32; ++k4) {
            const float w0 = wp[(size_t)(4 * k4) * 6144], w1 = wp[(size_t)(4 * k4 + 1) * 6144], w2 = wp[(size_t)(4 * k4 + 2) * 6144], w3 = wp[(size_t)(4 * k4 + 3) * 6144];
#pragma unroll
            for (int r = 0; r < 24; ++r) { const f32x4 s = *(const LAS f32x4*)(sc + r * 1024 + wave * 128 + 4 * k4); acc[r] += s[0] * w0 + s[1] * w1 + s[2] * w2 + s[3] * w3; }
        }
#pragma unroll
        for (int r = 0; r < 24; ++r) red[(wave * 24 + r) * 64 + lane] = acc[r];
        __syncthreads();
        for (int i = tid; i < 24 * 64; i += 512) { const int r = i >> 6, c = i & 63; float s = a.in[I_ADAB][blockIdx.x * 64 + c];
#pragma unroll
            for (int w = 0; w < 8; ++w) s += red[(w * 24 + r) * 64 + c];
            ((float*)(ws + WS_MOD))[r * 6144 + blockIdx.x * 64 + c] = s; }
        __syncthreads();
    }
    LAS float* scr = (LAS float*)(lds + wave * 8448);
    unsigned* ctr = (unsigned*)(ws + WS_CTL);
    constexpr int N0 = 16 * 152, N1 = 6 * 24, N2 = 4 * 16, N3 = 4 * 16, N4 = 8 * 32, N5 = 8 * 32, N6 = 16 * 32, N7 = 16 * 128, N8 = 64 * 32;
    constexpr int NT = N0 + N1 + N2 + N3 + N4 + N5 + N6 + N7 + N8;
    for (;;) {
        int it = 0; if (lane == 0) it = (int)atomicAdd(ctr, 1u); it = __builtin_amdgcn_readfirstlane(it);
        if (it >= NT) break;
        if (it < N0) { transpose_item(a.in[I_WIN], 1024, NIN, (bf16_t*)(ws + WS_WIN), scr, 152, 0, it, lane); continue; } it -= N0;
        if (it < N1) { transpose_item(a.in[I_WUQ], 384, 768, (bf16_t*)(ws + WS_WUQ), scr, 24, 1, it, lane); continue; } it -= N1;
        if (it < N2) { transpose_item(a.in[I_WUKV], 256, 1024, (bf16_t*)(ws + WS_WUK), scr, 16, 2, it, lane); continue; } it -= N2;
        if (it < N3) { transpose_item(a.in[I_WUKV], 256, 1024, (bf16_t*)(ws + WS_WUV), scr, 16, 3, it, lane); continue; } it -= N3;
        if (it < N4) { transpose_item(a.in[I_WGO], 512, 1024, (bf16_t*)(ws + WS_WGO), scr, 32, 1, it, lane); continue; } it -= N4;
        if (it < N5) { transpose_item(a.in[I_WMO], 512, 1024, (bf16_t*)(ws + WS_WMO), scr, 32, 1, it, lane); continue; } it -= N5;
        if (it < N6) { transpose_item(a.in[I_WO], 1024, 1024, (bf16_t*)(ws + WS_WO), scr, 32, 1, it, lane); continue; } it -= N6;
        if (it < N7) { transpose_item(a.in[I_WF1], 1024, 4096, (bf16_t*)(ws + WS_WF1), scr, 128, 1, it, lane); continue; } it -= N7;
        transpose_item(a.in[I_WF2], 4096, 1024, (bf16_t*)(ws + WS_WF2), scr, 32, 1, it, lane);
    }
}

__device__ __forceinline__ void norm_rows(const float* xp, const float* xs, const float* g, const float* mod, int shift_off, int scale_off, bf16_t* out, int gw, int lane) {
    for (int r = gw; r < MR; r += 2048) {
        const float* xr = r < MP ? xp + (size_t)r * 1024 : xs + (size_t)(r - MP) * 1024;
        const float* mr = mod + mod_row(r) * 6144;
        f32x4 v[4]; float ss = 0.f;
#pragma unroll
        for (int j = 0; j < 4; ++j) { v[j] = *(const f32x4*)(xr + 4 * (lane + 64 * j)); ss += v[j][0] * v[j][0] + v[j][1] * v[j][1] + v[j][2] * v[j][2] + v[j][3] * v[j][3]; }
        const float rs = rsqrtf(wave_sum(ss) * (1.f / 1024.f) + EPS);
#pragma unroll
        for (int j = 0; j < 4; ++j) { const int col = 4 * (lane + 64 * j);
            const f32x4 gg = *(const f32x4*)(g + col), sc = *(const f32x4*)(mr + scale_off + col), sh = *(const f32x4*)(mr + shift_off + col);
            const f32x4 y = v[j] * rs * gg * (sc + 1.f) + sh;
            u32x2 w; w.x = cvt_pk_bf16(y[0], y[1]); w.y = cvt_pk_bf16(y[2], y[3]);
            *(u32x2*)(out + (size_t)r * 1024 + col) = w; }
    }
}

__device__ __forceinline__ void mla_rows(const Args& a, int gw, int lane) {
    unsigned char* ws = a.ws; float* out = a.out;
    bf16_t* cq = (bf16_t*)(ws + WS_CQ); const bf16_t* ckvraw = (const bf16_t*)(ws + WS_CKVRAW); const float* krraw = (const float*)(ws + WS_KRRAW);
    bf16_t* ckvrows = (bf16_t*)(ws + WS_CKVROWS); const f32x2* rope = (const f32x2*)(ws + WS_ROPE);
    for (int r = gw; r < MR; r += 2048) {
        { float v[8]; float ss = 0.f;
          if (lane < 48) { const u32x4 w = *(const u32x4*)(cq + (size_t)r * 384 + 8 * lane);
              v[0] = bflo(w.x); v[1] = bfhi(w.x); v[2] = bflo(w.y); v[3] = bfhi(w.y); v[4] = bflo(w.z); v[5] = bfhi(w.z); v[6] = bflo(w.w); v[7] = bfhi(w.w);
#pragma unroll
              for (int e = 0; e < 8; ++e) ss += v[e] * v[e]; }
          const float rs = rsqrtf(wave_sum(ss) * (1.f / 384.f) + EPS);
          if (lane < 48) {
#pragma unroll
              for (int e = 0; e < 8; ++e) v[e] = v[e] * rs * a.in[I_QNG][8 * lane + e];
              *(u32x4*)(cq + (size_t)r * 384 + 8 * lane) = pack8(v); } }
        { float v[8]; float ss = 0.f;
          if (lane < 32) { const u32x4 w = *(const u32x4*)(ckvraw + (size_t)r * 256 + 8 * lane);
              v[0] = bflo(w.x); v[1] = bfhi(w.x); v[2] = bflo(w.y); v[3] = bfhi(w.y); v[4] = bflo(w.z); v[5] = bfhi(w.z); v[6] = bflo(w.w); v[7] = bfhi(w.w);
#pragma unroll
              for (int e = 0; e < 8; ++e) ss += v[e] * v[e]; }
          const float rs = rsqrtf(wave_sum(ss) * (1.f / 256.f) + EPS);
          if (lane < 32) {
#pragma unroll
              for (int e = 0; e < 8; ++e) v[e] = v[e] * rs * a.in[I_KVNG][8 * lane + e];
              float* o = r < MP ? out + O_CKVP + (size_t)r * 256 : out + O_CKVS + (size_t)(r - MP) * 256;
              *(f32x4*)(o + 8 * lane) = (f32x4){v[0], v[1], v[2], v[3]}; *(f32x4*)(o + 8 * lane + 4) = (f32x4){v[4], v[5], v[6], v[7]};
              const size_t R = r < MP ? (size_t)r : (size_t)MP + (size_t)((r - MP) >> 4) * SKV + PAST + ((r - MP) & 15);
              *(u32x4*)(ckvrows + R * 256 + 8 * lane) = pack8(v); } }
        if (lane < 16) { const int pos = r < MP ? (r & 2047) : PAST + ((r - MP) & 15);
            const float x1 = krraw[(size_t)r * 32 + lane], x2 = krraw[(size_t)r * 32 + 16 + lane]; const f32x2 cs = rope[pos * 16 + lane];
            float* o = r < MP ? out + O_KRP + (size_t)r * 32 : out + O_KRS + (size_t)(r - MP) * 32;
            o[lane] = x1 * cs.x - x2 * cs.y; o[16 + lane] = x2 * cs.x + x1 * cs.y; }
    }
}

template <int I> struct SolveRow {
    static __device__ __forceinline__ void run(float (&x)[64], const LAS float* A, const LAS bf16_t* src, const LAS float* scp) {
        float s = scp[I] * bf2f(src[I * 72]);
#pragma unroll
        for (int j4 = 0; j4 < (I + 3) / 4; ++j4) { const f32x4 av = *(const LAS f32x4*)(A + I * 64 + 4 * j4);
#pragma unroll
            for (int e = 0; e < 4; ++e) if (4 * j4 + e < I) s -= av[e] * x[4 * j4 + e]; }
        x[I] = s;
        SolveRow<I + 1>::run(x, A, src, scp);
    }
};
template <> struct SolveRow<64> { static __device__ __forceinline__ void run(float (&)[64], const LAS float*, const LAS bf16_t*, const LAS float*) {} };

__device__ __forceinline__ void gdn_prep(const Args& a, LAS unsigned char* lds, int tid) {
    const int slot = tid >> 7, w2 = __builtin_amdgcn_readfirstlane((tid >> 6) & 1), lane = tid & 63;
    LAS unsigned char* sl = lds + slot * 35584;
    LAS bf16_t* q_lds = (LAS bf16_t*)sl; LAS float* A_lds = (LAS float*)sl;
    LAS bf16_t* k_lds = (LAS bf16_t*)(sl + 16384); LAS bf16_t* v_lds = (LAS bf16_t*)(sl + 25600);
    LAS float* gcs = (LAS float*)(sl + 34816); LAS float* bts = (LAS float*)(sl + 35072); LAS float* scw = (LAS float*)(sl + 35328);
    const bf16_t* gqkv = (const bf16_t*)(a.ws + WS_GQKV); const float* ab = (const float*)(a.ws + WS_AB); const float* cw = a.in[I_CONVW];
    for (int qi = blockIdx.x; qi < 512; qi += gridDim.x) {
        const int item = qi * 4 + slot, bh = item >> 5, n = item & 31, b = bh >> 3, h = bh & 7;
        const int r0 = b * SP + 64 * n, t = lane;
        unsigned char* rec = a.ws + WS_PREP + (size_t)item * REC_BYTES;
        LAS float* cwl = (LAS float*)(sl + 9216);
        for (int i = tid & 127; i < 768; i += 128) { const int tap = i / 192, cc = i - tap * 192; cwl[i] = cw[tap * 1536 + (cc >> 6) * 512 + h * 64 + (cc & 63)]; }
        __syncthreads();
        {
            const int colbase = w2 * 512 + h * 64;
            float o[64];
#pragma unroll
            for (int c = 0; c < 64; ++c) o[c] = 0.f;
#pragma unroll 1
            for (int tap = 0; tap < 4; ++tap) { const int rr = t - 3 + tap; const bool valid = (n > 0) || (rr >= 0);
                const bf16_t* src = gqkv + (size_t)(r0 + (valid ? rr : 0)) * 1536 + colbase;
#pragma unroll
                for (int c8 = 0; c8 < 8; ++c8) { u32x4 w = *(const u32x4*)(src + 8 * c8); if (!valid) w = (u32x4){0u, 0u, 0u, 0u};
                    const f32x4 wa = *(const LAS f32x4*)(cwl + tap * 192 + w2 * 64 + 8 * c8), wb = *(const LAS f32x4*)(cwl + tap * 192 + w2 * 64 + 8 * c8 + 4);
                    o[8 * c8 + 0] += wa[0] * bflo(w.x); o[8 * c8 + 1] += wa[1] * bfhi(w.x); o[8 * c8 + 2] += wa[2] * bflo(w.y); o[8 * c8 + 3] += wa[3] * bfhi(w.y);
                    o[8 * c8 + 4] += wb[0] * bflo(w.z); o[8 * c8 + 5] += wb[1] * bfhi(w.z); o[8 * c8 + 6] += wb[2] * bflo(w.w); o[8 * c8 + 7] += wb[3] * bfhi(w.w); } }
            float ss = 0.f;
#pragma unroll
            for (int c = 0; c < 64; ++c) { o[c] = siluf_(o[c]); ss += o[c] * o[c]; }
            const float sc = rsqrtf(ss + EPS) * (w2 ? 1.f : 0.125f);
            LAS bf16_t* dst = (w2 ? k_lds : q_lds) + t * 72;
#pragma unroll
            for (int c8 = 0; c8 < 8; ++c8) { float v[8];
#pragma unroll
                for (int e = 0; e < 8; ++e) v[e] = o[8 * c8 + e] * sc;
                *(LAS u32x4*)(dst + 8 * c8) = pack8(v); }
        }
        {
            const int colbase = 1024 + h * 64 + 32 * w2;
            float o[32];
#pragma unroll
            for (int c = 0; c < 32; ++c) o[c] = 0.f;
#pragma unroll 1
            for (int tap = 0; tap < 4; ++tap) { const int rr = t - 3 + tap; const bool valid = (n > 0) || (rr >= 0);
                const bf16_t* src = gqkv + (size_t)(r0 + (valid ? rr : 0)) * 1536 + colbase;
#pragma unroll
                for (int c8 = 0; c8 < 4; ++c8) { u32x4 w = *(const u32x4*)(src + 8 * c8); if (!valid) w = (u32x4){0u, 0u, 0u, 0u};
                    const f32x4 wa = *(const LAS f32x4*)(cwl + tap * 192 + 128 + 32 * w2 + 8 * c8), wb = *(const LAS f32x4*)(cwl + tap * 192 + 128 + 32 * w2 + 8 * c8 + 4);
                    o[8 * c8 + 0] += wa[0] * bflo(w.x); o[8 * c8 + 1] += wa[1] * bfhi(w.x); o[8 * c8 + 2] += wa[2] * bflo(w.y); o[8 * c8 + 3] += wa[3] * bfhi(w.y);
                    o[8 * c8 + 4] += wb[0] * bflo(w.z); o[8 * c8 + 5] += wb[1] * bfhi(w.z); o[8 * c8 + 6] += wb[2] * bflo(w.w); o[8 * c8 + 7] += wb[3] * bfhi(w.w); } }
#pragma unroll
            for (int c8 = 0; c8 < 4; ++c8) { float v[8];
#pragma unroll
                for (int e = 0; e < 8; ++e) v[e] = siluf_(o[8 * c8 + e]);
                *(LAS u32x4*)(v_lds + t * 72 + 32 * w2 + 8 * c8) = pack8(v); }
        }
        float gc, gcl;
        {
            const float av = ab[(size_t)(r0 + t) * 16 + h], bv = ab[(size_t)(r0 + t) * 16 + 8 + h];
            const float xg = av + a.in[I_DTB][h];
            const float sp = fmaxf(xg, 0.f) + __logf(1.f + __expf(-fabsf(xg)));
            gc = -__expf(a.in[I_ALOG][h]) * sp;
#pragma unroll
            for (int o = 1; o < 64; o <<= 1) { const float u = __shfl_up(gc, o); if (lane >= o) gc += u; }
            gcl = __shfl(gc, 63);
            if (w2 == 0) { const float be = sigmoidf_(bv); gcs[t] = gc; bts[t] = be; scw[t] = be * __expf(gc); if (lane == 0) *(float*)(rec + 40960) = __expf(gcl); }
        }
        __syncthreads();
#pragma unroll
        for (int it = 0; it < 8; ++it) { const int ri = (lane >> 3) + 8 * it, pg = lane & 7, d0 = 32 * (pg >> 2) + 4 * (pg & 3);
            float v[8];
            if (w2 == 0) { const u32x2 w0 = *(const LAS u32x2*)(q_lds + ri * 72 + d0), w1 = *(const LAS u32x2*)(q_lds + ri * 72 + d0 + 16); const float e = __expf(gcs[ri]);
                v[0] = bflo(w0.x) * e; v[1] = bfhi(w0.x) * e; v[2] = bflo(w0.y) * e; v[3] = bfhi(w0.y) * e; v[4] = bflo(w1.x) * e; v[5] = bfhi(w1.x) * e; v[6] = bflo(w1.y) * e; v[7] = bfhi(w1.y) * e;
                *(u32x4*)(rec + 8192 + (ri * 64 + 8 * pg) * 2) = pack8(v); }
            else {
#pragma unroll
                for (int j = 0; j < 8; ++j) { const int c = d0 + 16 * (j >> 2) + (j & 3); v[j] = bf2f(k_lds[c * 72 + ri]) * __expf(gcl - gcs[c]); }
                *(u32x4*)(rec + 24576 + (ri * 64 + 8 * pg) * 2) = pack8(v); } }
        const int m_ = lane & 15, g4 = lane >> 4;
        f32x4 acc[4][4];
        {
            bf16x8 ka[4][2], bb[4][2];
            const LAS bf16_t* bsrc = w2 ? k_lds : q_lds;
#pragma unroll
            for (int jt = 0; jt < 4; ++jt)
#pragma unroll
                for (int ks = 0; ks < 2; ++ks) { ka[jt][ks] = *(const LAS bf16x8*)(k_lds + (16 * jt + m_) * 72 + 32 * ks + 8 * g4); bb[jt][ks] = *(const LAS bf16x8*)(bsrc + (16 * jt + m_) * 72 + 32 * ks + 8 * g4); }
#pragma unroll
            for (int jt = 0; jt < 4; ++jt)
#pragma unroll
                for (int it = 0; it < 4; ++it) { f32x4 c = (f32x4){0.f, 0.f, 0.f, 0.f};
                    if (it >= jt) {
#pragma unroll
                        for (int ks = 0; ks < 2; ++ks) c = __builtin_amdgcn_mfma_f32_16x16x32_bf16(ka[jt][ks], bb[it][ks], c, 0, 0, 0); }
                    acc[jt][it] = c; }
        }
        __syncthreads();
#pragma unroll
        for (int jt = 0; jt < 4; ++jt)
#pragma unroll
            for (int it = 0; it < 4; ++it) { const int i = 16 * it + m_, j0 = 16 * jt + 4 * g4; const float gi = gcs[i]; const f32x4 gj = *(const LAS f32x4*)(gcs + j0);
                float v[4];
                if (w2 == 0) {
#pragma unroll
                    for (int e = 0; e < 4; ++e) { const bool keep = it > jt ? true : (it < jt ? false : m_ >= 4 * g4 + e); v[e] = keep ? acc[jt][it][e] * __expf(keep ? gi - gj[e] : 0.f) : 0.f; }
                    u32x2 w; w.x = cvt_pk_bf16(v[0], v[1]); w.y = cvt_pk_bf16(v[2], v[3]);
                    *(u32x2*)(rec + 16384 + (i * 64 + 32 * (jt >> 1) + 8 * g4 + 4 * (jt & 1)) * 2) = w; }
                else { const float bi = bts[i];
#pragma unroll
                    for (int e = 0; e < 4; ++e) { const bool keep = it > jt ? true : (it < jt ? false : m_ > 4 * g4 + e); v[e] = keep ? bi * acc[jt][it][e] * __expf(keep ? gi - gj[e] : 0.f) : 0.f; }
                    *(LAS f32x4*)(A_lds + i * 64 + j0) = (f32x4){v[0], v[1], v[2], v[3]}; } }
        __syncthreads();
        {
            const LAS bf16_t* src = w2 ? k_lds : v_lds; const LAS float* scp = w2 ? scw : bts;
            float x[64];
            SolveRow<0>::run(x, A_lds, src + lane, scp);
            if (w2 == 0) {
#pragma unroll
                for (int q = 0; q < 8; ++q) *(u32x4*)(rec + 32768 + (lane * 64 + 8 * q) * 2) = pack8(&x[8 * q]);
            } else { const int pinv = (lane & 32) | (((lane >> 2) & 3) << 3) | (((lane >> 4) & 1) << 2) | (lane & 3);
#pragma unroll
                for (int i = 0; i < 64; ++i) *(bf16_t*)(rec + (i * 64 + pinv) * 2) = f2bf(-x[i]); }
        }
        __syncthreads();
    }
}

__device__ __forceinline__ void misc_p3(const Args& a, int tid) {
    bf16_t* ckvrows = (bf16_t*)(a.ws + WS_CKVROWS); const float* cache = a.in[I_CKV];
    const int gt = blockIdx.x * 512 + tid, GT = gridDim.x * 512;
    for (int i = gt; i < BS * PAST * 32; i += GT) { const int row = i >> 5, c8 = i & 31, s = row >> 11, j = row & 2047;
        const f32x4 v0 = *(const f32x4*)(cache + (size_t)row * 256 + 8 * c8), v1 = *(const f32x4*)(cache + (size_t)row * 256 + 8 * c8 + 4);
        *(u32x4*)(ckvrows + ((size_t)MP + (size_t)s * SKV + j) * 256 + 8 * c8) = pack_v(v0, v1); }
    const bf16_t* gqkv = (const bf16_t*)(a.ws + WS_GQKV);
    for (int i = gt; i < BP * 3 * 1536; i += GT) { const int b = i / 4608, rem = i - b * 4608, r = rem / 1536, c = rem - r * 1536;
        a.out[O_CVP + i] = bf2f(gqkv[(size_t)(b * SP + SP - 3 + r) * 1536 + c]); }
    for (int i = gt; i < BS * 3 * 1536; i += GT) { const int s = i / 4608, rem = i - s * 4608, r = rem / 1536, c = rem - r * 1536;
        a.out[O_CVS + i] = bf2f(gqkv[(size_t)(MP + s * SS + SS - 3 + r) * 1536 + c]); }
}

__device__ __forceinline__ bf16x8 pack_frag(const f32x4 lo, const f32x4 hi) { u32x4 w = pack_v(lo, hi); return __builtin_bit_cast(bf16x8, w); }

__device__ __forceinline__ void scan_prompt(const Args& a, LAS unsigned char* lds, int bh, int tid, int lane, int wave) {
    const int b = bh >> 3, h = bh & 7;
    const unsigned char* recs = a.ws + WS_PREP + (size_t)bh * 32 * REC_BYTES;
    bf16_t* zo = (bf16_t*)(a.ws + WS_Z);
    LAS float* red = (LAS float*)(lds + 92160);
    const int prow = (tid & 511) >> 3, pc16 = tid & 7;
    const int n_ = lane & 15, g4 = lane >> 4, dv = 16 * wave + n_;
    f32x4 S[4];
#pragma unroll
    for (int kt = 0; kt < 4; ++kt) S[kt] = (f32x4){0.f, 0.f, 0.f, 0.f};
    const float gn = wave < 4 ? a.in[I_GNG][dv] : 0.f;
    { u32x4 p[5];
#pragma unroll
      for (int i = 0; i < 5; ++i) p[i] = *(const u32x4*)(recs + i * 8192 + tid * 16);
#pragma unroll
      for (int i = 0; i < 5; ++i) *(LAS u32x4*)(lds + i * 9216 + prow * 144 + pc16 * 16) = p[i]; }
    __syncthreads();
    for (int n = 0; n < 32; ++n) {
        LAS unsigned char* cur = lds + (n & 1) * 46080; LAS unsigned char* nxt = lds + ((n + 1) & 1) * 46080;
        u32x4 p[5];
        if (n + 1 < 32) {
#pragma unroll
            for (int i = 0; i < 5; ++i) p[i] = *(const u32x4*)(recs + (size_t)(n + 1) * REC_BYTES + i * 8192 + tid * 16); }
        f32x4 O[4];
        float zv[4][4];
        const size_t rowbase = (size_t)b * SP + 64 * n;
        if (wave < 4) {
#pragma unroll
            for (int mt = 0; mt < 4; ++mt)
#pragma unroll
                for (int e = 0; e < 4; ++e) zv[mt][e] = bf2f(zo[(rowbase + 16 * mt + 4 * g4 + e) * 512 + h * 64 + dv]);
            const float gl = *(const float*)(recs + (size_t)n * REC_BYTES + 40960);
            bf16x8 Bs[2];
            Bs[0] = pack_frag(S[0], S[1]); Bs[1] = pack_frag(S[2], S[3]);
            f32x4 VN[4];
#pragma unroll
            for (int mt = 0; mt < 4; ++mt) { const u32x2 w = *(const LAS u32x2*)(cur + 4 * 9216 + dv * 144 + (16 * mt + 4 * g4) * 2);
                f32x4 c = (f32x4){bflo(w.x), bfhi(w.x), bflo(w.y), bfhi(w.y)};
#pragma unroll
                for (int ks = 0; ks < 2; ++ks) c = __builtin_amdgcn_mfma_f32_16x16x32_bf16(*(const LAS bf16x8*)(cur + (16 * mt + n_) * 144 + (32 * ks + 8 * g4) * 2), Bs[ks], c, 0, 0, 0);
                VN[mt] = c;
                f32x4 o = (f32x4){0.f, 0.f, 0.f, 0.f};
#pragma unroll
                for (int ks = 0; ks < 2; ++ks) o = __builtin_amdgcn_mfma_f32_16x16x32_bf16(*(const LAS bf16x8*)(cur + 9216 + (16 * mt + n_) * 144 + (32 * ks + 8 * g4) * 2), Bs[ks], o, 0, 0, 0);
                O[mt] = o; }
            bf16x8 Bv[2];
            Bv[0] = pack_frag(VN[0], VN[1]); Bv[1] = pack_frag(VN[2], VN[3]);
#pragma unroll
            for (int mt = 0; mt < 4; ++mt) {
#pragma unroll
                for (int ks = 0; ks < 2; ++ks) O[mt] = __builtin_amdgcn_mfma_f32_16x16x32_bf16(*(const LAS bf16x8*)(cur + 2 * 9216 + (16 * mt + n_) * 144 + (32 * ks + 8 * g4) * 2), Bv[ks], O[mt], 0, 0, 0);
                f32x4 s = S[mt] * gl;
#pragma unroll
                for (int ks = 0; ks < 2; ++ks) s = __builtin_amdgcn_mfma_f32_16x16x32_bf16(*(const LAS bf16x8*)(cur + 3 * 9216 + (16 * mt + n_) * 144 + (32 * ks + 8 * g4) * 2), Bv[ks], s, 0, 0, 0);
                S[mt] = s; }
#pragma unroll
            for (int mt = 0; mt < 4; ++mt)
#pragma unroll
                for (int e = 0; e < 4; ++e) { float q = O[mt][e] * O[mt][e]; q += __shfl_xor(q, 1); q += __shfl_xor(q, 2); q += __shfl_xor(q, 4); q += __shfl_xor(q, 8);
                    if (n_ == 0) red[((n & 1) * 4 + wave) * 64 + 16 * mt + 4 * g4 + e] = q; }
        }
        if (n + 1 < 32) {
#pragma unroll
            for (int i = 0; i < 5; ++i) *(LAS u32x4*)(nxt + i * 9216 + prow * 144 + pc16 * 16) = p[i]; }
        __syncthreads();
        if (wave < 4) {
#pragma unroll
            for (int mt = 0; mt < 4; ++mt)
#pragma unroll
                for (int e = 0; e < 4; ++e) { const int c = 16 * mt + 4 * g4 + e; const LAS float* rp = red + (n & 1) * 256 + c;
                    const float ss = rp[0] + rp[64] + rp[128] + rp[192];
                    const float val = O[mt][e] * rsqrtf(ss * (1.f / 64.f) + EPS) * gn * siluf_(zv[mt][e]);
                    zo[(rowbase + c) * 512 + h * 64 + dv] = f2bf(val); }
        }
    }
    if (wave < 4) { float* so = a.out + O_STP + (size_t)bh * 4096;
#pragma unroll
        for (int kt = 0; kt < 4; ++kt)
#pragma unroll
            for (int e = 0; e < 4; ++e) so[(16 * kt + 4 * g4 + e) * 64 + dv] = S[kt][e]; }
}

__device__ __forceinline__ void gdn_sample(const Args& a, LAS unsigned char* lds, int u, int tid, int lane, int wave) {
    const int s = u >> 3, h = u & 7;
    LAS float* raw = (LAS float*)lds;
    LAS float* qkv = raw + 19 * 192;
    LAS float* gs = qkv + 16 * 192;
    LAS float* pa = gs + 32;
    LAS float* pb = pa + 512;
    LAS float* ol = pb + 512;
    const bf16_t* gqkv = (const bf16_t*)(a.ws + WS_GQKV); const float* ab = (const float*)(a.ws + WS_AB);
    for (int i = tid; i < 19 * 192; i += 512) { const int r = i / 192, cc = i - r * 192, seg = cc >> 6, c = cc & 63, col = seg * 512 + h * 64 + c;
        raw[i] = r < 3 ? a.in[I_CONV][((size_t)s * 3 + r) * 1536 + col] : bf2f(gqkv[(size_t)(MP + s * SS + (r - 3)) * 1536 + col]); }
    if (tid < 16) { const size_t row = (size_t)MP + s * SS + tid; const float av = ab[row * 16 + h], bv = ab[row * 16 + 8 + h];
        const float xg = av + a.in[I_DTB][h]; const float sp = fmaxf(xg, 0.f) + __logf(1.f + __expf(-fabsf(xg)));
        gs[tid] = __expf(-__expf(a.in[I_ALOG][h]) * sp); gs[16 + tid] = sigmoidf_(bv); }
    __syncthreads();
    for (int i = tid; i < 16 * 192; i += 512) { const int t = i / 192, cc = i - t * 192, seg = cc >> 6, c = cc & 63, col = seg * 512 + h * 64 + c;
        float y = 0.f;
#pragma unroll
        for (int tap = 0; tap < 4; ++tap) y += a.in[I_CONVW][tap * 1536 + col] * raw[(t + tap) * 192 + cc];
        qkv[i] = siluf_(y); }
    __syncthreads();
    for (int v = wave; v < 32; v += 8) { const int t = v >> 1, seg = v & 1; const float x = qkv[t * 192 + seg * 64 + lane];
        const float ss = wave_sum(x * x); qkv[t * 192 + seg * 64 + lane] = x * rsqrtf(ss + EPS) * (seg ? 1.f : 0.125f); }
    __syncthreads();
    const int dv = tid & 63, dkg = tid >> 6;
    float S[8];
    const float* s0 = a.in[I_ST] + (size_t)u * 4096;
#pragma unroll
    for (int i = 0; i < 8; ++i) S[i] = s0[(8 * dkg + i) * 64 + dv];
    for (int t = 0; t < 16; ++t) {
        const float eg = gs[t], bt = gs[16 + t];
        const LAS float* qr = qkv + t * 192; const LAS float* kr = qr + 64; const float vv = qr[128 + dv];
        float part = 0.f;
#pragma unroll
        for (int i = 0; i < 8; ++i) { S[i] *= eg; part += kr[8 * dkg + i] * S[i]; }
        pa[dkg * 64 + dv] = part;
        __syncthreads();
        float ks = 0.f;
#pragma unroll
        for (int w = 0; w < 8; ++w) ks += pa[w * 64 + dv];
        const float dl = bt * (vv - ks);
        float po = 0.f;
#pragma unroll
        for (int i = 0; i < 8; ++i) { S[i] += kr[8 * dkg + i] * dl; po += qr[8 * dkg + i] * S[i]; }
        pb[dkg * 64 + dv] = po;
        __syncthreads();
        if (dkg == 0) { float o = 0.f;
#pragma unroll
            for (int w = 0; w < 8; ++w) o += pb[w * 64 + dv];
            ol[t * 64 + dv] = o; }
    }
    __syncthreads();
    float* so = a.out + O_STS + (size_t)u * 4096;
#pragma unroll
    for (int i = 0; i < 8; ++i) so[(8 * dkg + i) * 64 + dv] = S[i];
    bf16_t* zo = (bf16_t*)(a.ws + WS_Z);
    for (int t = wave; t < 16; t += 8) { const float o = ol[t * 64 + lane]; const float ss = wave_sum(o * o);
        const size_t idx = ((size_t)MP + s * SS + t) * 512 + h * 64 + lane;
        zo[idx] = f2bf(o * rsqrtf(ss * (1.f / 64.f) + EPS) * a.in[I_GNG][lane] * siluf_(bf2f(zo[idx]))); }
}

struct AttnWave { int qrow, pos, mylast; bool qvalid; };
__device__ __forceinline__ void attn_unit(const Args& a, LAS unsigned char* lds, const bf16_t* Kb, const bf16_t* VTb, int pitch, int head, int ntiles, int nkeys,
                                          const AttnWave w, float boff, int tid, int lane) {
    const int r = lane & 31, hh = lane >> 5;
    const bf16_t* qraw = (const bf16_t*)(a.ws + WS_QRAW); const f32x2* rope = (const f32x2*)(a.ws + WS_ROPE);
    bf16x8 Qf[6];
    {
        const bf16_t* qp = qraw + (size_t)w.qrow * 768 + head * 96 + 8 * hh;
        float v[6][8]; float ss = 0.f;
#pragma unroll
        for (int s = 0; s < 6; ++s) { const u32x4 u = *(const u32x4*)(qp + 16 * s);
            v[s][0] = bflo(u.x); v[s][1] = bfhi(u.x); v[s][2] = bflo(u.y); v[s][3] = bfhi(u.y); v[s][4] = bflo(u.z); v[s][5] = bfhi(u.z); v[s][6] = bflo(u.w); v[s][7] = bfhi(u.w); }
#pragma unroll
        for (int e = 0; e < 8; ++e) { const f32x2 cs = rope[w.pos * 16 + 8 * hh + e]; const float x1 = v[4][e], x2 = v[5][e]; v[4][e] = x1 * cs.x - x2 * cs.y; v[5][e] = x2 * cs.x + x1 * cs.y; }
#pragma unroll
        for (int s = 0; s < 6; ++s)
#pragma unroll
            for (int e = 0; e < 8; ++e) ss += v[s][e] * v[s][e];
        ss += __shfl_xor(ss, 32);
        const float rs = rsqrtf(ss * (1.f / 96.f) + EPS) * (1.4426950408889634f * 0.10206207261596575f);
#pragma unroll
        for (int s = 0; s < 6; ++s) { float o[8];
#pragma unroll
            for (int e = 0; e < 8; ++e) o[e] = v[s][e] * rs * a.in[I_QHG][16 * s + 8 * hh + e];
            Qf[s] = __builtin_bit_cast(bf16x8, pack8(o)); }
    }
    const int kp0row = tid / 12, kp0c = tid - kp0row * 12, kp1row = (tid + 512) / 12, kp1c = (tid + 512) - kp1row * 12, vrow = tid >> 3, vc = tid & 7;
    const int pr = (r & 19) | ((r & 4) << 1) | ((r & 8) >> 1);
    f32x16 oa[2];
#pragma unroll
    for (int i = 0; i < 16; ++i) { oa[0][i] = 0.f; oa[1][i] = 0.f; }
    float lsum = 0.f;
    u32x4 k0, k1, vv;
    k0 = *(const u32x4*)(Kb + (size_t)kp0row * 768 + kp0c * 8); if (tid < 256) k1 = *(const u32x4*)(Kb + (size_t)kp1row * 768 + kp1c * 8);
    vv = *(const u32x4*)(VTb + (size_t)vrow * pitch + vc * 8);
    *(LAS u32x4*)(lds + kp0row * 208 + kp0c * 16) = k0; if (tid < 256) *(LAS u32x4*)(lds + kp1row * 208 + kp1c * 16) = k1;
    *(LAS u32x4*)(lds + 13312 + vrow * 144 + vc * 16) = vv;
    __syncthreads();
    for (int kt = 0; kt < ntiles; ++kt) {
        LAS unsigned char* cur = lds + (kt & 1) * 22528; LAS unsigned char* nxt = lds + ((kt + 1) & 1) * 22528;
        const int key0 = kt * 64;
        if (kt + 1 < ntiles) { const bf16_t* kn = Kb + (size_t)(key0 + 64) * 768;
            k0 = *(const u32x4*)(kn + (size_t)kp0row * 768 + kp0c * 8); if (tid < 256) k1 = *(const u32x4*)(kn + (size_t)kp1row * 768 + kp1c * 8);
            vv = *(const u32x4*)(VTb + (size_t)vrow * pitch + key0 + 64 + vc * 8); }
        if (kt <= w.mylast) {
            f32x16 sa[2];
#pragma unroll
            for (int t2 = 0; t2 < 2; ++t2) {
#pragma unroll
                for (int i = 0; i < 16; ++i) sa[t2][i] = 0.f;
#pragma unroll
                for (int s = 0; s < 6; ++s) sa[t2] = __builtin_amdgcn_mfma_f32_32x32x16_bf16(*(const LAS bf16x8*)(cur + (32 * t2 + pr) * 208 + (16 * s + 8 * hh) * 2), Qf[s], sa[t2], 0, 0, 0);
            }
            const bool tail = key0 + 64 > nkeys;
            bf16x8 Pf[2][2];
#pragma unroll
            for (int t2 = 0; t2 < 2; ++t2) { float p[16];
#pragma unroll
                for (int jj = 0; jj < 16; ++jj) { float e = __builtin_amdgcn_exp2f(sa[t2][jj] - boff);
                    if (tail) { const int key = key0 + 32 * t2 + (jj & 3) + 4 * ((jj >> 2) & 1) + 8 * hh + 16 * (jj >> 3); if (key >= nkeys) e = 0.f; }
                    p[jj] = e; lsum += e; }
                Pf[t2][0] = __builtin_bit_cast(bf16x8, pack8(&p[0])); Pf[t2][1] = __builtin_bit_cast(bf16x8, pack8(&p[8])); }
#pragma unroll
            for (int mt = 0; mt < 2; ++mt)
#pragma unroll
                for (int t2 = 0; t2 < 2; ++t2)
#pragma unroll
                    for (int s2 = 0; s2 < 2; ++s2)
                        oa[mt] = __builtin_amdgcn_mfma_f32_32x32x16_bf16(*(const LAS bf16x8*)(cur + 13312 + (32 * mt + r) * 144 + (32 * t2 + 16 * s2 + 8 * hh) * 2), Pf[t2][s2], oa[mt], 0, 0, 0);
        }
        if (kt + 1 < ntiles) { *(LAS u32x4*)(nxt + kp0row * 208 + kp0c * 16) = k0; if (tid < 256) *(LAS u32x4*)(nxt + kp1row * 208 + kp1c * 16) = k1;
            *(LAS u32x4*)(nxt + 13312 + vrow * 144 + vc * 16) = vv; }
        __syncthreads();
    }
    lsum += __shfl_xor(lsum, 32);
    if (w.qvalid && w.mylast >= 0) { const float inv = 1.f / lsum; bf16_t* op = (bf16_t*)(a.ws + WS_OMLA) + (size_t)w.qrow * 512 + head * 64 + 4 * hh;
#pragma unroll
        for (int mt = 0; mt < 2; ++mt)
#pragma unroll
            for (int q4 = 0; q4 < 4; ++q4) { u32x2 o; o.x = cvt_pk_bf16(oa[mt][4 * q4] * inv, oa[mt][4 * q4 + 1] * inv); o.y = cvt_pk_bf16(oa[mt][4 * q4 + 2] * inv, oa[mt][4 * q4 + 3] * inv);
                *(u32x2*)(op + 32 * mt + 8 * q4) = o; } }
}
__device__ __forceinline__ void attn_phase(const Args& a, LAS unsigned char* lds, int tid, int lane, int wave) {
    const int c = blockIdx.x, G = gridDim.x;
    float mq = fabsf(a.in[I_QHG][lane]), mk = fabsf(a.in[I_KHG][lane]);
    if (lane < 32) { mq = fmaxf(mq, fabsf(a.in[I_QHG][64 + lane])); mk = fmaxf(mk, fabsf(a.in[I_KHG][64 + lane])); }
    const float boff = 9.797958971132712f * wave_max(mq) * wave_max(mk) * 1.4426950408889634f;
    const bf16_t* Kbuf = (const bf16_t*)(a.ws + WS_KBUF); const bf16_t* VT = (const bf16_t*)(a.ws + WS_VT);
    for (int p = c; p < 256; p += G) { const int bh = p >> 2, b = bh >> 3, h = bh & 7;
#pragma unroll 1
        for (int half = 0; half < 2; ++half) { const int qb = half ? 7 - (p & 3) : (p & 3);
            AttnWave w; w.pos = 256 * qb + 32 * wave + (lane & 31); w.qrow = b * SP + w.pos; w.mylast = 4 * qb + (wave >> 1); w.qvalid = true;
            attn_unit(a, lds, Kbuf + (size_t)b * SP * 768 + h * 96, VT + (size_t)bh * 64 * SP, SP, h, 4 * qb + 4, SP, w, boff, tid, lane); } }
    for (int u = (c + G / 2) % G; u < BS * 8; u += G) { const int s = u >> 3, h = u & 7;
        AttnWave w; w.pos = PAST + (lane & 15); w.qrow = MP + s * SS + (lane & 15); w.mylast = wave == 0 ? 32 : -1; w.qvalid = (lane & 31) < 16;
        attn_unit(a, lds, Kbuf + ((size_t)MP + (size_t)s * SKV) * 768 + h * 96, VT + VT_SAMPLE_OFF + (size_t)u * 64 * SKV, SKV, h, 33, SKV, w, boff, tid, lane); }
}

__global__ void __launch_bounds__(512, 2) mk_fwd(Args a) {
    extern __shared__ __attribute__((aligned(16))) unsigned char lds_raw[];
    LAS unsigned char* lds = (LAS unsigned char*)lds_raw;
    const int tid = threadIdx.x, lane = tid & 63, wave = __builtin_amdgcn_readfirstlane(tid >> 6);
    const int c = blockIdx.x, G = gridDim.x, gw = c * 8 + wave;
    unsigned char* ws = a.ws;
    const int lo = a.ph_lo, hi = a.ph_hi;
#define IN(k) (((MK_PHMASK >> (k)) & 1) && lo <= (k) && (k) < hi)
#if MK_SPLIT
#define SEAM(k) do { } while (0)
#else
#define SEAM(k) do { if (IN(k) && IN((k) + 1)) { __threadfence(); cg::this_grid().sync(); } } while (0)
#endif
    const bf16_t* H = (const bf16_t*)(ws + WS_H);
    float* mod = (float*)(ws + WS_MOD);
    if (IN(0)) phase0(a, lds, tid, lane, wave);
    SEAM(0);
    if (IN(1)) norm_rows(a.in[I_XP], a.in[I_XS], a.in[I_N1G], mod, 0, 1024, (bf16_t*)(ws + WS_H), gw, lane);
    SEAM(1);
    if (IN(2)) { pg8::Gemm g{{H, H}, {(const bf16_t*)(ws + WS_WIN), nullptr}, 1024, 1024, 1024}; pg8::StaticOrder S; S.init(MR / 256, NINP / 256, G, c);
        EpiProj E{(bf16_t*)(ws + WS_GQKV), (bf16_t*)(ws + WS_Z), (bf16_t*)a.out, (bf16_t*)(ws + WS_CKVRAW), (bf16_t*)(ws + WS_CQ), (float*)(ws + WS_KRRAW), (float*)(ws + WS_AB)};
        pg8::gemm_phase(lds, g, S, E); }
    SEAM(2);
    if (IN(3)) { gdn_prep(a, lds, tid); mla_rows(a, gw, lane); misc_p3(a, tid); }
    SEAM(3);
    if (IN(4)) { for (int u = c; u < 192; u += G) { if (u < 64) scan_prompt(a, lds, u, tid, lane, wave); else gdn_sample(a, lds, u - 64, tid, lane, wave); __syncthreads(); } }
    SEAM(4);
    if (IN(5)) {
        { pg8::Gemm g{{(const bf16_t*)(ws + WS_CQ), nullptr}, {(const bf16_t*)(ws + WS_WUQ), nullptr}, 384, 384, 384}; pg8::StaticOrder S; S.init(MR / 256, 3, G, c);
          EpiBf16<0> E{(bf16_t*)(ws + WS_QRAW), 768}; pg8::gemm_phase(lds, g, S, E); }
        { pg8::Gemm g{{(const bf16_t*)(ws + WS_CKVROWS), nullptr}, {(const bf16_t*)(ws + WS_WUK), nullptr}, 256, 256, 256}; pg8::StaticOrder S; S.init(KR / 256, 2, G, (c + G - 195 % G) % G);
          EpiK E{(bf16_t*)(ws + WS_KBUF), a.in[I_KHG], a.out + O_KRP, a.out + O_KRS, a.in[I_CKR]}; pg8::gemm_phase(lds, g, S, E); }
        { pg8::Gemm g{{(const bf16_t*)(ws + WS_WUV), nullptr}, {(const bf16_t*)(ws + WS_CKVROWS), nullptr}, 256, 256, 256}; pg8::StaticOrder S; S.init(2, KR / 256, G, (c + G - 69 % G) % G);
          EpiVT E{(bf16_t*)(ws + WS_VT)}; pg8::gemm_phase(lds, g, S, E); }
    }
    SEAM(5);
    if (IN(6)) attn_phase(a, lds, tid, lane, wave);
    SEAM(6);
    if (IN(7)) { pg8::Gemm g{{(const bf16_t*)(ws + WS_Z), (const bf16_t*)(ws + WS_OMLA)}, {(const bf16_t*)(ws + WS_WGO), (const bf16_t*)(ws + WS_WMO)}, 512, 512, 512};
        pg8::DualOrder S; S.S.init(MR / 256, 4, G, c); EpiGate E{(bf16_t*)(ws + WS_MERGED), (const bf16_t*)a.out}; pg8::gemm_phase(lds, g, S, E); }
    SEAM(7);
    if (IN(8)) { pg8::Gemm g{{(const bf16_t*)(ws + WS_MERGED), nullptr}, {(const bf16_t*)(ws + WS_WO), nullptr}, 1024, 1024, 1024}; pg8::StaticOrder S; S.init(MR / 256, 4, G, c);
        EpiRes E{a.in[I_XP], a.in[I_XS], a.out, mod, 2048}; pg8::gemm_phase(lds, g, S, E); }
    SEAM(8);
    if (IN(9)) norm_rows(a.out, a.out + (size_t)MP * 1024, a.in[I_N2G], mod, 3072, 4096, (bf16_t*)(ws + WS_H), gw, lane);
    SEAM(9);
    if (IN(10)) { pg8::Gemm g{{H, nullptr}, {(const bf16_t*)(ws + WS_WF1), nullptr}, 1024, 1024, 1024}; pg8::StaticOrder S; S.init(MR / 256, 16, G, c);
        EpiBf16<1> E{(bf16_t*)(ws + WS_HID), DFF}; pg8::gemm_phase(lds, g, S, E); }
    SEAM(10);
    if (IN(11)) { pg8::Gemm g{{(const bf16_t*)(ws + WS_HID), nullptr}, {(const bf16_t*)(ws + WS_WF2), nullptr}, DFF, DFF, DFF}; pg8::StaticOrder S; S.init(MR / 256, 4, G, c);
        EpiRes E{a.out, a.out + (size_t)MP * 1024, a.out, mod, 5120}; pg8::gemm_phase(lds, g, S, E); }
#undef IN
#undef SEAM
}

extern "C" void kernel_launch(void* const* d_in, const int* in_sizes, int n_in, void* d_out, int out_size, void* d_ws, size_t ws_size, hipStream_t stream) {
    static int grid = 0;
    if (grid == 0) {
        int dev = 0, cus = 0, per_cu = 0;
        hipGetDevice(&dev); hipDeviceGetAttribute(&cus, hipDeviceAttributeMultiprocessorCount, dev);
        hipFuncSetAttribute((const void*)mk_fwd, hipFuncAttributeMaxDynamicSharedMemorySize, LDS_BYTES);
        hipOccupancyMaxActiveBlocksPerMultiprocessor(&per_cu, (const void*)mk_fwd, 512, LDS_BYTES);
        if (per_cu < 1) per_cu = 1;
        grid = cus * per_cu; if (grid > 256) grid = 256;
        (void)hipGetLastError();
    }
    hipMemsetAsync((char*)d_ws + WS_CTL, 0, 64 * KiB, stream);
    Args a{};
    for (int i = 0; i < 28; ++i) a.in[i] = (const float*)d_in[i];
    a.out = (float*)d_out; a.ws = (unsigned char*)d_ws;
#if MK_SPLIT
    for (int p = 0; p < NPHASE; ++p) { a.ph_lo = p; a.ph_hi = p + 1; hipLaunchKernelGGL(mk_fwd, dim3(grid), dim3(512), LDS_BYTES, stream, a); }
#else
    a.ph_lo = 0; a.ph_hi = NPHASE;
    void* args[] = {&a};
    hipError_t e = hipLaunchCooperativeKernel((const void*)mk_fwd, dim3(grid), dim3(512), args, LDS_BYTES, stream);
    if (e != hipSuccess) fprintf(stderr, "cooperative launch failed: %s (grid %d)\n", hipGetErrorString(e), grid);
#endif
}
```

```cpp
#include <hip/hip_runtime.h>
#include <hip/hip_cooperative_groups.h>
#include <cstdio>
#include <cstdint>
namespace cg = cooperative_groups;

#ifndef REP_GEMM
#define REP_GEMM 0x111111111111ull
#endif
#define REPK(k) ((int)((REP_GEMM >> (4 * (k))) & 15))
#ifndef MK_XSYNC
#define MK_XSYNC 0
#endif
#ifndef MK_PHMASK
#define MK_PHMASK 0xFFF
#endif
#ifndef MK_SPLIT
#define MK_SPLIT 0
#endif

#define LAS __attribute__((address_space(3)))
typedef unsigned short bf16_t;
typedef short bf16x8 __attribute__((ext_vector_type(8)));
typedef float f32x4 __attribute__((ext_vector_type(4)));
typedef float f32x2 __attribute__((ext_vector_type(2)));
typedef float f32x16 __attribute__((ext_vector_type(16)));
typedef unsigned u32x4 __attribute__((ext_vector_type(4)));
typedef unsigned u32x2 __attribute__((ext_vector_type(2)));

constexpr int DM = 1024, BP = 8, SP = 2048, BS = 16, SS = 16, PAST = 2048;
constexpr int MP = BP * SP, MS = BS * SS, MR = MP + MS;
constexpr int SKV = PAST + SS;
constexpr int KR = MP + BS * SKV;
constexpr int NIN = 4784, NINP = 4864;
constexpr int DFF = 4096;
constexpr float EPS = 1e-6f;

constexpr size_t O_Y = 0, O_CKVP = 17039360, O_KRP = 21233664, O_STP = 21757952, O_CVP = 22020096,
                 O_CKVS = 22056960, O_KRS = 22122496, O_STS = 22130688, O_CVS = 22654976;

constexpr size_t KiB = 1024, MiB = 1024 * 1024;
constexpr size_t WS_CTL = 0;
constexpr size_t WS_MOD = 64 * KiB;
constexpr size_t WS_ROPE = 640 * KiB;
constexpr size_t WS_WIN = 960 * KiB;
constexpr size_t WS_WUQ = WS_WIN + (size_t)NINP * 1024 * 2;
constexpr size_t WS_WUK = WS_WUQ + 768 * 384 * 2;
constexpr size_t WS_WUV = WS_WUK + 512 * 256 * 2;
constexpr size_t WS_WGO = WS_WUV + 512 * 256 * 2;
constexpr size_t WS_WMO = WS_WGO + 1024 * 512 * 2;
constexpr size_t WS_WO = WS_WMO + 1024 * 512 * 2;
constexpr size_t WS_WF1 = WS_WO + 1024 * 1024 * 2;
constexpr size_t WS_WF2 = WS_WF1 + (size_t)4096 * 1024 * 2;
constexpr size_t WS_WEND = WS_WF2 + (size_t)4096 * 1024 * 2;
static_assert(WS_WEND <= 32 * MiB, "weights region");
constexpr size_t WS_H = 32 * MiB;
constexpr size_t WS_CKVROWS = 32 * MiB;
constexpr size_t WS_OMLA = 32 * MiB;
constexpr size_t WS_GQKV = 64 * MiB + 512 * KiB;
constexpr size_t WS_VT = WS_GQKV;
constexpr size_t WS_Z = 113 * MiB + 256 * KiB;
constexpr size_t WS_CQ = 129 * MiB + 512 * KiB;
constexpr size_t WS_CKVRAW = WS_CQ + (size_t)MR * 384 * 2;
constexpr size_t WS_KRRAW = WS_CKVRAW + (size_t)MR * 256 * 2;
constexpr size_t WS_AB = WS_KRRAW + (size_t)MR * 32 * 4;
static_assert(WS_AB + (size_t)MR * 16 * 4 <= 153 * MiB, "small proj outputs");
constexpr size_t WS_PREP = 153 * MiB;
constexpr size_t REC_BYTES = 41024;
static_assert(WS_PREP + (size_t)2048 * REC_BYTES <= 256 * MiB, "prep region");
constexpr size_t WS_KBUF = 153 * MiB;
constexpr size_t WS_QRAW = WS_KBUF + (size_t)KR * 768 * 2;
static_assert(WS_QRAW + (size_t)MR * 768 * 2 <= 256 * MiB, "qraw");
constexpr size_t WS_MERGED = 153 * MiB;
constexpr size_t WS_HID = 64 * MiB + 512 * KiB;
static_assert(WS_HID + (size_t)MR * DFF * 2 <= 256 * MiB, "hid");
constexpr size_t VT_SAMPLE_OFF = (size_t)BP * 8 * 64 * SP;

constexpr int LDS_BYTES = 147456 + 64;
constexpr int CW_BAR = 4096;
constexpr int NPHASE = 12;

__device__ __forceinline__ unsigned cvt_pk_bf16(float lo, float hi) { unsigned r; asm volatile("v_cvt_pk_bf16_f32 %0, %1, %2" : "=v"(r) : "v"(lo), "v"(hi)); return r; }
__device__ __forceinline__ float bflo(unsigned u) { return __uint_as_float(u << 16); }
__device__ __forceinline__ float bfhi(unsigned u) { return __uint_as_float(u & 0xffff0000u); }
__device__ __forceinline__ float bf2f(bf16_t b) { return __uint_as_float((unsigned)b << 16); }
__device__ __forceinline__ bf16_t f2bf(float f) { return (bf16_t)(cvt_pk_bf16(f, 0.f) & 0xffffu); }
__device__ __forceinline__ float wave_sum(float v) {
#pragma unroll
    for (int o = 1; o < 64; o <<= 1) v += __shfl_xor(v, o);
    return v;
}
__device__ __forceinline__ float wave_max(float v) {
#pragma unroll
    for (int o = 1; o < 64; o <<= 1) v = fmaxf(v, __shfl_xor(v, o));
    return v;
}
__device__ __forceinline__ float sigmoidf_(float x) { return 1.f / (1.f + __expf(-x)); }
__device__ __forceinline__ float siluf_(float x) { return x / (1.f + __expf(-x)); }
__device__ __forceinline__ u32x4 pack8(const float* v) { u32x4 w; w.x = cvt_pk_bf16(v[0], v[1]); w.y = cvt_pk_bf16(v[2], v[3]); w.z = cvt_pk_bf16(v[4], v[5]); w.w = cvt_pk_bf16(v[6], v[7]); return w; }
__device__ __forceinline__ int mod_row(int r) { return r < MP ? (r >> 11) : 8 + ((r - MP) >> 4); }

namespace pg8 {
constexpr int BM = 256, BK = 64, HALF = 128, HTB = HALF * BK * 2, STAGE_BYTES = 8 * HTB, NXCD = 8, WGM = 8;
__host__ __device__ __forceinline__ int lds_byte(int r, int c) { const int st = (r >> 4) * 2 + (c >> 5), rr = r & 15, cc = c & 31, ob = rr * 64 + cc * 2; return st * 1024 + (ob ^ (((ob >> 9) & 1) << 5)); }
__host__ __device__ __forceinline__ void stage_rc(int b, int& R, int& C) { const int st = b / 1024, sb = b % 1024, swz = sb ^ (((sb >> 9) & 1) << 5); R = (st >> 1) * 16 + swz / 64; C = (st & 1) * 32 + (swz % 64) / 2; }
__host__ __device__ __forceinline__ int perm32(int rho) { const int n = rho >> 4, i = rho & 15; return 8 * (i >> 2) + 4 * n + (i & 3); }

struct Unit { int pm, pn, sel; };
struct Gemm { const bf16_t* A[2]; const bf16_t* Bt[2]; int lda, ldb, K; };

struct StaticOrder {
    int nM, nN, nwg, G, c, rep;
    __device__ void init(int nM_, int nN_, int G_, int c_, int rep_ = 1) { nM = nM_; nN = nN_; nwg = nM * nN; G = G_; c = c_; rep = rep_; }
    __device__ bool next(int i, Unit& u) const {
        const long L = (long)(i / rep) * G + c; if (L >= nwg) return false;
        int wgid = (int)L; { const int q = nwg / NXCD, r = nwg % NXCD, xcd = wgid % NXCD, off = wgid / NXCD; wgid = (xcd < r ? xcd * (q + 1) : r * (q + 1) + (xcd - r) * q) + off; }
        const int nig = WGM * nN, gid = wgid / nig, fm = gid * WGM, gsz = (nM - fm) < WGM ? (nM - fm) : WGM;
        u.pm = fm + ((wgid % nig) % gsz); u.pn = (wgid % nig) / gsz; u.sel = 0; return true;
    }
};
struct DualOrder {
    StaticOrder S;
    __device__ bool next(int i, Unit& u) const { const bool ok = S.next(i >> 1, u); u.sel = i & 1; return ok; }
};

template <class Epi, class Sched>
__device__ __forceinline__ void gemm_phase(LAS unsigned char* lds, const Gemm g, const Sched& S, const Epi& E) {
    const int tid = threadIdx.x, wid = __builtin_amdgcn_readfirstlane(tid >> 6), lane = tid & 63, wr = wid >> 2, wc = wid & 3, fr = lane & 15, fq = lane >> 4;
    const int K = g.K, nt = K / BK;
    unsigned voffA[2], voffB[2];
#pragma unroll
    for (int i = 0; i < 2; ++i) { int R, C; stage_rc(tid * 16 + i * 8192, R, C); const int Rb = Epi::PERM ? ((R & ~31) + perm32(R & 31)) : R;
        voffA[i] = (unsigned)(R * g.lda + C) * 2u; voffB[i] = (unsigned)(Rb * g.ldb + C) * 2u; }
    const size_t kstep = (size_t)(BK * 2);
    const size_t hstepA = (size_t)HALF * g.lda * 2, hstepB = (size_t)HALF * g.ldb * 2;
    const size_t tstepA = 2 * hstepA, tstepB = 2 * hstepB;
    const unsigned ldsw = (unsigned)wid * 1024u;
    const int aoff = lds_byte(wr * 64 + fr, fq * 8), boff = lds_byte(wc * 32 + fr, fq * 8);
#define PG8_SA(b, h) (((b) * 2 + (h)) * HTB)
#define PG8_SB(b, h) ((4 + (b) * 2 + (h)) * HTB)
#define PG8_STAGE(bufoff, gbase, voff) do { _Pragma("unroll") for (int _i = 0; _i < 2; ++_i) \
        __builtin_amdgcn_global_load_lds((const unsigned*)((const char*)(gbase) + (voff)[_i]), (LAS unsigned*)(lds + (bufoff) + ldsw + _i * 8192), 16, 0, 0); } while (0)
#define PG8_LDA(dst, b, h) do { _Pragma("unroll") for (int m = 0; m < 4; ++m) _Pragma("unroll") for (int k = 0; k < 2; ++k) dst[m][k] = *(const LAS bf16x8*)(lds + PG8_SA(b, h) + aoff + m * 2048 + k * 1024); } while (0)
#define PG8_LDB(dst, b, h) do { _Pragma("unroll") for (int n = 0; n < 2; ++n) _Pragma("unroll") for (int k = 0; k < 2; ++k) dst[n][k] = *(const LAS bf16x8*)(lds + PG8_SB(b, h) + boff + n * 2048 + k * 1024); } while (0)
#define PG8_MMA(ai, bj, At, Bt) do { __builtin_amdgcn_s_setprio(1); _Pragma("unroll") for (int m = 0; m < 4; ++m) _Pragma("unroll") for (int n = 0; n < 2; ++n) _Pragma("unroll") for (int k = 0; k < 2; ++k) \
        acc[ai][bj][m][n] = __builtin_amdgcn_mfma_f32_16x16x32_bf16(Bt[n][k], At[m][k], acc[ai][bj][m][n], 0, 0, 0); __builtin_amdgcn_s_setprio(0); } while (0)
#define PG8_WAIT_V(n) asm volatile("s_waitcnt vmcnt(" #n ")" ::: "memory")
#define PG8_WAIT_L(n) asm volatile("s_waitcnt lgkmcnt(" #n ")" ::: "memory")
#define PG8_BAR __builtin_amdgcn_s_barrier()
#define PG8_SCHED __builtin_amdgcn_sched_barrier(0)
    Unit cur, nxt; int ui = 0;
    if (!S.next(0, cur)) return;
    f32x4 acc[2][2][4][2];
#pragma unroll
    for (int a = 0; a < 2; ++a)
#pragma unroll
        for (int b = 0; b < 2; ++b)
#pragma unroll
            for (int m = 0; m < 4; ++m)
#pragma unroll
                for (int n = 0; n < 2; ++n) acc[a][b][m][n] = (f32x4){0.f, 0.f, 0.f, 0.f};
    bf16x8 At[4][2], B0[2][2], B1[2][2];
    const char* cA = (const char*)(cur.sel ? g.A[1] : g.A[0]) + (size_t)cur.pm * tstepA; const char* cB = (const char*)(cur.sel ? g.Bt[1] : g.Bt[0]) + (size_t)cur.pn * tstepB;
    PG8_STAGE(PG8_SB(0, 0), cB, voffB); PG8_STAGE(PG8_SB(0, 1), cB + hstepB, voffB); PG8_STAGE(PG8_SA(0, 0), cA, voffA); PG8_STAGE(PG8_SA(0, 1), cA + hstepA, voffA);
    if (wr == 1) PG8_BAR;
    PG8_WAIT_V(2); PG8_BAR;
    PG8_STAGE(PG8_SB(1, 0), cB + kstep, voffB); PG8_STAGE(PG8_SA(1, 0), cA + kstep, voffA); PG8_STAGE(PG8_SB(1, 1), cB + hstepB + kstep, voffB);
    PG8_WAIT_V(6); PG8_BAR;
    for (;;) {
        const bool has_next = S.next(ui + 1, nxt);
        const char* nA = has_next ? (const char*)(nxt.sel ? g.A[1] : g.A[0]) + (size_t)nxt.pm * tstepA : cA; const char* nB = has_next ? (const char*)(nxt.sel ? g.Bt[1] : g.Bt[0]) + (size_t)nxt.pn * tstepB : cB;
#pragma unroll 1
        for (int t = 0; t < nt; t += 2) {
            const bool last = (t == nt - 2);
            const char* a1 = cA + (size_t)(t + 1) * kstep;
            const char* a2 = last ? nA : cA + (size_t)(t + 2) * kstep; const char* b2 = last ? nB : cB + (size_t)(t + 2) * kstep;
            const char* a3 = a2 + kstep; const char* b3 = b2 + kstep;
            PG8_LDB(B0, 0, 0); PG8_LDB(B1, 0, 1); PG8_SCHED; PG8_LDA(At, 0, 0); PG8_STAGE(PG8_SA(1, 1), a1 + hstepA, voffA);
            PG8_WAIT_V(8); PG8_WAIT_L(0); PG8_BAR; PG8_MMA(0, 0, At, B0); PG8_MMA(0, 1, At, B1); PG8_BAR; PG8_SCHED;
            PG8_LDA(At, 0, 1); PG8_STAGE(PG8_SB(0, 0), b2, voffB); PG8_STAGE(PG8_SB(0, 1), b2 + hstepB, voffB); PG8_STAGE(PG8_SA(0, 0), a2, voffA);
            PG8_WAIT_V(8); PG8_WAIT_L(0); PG8_BAR; PG8_MMA(1, 0, At, B0); PG8_MMA(1, 1, At, B1); PG8_BAR; PG8_SCHED;
            PG8_LDB(B0, 1, 0); PG8_LDB(B1, 1, 1); PG8_SCHED; PG8_LDA(At, 1, 0); PG8_STAGE(PG8_SA(0, 1), a2 + hstepA, voffA);
            PG8_WAIT_V(8); PG8_WAIT_L(0); PG8_BAR; PG8_MMA(0, 0, At, B0); PG8_MMA(0, 1, At, B1); PG8_BAR; PG8_SCHED;
            PG8_LDA(At, 1, 1); PG8_STAGE(PG8_SB(1, 0), b3, voffB); PG8_STAGE(PG8_SB(1, 1), b3 + hstepB, voffB); PG8_STAGE(PG8_SA(1, 0), a3, voffA);
            PG8_WAIT_V(8); PG8_WAIT_L(0); PG8_BAR; PG8_MMA(1, 0, At, B0); PG8_MMA(1, 1, At, B1); PG8_BAR; PG8_SCHED;
        }
        if (wr == 0) PG8_BAR;
        E(acc, cur, wr, wc, fr, fq);
        if (!has_next) break;
#pragma unroll
        for (int a = 0; a < 2; ++a)
#pragma unroll
            for (int b = 0; b < 2; ++b)
#pragma unroll
                for (int m = 0; m < 4; ++m)
#pragma unroll
                    for (int n = 0; n < 2; ++n) acc[a][b][m][n] = (f32x4){0.f, 0.f, 0.f, 0.f};
        cur = nxt; cA = nA; cB = nB; ++ui;
        if (wr == 1) PG8_BAR;
    }
    PG8_WAIT_V(0);
    PG8_BAR;
#undef PG8_SA
#undef PG8_SB
#undef PG8_STAGE
#undef PG8_LDA
#undef PG8_LDB
#undef PG8_MMA
#undef PG8_WAIT_V
#undef PG8_WAIT_L
#undef PG8_BAR
#undef PG8_SCHED
}
}
using pg8::Unit;

#define EPI_ARGS const f32x4 (&acc)[2][2][4][2], const Unit& u, int wr, int wc, int fr, int fq
__device__ __forceinline__ u32x4 pack_v(const f32x4 v0, const f32x4 v1) { u32x4 w; w.x = cvt_pk_bf16(v0[0], v0[1]); w.y = cvt_pk_bf16(v0[2], v0[3]); w.z = cvt_pk_bf16(v1[0], v1[1]); w.w = cvt_pk_bf16(v1[2], v1[3]); return w; }

struct EpiProj {
    static constexpr bool PERM = true;
    bf16_t *gqkv, *z, *gl, *ckvraw, *cq; float *krraw, *ab;
    __device__ __forceinline__ void operator()(EPI_ARGS) const {
        const int pn = u.pn; bf16_t* base; int pitch;
        if (pn < 6) { base = gqkv + pn * 256; pitch = 1536; } else if (pn < 8) { base = z + (pn - 6) * 256; pitch = 512; }
        else if (pn < 16) { base = gl + (pn - 8) * 256; pitch = 2048; } else if (pn == 16) { base = ckvraw; pitch = 256; }
        else if (pn == 17) { base = cq; pitch = 384; } else { base = cq + 256; pitch = 384; }
#pragma unroll
        for (int ai = 0; ai < 2; ++ai)
#pragma unroll
            for (int m = 0; m < 4; ++m) { const size_t row = (size_t)u.pm * 256 + ai * 128 + wr * 64 + m * 16 + fr;
#pragma unroll
                for (int bj = 0; bj < 2; ++bj) { const int ct = bj * 128 + wc * 32 + 8 * fq; const f32x4 v0 = acc[ai][bj][m][0], v1 = acc[ai][bj][m][1];
                    if (pn < 18 || bj == 0) { *(u32x4*)(base + row * pitch + ct) = pack_v(v0, v1); }
                    else if (wc == 0) { float* d = krraw + row * 32 + 8 * fq; *(f32x4*)d = v0; *(f32x4*)(d + 4) = v1; }
                    else if (wc == 1 && fq < 2) { float* d = ab + row * 16 + 8 * fq; *(f32x4*)d = v0; *(f32x4*)(d + 4) = v1; }
                } }
    }
};
template <int ACT> struct EpiBf16 {
    static constexpr bool PERM = true;
    bf16_t* O; int ldc;
    __device__ __forceinline__ void operator()(EPI_ARGS) const {
#pragma unroll
        for (int ai = 0; ai < 2; ++ai)
#pragma unroll
            for (int m = 0; m < 4; ++m) { const size_t row = (size_t)u.pm * 256 + ai * 128 + wr * 64 + m * 16 + fr;
#pragma unroll
                for (int bj = 0; bj < 2; ++bj) { const int col = u.pn * 256 + bj * 128 + wc * 32 + 8 * fq; f32x4 v0 = acc[ai][bj][m][0], v1 = acc[ai][bj][m][1];
                    if (ACT == 1) {
#pragma unroll
                        for (int e = 0; e < 4; ++e) { const float a = fmaxf(v0[e], 0.f), b = fmaxf(v1[e], 0.f); v0[e] = a * a; v1[e] = b * b; } }
                    *(u32x4*)(O + row * ldc + col) = pack_v(v0, v1); } }
    }
};
struct EpiK {
    static constexpr bool PERM = true;
    bf16_t* K; const float *gk, *krp, *krs, *krcache;
    __device__ __forceinline__ void operator()(EPI_ARGS) const {
        const int head = u.pn * 4 + wc;
        float g0[8], g1[8], g2[8];
#pragma unroll
        for (int e = 0; e < 8; ++e) { g0[e] = gk[8 * fq + e]; g1[e] = gk[32 + 8 * fq + e]; g2[e] = gk[64 + 8 * fq + e]; }
#pragma unroll
        for (int ai = 0; ai < 2; ++ai)
#pragma unroll
            for (int m = 0; m < 4; ++m) { const int R = u.pm * 256 + ai * 128 + wr * 64 + m * 16 + fr;
                const float* kr;
                if (R < MP) kr = krp + (size_t)R * 32;
                else { const int q = R - MP, s = q / SKV, j = q - s * SKV; kr = j < PAST ? krcache + ((size_t)s * PAST + j) * 32 : krs + ((size_t)s * SS + (j - PAST)) * 32; }
                const f32x4 r0 = *(const f32x4*)(kr + 8 * fq), r1 = *(const f32x4*)(kr + 8 * fq + 4);
                const f32x4 a0 = acc[ai][0][m][0], a1 = acc[ai][0][m][1], b0 = acc[ai][1][m][0], b1 = acc[ai][1][m][1];
                float ss = 0.f;
#pragma unroll
                for (int e = 0; e < 4; ++e) ss += a0[e] * a0[e] + a1[e] * a1[e] + b0[e] * b0[e] + b1[e] * b1[e] + r0[e] * r0[e] + r1[e] * r1[e];
                ss += __shfl_xor(ss, 16); ss += __shfl_xor(ss, 32);
                const float rs = rsqrtf(ss * (1.f / 96.f) + EPS);
                float o0[8], o1[8], o2[8];
#pragma unroll
                for (int e = 0; e < 4; ++e) { o0[e] = a0[e] * rs * g0[e]; o0[4 + e] = a1[e] * rs * g0[4 + e]; o1[e] = b0[e] * rs * g1[e]; o1[4 + e] = b1[e] * rs * g1[4 + e];
                    o2[e] = r0[e] * rs * g2[e]; o2[4 + e] = r1[e] * rs * g2[4 + e]; }
                bf16_t* d = K + (size_t)R * 768 + head * 96 + 8 * fq;
                *(u32x4*)d = pack8(o0); *(u32x4*)(d + 32) = pack8(o1); *(u32x4*)(d + 64) = pack8(o2); }
    }
};
struct EpiVT {
    static constexpr bool PERM = true;
    bf16_t* VT;
    __device__ __forceinline__ void operator()(EPI_ARGS) const {
        size_t coff[2]; int pitch[2];
#pragma unroll
        for (int bj = 0; bj < 2; ++bj) { const int R0 = u.pn * 256 + bj * 128 + wc * 32 + 8 * fq;
            if (R0 < MP) { coff[bj] = (size_t)(R0 >> 11) * 8 * 64 * SP + (R0 & 2047); pitch[bj] = SP; }
            else { const int q = R0 - MP, s = q / SKV, j = q - s * SKV; coff[bj] = VT_SAMPLE_OFF + (size_t)s * 8 * 64 * SKV + j; pitch[bj] = SKV; } }
#pragma unroll
        for (int ai = 0; ai < 2; ++ai)
#pragma unroll
            for (int m = 0; m < 4; ++m) { const int f = u.pm * 256 + ai * 128 + wr * 64 + m * 16 + fr;
#pragma unroll
                for (int bj = 0; bj < 2; ++bj) *(u32x4*)(VT + coff[bj] + (size_t)f * pitch[bj]) = pack_v(acc[ai][bj][m][0], acc[ai][bj][m][1]); }
    }
};
struct EpiGate {
    static constexpr bool PERM = true;
    bf16_t* merged; const bf16_t* gl;
    __device__ __forceinline__ void operator()(EPI_ARGS) const {
#pragma unroll
        for (int ai = 0; ai < 2; ++ai)
#pragma unroll
            for (int m = 0; m < 4; ++m) { const size_t row = (size_t)u.pm * 256 + ai * 128 + wr * 64 + m * 16 + fr;
#pragma unroll
                for (int bj = 0; bj < 2; ++bj) { const int col = u.pn * 256 + bj * 128 + wc * 32 + 8 * fq; const f32x4 v0 = acc[ai][bj][m][0], v1 = acc[ai][bj][m][1];
                    const u32x4 gw = *(const u32x4*)(gl + row * 2048 + u.sel * 1024 + col);
                    float o[8];
                    o[0] = sigmoidf_(bflo(gw.x)) * v0[0]; o[1] = sigmoidf_(bfhi(gw.x)) * v0[1]; o[2] = sigmoidf_(bflo(gw.y)) * v0[2]; o[3] = sigmoidf_(bfhi(gw.y)) * v0[3];
                    o[4] = sigmoidf_(bflo(gw.z)) * v1[0]; o[5] = sigmoidf_(bfhi(gw.z)) * v1[1]; o[6] = sigmoidf_(bflo(gw.w)) * v1[2]; o[7] = sigmoidf_(bfhi(gw.w)) * v1[3];
                    bf16_t* d = merged + row * 1024 + col;
                    if (u.sel) { const u32x4 t = *(const u32x4*)d;
                        o[0] += bflo(t.x); o[1] += bfhi(t.x); o[2] += bflo(t.y); o[3] += bfhi(t.y); o[4] += bflo(t.z); o[5] += bfhi(t.z); o[6] += bflo(t.w); o[7] += bfhi(t.w); }
                    *(u32x4*)d = pack8(o); } }
    }
};
struct EpiRes {
    static constexpr bool PERM = false;
    const float *bp, *bs; float* out; const float* mod; int goff;
    __device__ __forceinline__ void operator()(EPI_ARGS) const {
#pragma unroll
        for (int ai = 0; ai < 2; ++ai)
#pragma unroll
            for (int m = 0; m < 4; ++m) { const int row = u.pm * 256 + ai * 128 + wr * 64 + m * 16 + fr;
                const float* br = row < MP ? bp + (size_t)row * 1024 : bs + (size_t)(row - MP) * 1024; const float* gr = mod + mod_row(row) * 6144 + goff;
#pragma unroll
                for (int bj = 0; bj < 2; ++bj)
#pragma unroll
                    for (int n = 0; n < 2; ++n) { const int col = u.pn * 256 + bj * 128 + wc * 32 + 16 * n + 4 * fq;
                        const f32x4 b = *(const f32x4*)(br + col), gt = *(const f32x4*)(gr + col);
                        *(f32x4*)(out + (size_t)row * 1024 + col) = b + gt * acc[ai][bj][m][n]; } }
    }
};

struct Args { const float* in[28]; float* out; unsigned char* ws; int ph_lo, ph_hi; };
enum { I_XP = 0, I_XS, I_CP, I_CS, I_CKV, I_CKR, I_ST, I_CONV, I_ADAW, I_ADAB, I_N1G, I_WIN, I_CONVW, I_ALOG, I_DTB, I_GNG, I_WGO, I_QNG, I_WUQ, I_KVNG, I_WUKV,
       I_QHG, I_KHG, I_WMO, I_WO, I_N2G, I_WF1, I_WF2 };

__device__ __forceinline__ int colmap(int which, int n) {
    switch (which) {
    case 0:
        if (n < 2048) return n; if (n < 4096) return 2736 + (n - 2048); if (n < 4352) return 2448 + (n - 4096); if (n < 4736) return 2064 + (n - 4352);
        if (n < 4768) return 2704 + (n - 4736); if (n < 4776) return 2048 + (n - 4768); if (n < 4784) return 2056 + (n - 4776); return -1;
    case 2: { const int pn = n >> 8, bj = (n >> 7) & 1, wc = (n >> 5) & 3, j = n & 31; return (4 * pn + wc) * 128 + bj * 32 + j; }
    case 3: return (n >> 6) * 128 + 64 + (n & 63);
    default: return n;
    }
}
__device__ __forceinline__ void transpose_item(const float* W, int K, int N, bf16_t* WT, LAS float* scr, int nblk, int which, int item, int lane) {
    const int kb = item / nblk, nb = item - kb * nblk, k0 = 64 * kb, n0 = 32 * nb;
    const int sc = colmap(which, n0 + (lane & 31));
#pragma unroll 8
    for (int i = 0; i < 32; ++i) { const int kk = 2 * i + (lane >> 5); scr[kk * 33 + (lane & 31)] = sc >= 0 ? W[(size_t)(k0 + kk) * N + sc] : 0.f; }
    asm volatile("s_waitcnt lgkmcnt(0)" ::: "memory");
    const int c = lane & 7;
#pragma unroll
    for (int j = 0; j < 4; ++j) { const int n = (lane >> 3) + 8 * j; const LAS float* s = scr + (8 * c) * 33 + n;
        u32x4 o; o.x = cvt_pk_bf16(s[0 * 33], s[1 * 33]); o.y = cvt_pk_bf16(s[2 * 33], s[3 * 33]); o.z = cvt_pk_bf16(s[4 * 33], s[5 * 33]); o.w = cvt_pk_bf16(s[6 * 33], s[7 * 33]);
        *(u32x4*)(WT + (size_t)(n0 + n) * K + k0 + 8 * c) = o; }
    asm volatile("s_waitcnt lgkmcnt(0)" ::: "memory");
}
__device__ __forceinline__ void phase0(const Args& a, LAS unsigned char* lds, int tid, int lane, int wave) {
    unsigned char* ws = a.ws;
    for (int idx = blockIdx.x * 512 + tid; idx < SKV * 16; idx += gridDim.x * 512) {
        const int pos = idx >> 4, i = idx & 15;
        const float inv = exp2f(-(float)i * (13.287712379549449f / 16.f));
        const float ang = (float)pos * inv;
        double t = (double)ang * 0.15915494309189535; t -= floor(t);
        const float rev = (float)t;
        ((f32x2*)(ws + WS_ROPE))[idx] = (f32x2){__builtin_amdgcn_cosf(rev), __builtin_amdgcn_sinf(rev)};
    }
    if (blockIdx.x < 96) {
        LAS float* sc = (LAS float*)lds;
        LAS float* red = (LAS float*)(lds + 98304);
        for (int i = tid; i < 24 * 1024; i += 512) { const int r = i >> 10, k = i & 1023; const float v = r < 8 ? a.in[I_CP][r * 1024 + k] : a.in[I_CS][(r - 8) * 1024 + k]; sc[i] = siluf_(v); }
        __syncthreads();
        const int col = blockIdx.x * 64 + lane; const float* wp = a.in[I_ADAW] + (size_t)(wave * 128) * 6144 + col;
        float acc[24];
#pragma unroll
        for (int r = 0; r < 24; ++r) acc[r] = 0.f;
        for (int k4 = 0; k4 < 32; ++k4) {
            const float w0 = wp[(size_t)(4 * k4) * 6144], w1 = wp[(size_t)(4 * k4 + 1) * 6144], w2 = wp[(size_t)(4 * k4 + 2) * 6144], w3 = wp[(size_t)(4 * k4 + 3) * 6144];
#pragma unroll
            for (int r = 0; r < 24; ++r) { const f32x4 s = *(const LAS f32x4*)(sc + r * 1024 + wave * 128 + 4 * k4); acc[r] += s[0] * w0 + s[1] * w1 + s[2] * w2 + s[3] * w3; }
        }
#pragma unroll
        for (int r = 0; r < 24; ++r) red[(wave * 24 + r) * 64 + lane] = acc[r];
        __syncthreads();
        for (int i = tid; i < 24 * 64; i += 512) { const int r = i >> 6, c = i & 63; float s = a.in[I_ADAB][blockIdx.x * 64 + c];
#pragma unroll
            for (int w = 0; w < 8; ++w) s += red[(w * 24 + r) * 64 + c];
            ((float*)(ws + WS_MOD))[r * 6144 + blockIdx.x * 64 + c] = s; }
        __syncthreads();
    }
    LAS float* scr = (LAS float*)(lds + wave * 8448);
    constexpr int N0 = 16 * 152, N1 = 6 * 24, N2 = 4 * 16, N3 = 4 * 16, N4 = 8 * 32, N5 = 8 * 32, N6 = 16 * 32, N7 = 16 * 128, N8 = 64 * 32;
    constexpr int NT = N0 + N1 + N2 + N3 + N4 + N5 + N6 + N7 + N8;
    const int G = gridDim.x, vw = G > 96 ? ((int)blockIdx.x - 96) * 8 + wave : (int)blockIdx.x * 8 + wave, NW = G > 96 ? (G - 96) * 8 : G * 8;
    if (vw >= 0)
#pragma unroll 1
    for (int it0 = vw; it0 < NT * REPK(0); it0 += NW) {
        int it = it0 % NT;
        if (it < N0) { transpose_item(a.in[I_WIN], 1024, NIN, (bf16_t*)(ws + WS_WIN), scr, 152, 0, it, lane); continue; } it -= N0;
        if (it < N1) { transpose_item(a.in[I_WUQ], 384, 768, (bf16_t*)(ws + WS_WUQ), scr, 24, 1, it, lane); continue; } it -= N1;
        if (it < N2) { transpose_item(a.in[I_WUKV], 256, 1024, (bf16_t*)(ws + WS_WUK), scr, 16, 2, it, lane); continue; } it -= N2;
        if (it < N3) { transpose_item(a.in[I_WUKV], 256, 1024, (bf16_t*)(ws + WS_WUV), scr, 16, 3, it, lane); continue; } it -= N3;
        if (it < N4) { transpose_item(a.in[I_WGO], 512, 1024, (bf16_t*)(ws + WS_WGO), scr, 32, 1, it, lane); continue; } it -= N4;
        if (it < N5) { transpose_item(a.in[I_WMO], 512, 1024, (bf16_t*)(ws + WS_WMO), scr, 32, 1, it, lane); continue; } it -= N5;
        if (it < N6) { transpose_item(a.in[I_WO], 1024, 1024, (bf16_t*)(ws + WS_WO), scr, 32, 1, it, lane); continue; } it -= N6;
        if (it < N7) { transpose_item(a.in[I_WF1], 1024, 4096, (bf16_t*)(ws + WS_WF1), scr, 128, 1, it, lane); continue; } it -= N7;
        transpose_item(a.in[I_WF2], 4096, 1024, (bf16_t*)(ws + WS_WF2), scr, 32, 1, it, lane);
    }
}

__device__ __forceinline__ void norm_rows(const float* xp, const float* xs, const float* g, const float* mod, int shift_off, int scale_off, bf16_t* out, int gw, int lane) {
    for (int r = gw; r < MR; r += 2048) {
        const float* xr = r < MP ? xp + (size_t)r * 1024 : xs + (size_t)(r - MP) * 1024;
        const float* mr = mod + mod_row(r) * 6144;
        f32x4 v[4]; float ss = 0.f;
#pragma unroll
        for (int j = 0; j < 4; ++j) { v[j] = *(const f32x4*)(xr + 4 * (lane + 64 * j)); ss += v[j][0] * v[j][0] + v[j][1] * v[j][1] + v[j][2] * v[j][2] + v[j][3] * v[j][3]; }
        const float rs = rsqrtf(wave_sum(ss) * (1.f / 1024.f) + EPS);
#pragma unroll
        for (int j = 0; j < 4; ++j) { const int col = 4 * (lane + 64 * j);
            const f32x4 gg = *(const f32x4*)(g + col), sc = *(const f32x4*)(mr + scale_off + col), sh = *(const f32x4*)(mr + shift_off + col);
            const f32x4 y = v[j] * rs * gg * (sc + 1.f) + sh;
            u32x2 w; w.x = cvt_pk_bf16(y[0], y[1]); w.y = cvt_pk_bf16(y[2], y[3]);
            *(u32x2*)(out + (size_t)r * 1024 + col) = w; }
    }
}

__device__ __forceinline__ void mla_rows(const Args& a, int gw, int lane) {
    unsigned char* ws = a.ws; float* out = a.out;
    bf16_t* cq = (bf16_t*)(ws + WS_CQ); const bf16_t* ckvraw = (const bf16_t*)(ws + WS_CKVRAW); const float* krraw = (const float*)(ws + WS_KRRAW);
    bf16_t* ckvrows = (bf16_t*)(ws + WS_CKVROWS); const f32x2* rope = (const f32x2*)(ws + WS_ROPE);
    for (int r = gw; r < MR; r += 2048) {
        { float v[8]; float ss = 0.f;
          if (lane < 48) { const u32x4 w = *(const u32x4*)(cq + (size_t)r * 384 + 8 * lane);
              v[0] = bflo(w.x); v[1] = bfhi(w.x); v[2] = bflo(w.y); v[3] = bfhi(w.y); v[4] = bflo(w.z); v[5] = bfhi(w.z); v[6] = bflo(w.w); v[7] = bfhi(w.w);
#pragma unroll
              for (int e = 0; e < 8; ++e) ss += v[e] * v[e]; }
          const float rs = rsqrtf(wave_sum(ss) * (1.f / 384.f) + EPS);
          if (lane < 48) {
#pragma unroll
              for (int e = 0; e < 8; ++e) v[e] = v[e] * rs * a.in[I_QNG][8 * lane + e];
              *(u32x4*)(cq + (size_t)r * 384 + 8 * lane) = pack8(v); } }
        { float v[8]; float ss = 0.f;
          if (lane < 32) { const u32x4 w = *(const u32x4*)(ckvraw + (size_t)r * 256 + 8 * lane);
              v[0] = bflo(w.x); v[1] = bfhi(w.x); v[2] = bflo(w.y); v[3] = bfhi(w.y); v[4] = bflo(w.z); v[5] = bfhi(w.z); v[6] = bflo(w.w); v[7] = bfhi(w.w);
#pragma unroll
              for (int e = 0; e < 8; ++e) ss += v[e] * v[e]; }
          const float rs = rsqrtf(wave_sum(ss) * (1.f / 256.f) + EPS);
          if (lane < 32) {
#pragma unroll
              for (int e = 0; e < 8; ++e) v[e] = v[e] * rs * a.in[I_KVNG][8 * lane + e];
              float* o = r < MP ? out + O_CKVP + (size_t)r * 256 : out + O_CKVS + (size_t)(r - MP) * 256;
              *(f32x4*)(o + 8 * lane) = (f32x4){v[0], v[1], v[2], v[3]}; *(f32x4*)(o + 8 * lane + 4) = (f32x4){v[4], v[5], v[6], v[7]};
              const size_t R = r < MP ? (size_t)r : (size_t)MP + (size_t)((r - MP) >> 4) * SKV + PAST + ((r - MP) & 15);
              *(u32x4*)(ckvrows + R * 256 + 8 * lane) = pack8(v); } }
        if (lane < 16) { const int pos = r < MP ? (r & 2047) : PAST + ((r - MP) & 15);
            const float x1 = krraw[(size_t)r * 32 + lane], x2 = krraw[(size_t)r * 32 + 16 + lane]; const f32x2 cs = rope[pos * 16 + lane];
            float* o = r < MP ? out + O_KRP + (size_t)r * 32 : out + O_KRS + (size_t)(r - MP) * 32;
            o[lane] = x1 * cs.x - x2 * cs.y; o[16 + lane] = x2 * cs.x + x1 * cs.y; }
    }
}

template <int I> struct SolveRow {
    static __device__ __forceinline__ void run(float (&x)[64], const LAS float* A, const LAS bf16_t* src, const LAS float* scp) {
        float s = scp[I] * bf2f(src[I * 72]);
#pragma unroll
        for (int j4 = 0; j4 < (I + 3) / 4; ++j4) { const f32x4 av = *(const LAS f32x4*)(A + I * 64 + 4 * j4);
#pragma unroll
            for (int e = 0; e < 4; ++e) if (4 * j4 + e < I) s -= av[e] * x[4 * j4 + e]; }
        x[I] = s;
        SolveRow<I + 1>::run(x, A, src, scp);
    }
};
template <> struct SolveRow<64> { static __device__ __forceinline__ void run(float (&)[64], const LAS float*, const LAS bf16_t*, const LAS float*) {} };

__device__ __forceinline__ void gdn_prep(const Args& a, LAS unsigned char* lds, int tid) {
    const int slot = tid >> 7, w2 = __builtin_amdgcn_readfirstlane((tid >> 6) & 1), lane = tid & 63;
    LAS unsigned char* sl = lds + slot * 35584;
    LAS bf16_t* q_lds = (LAS bf16_t*)sl; LAS float* A_lds = (LAS float*)sl;
    LAS bf16_t* k_lds = (LAS bf16_t*)(sl + 16384); LAS bf16_t* v_lds = (LAS bf16_t*)(sl + 25600);
    LAS float* gcs = (LAS float*)(sl + 34816); LAS float* bts = (LAS float*)(sl + 35072); LAS float* scw = (LAS float*)(sl + 35328);
    const bf16_t* gqkv = (const bf16_t*)(a.ws + WS_GQKV); const float* ab = (const float*)(a.ws + WS_AB); const float* cw = a.in[I_CONVW];
#pragma unroll 1
    for (int qi = blockIdx.x; qi < 512 * REPK(3); qi += gridDim.x) {
        const int item = (qi & 511) * 4 + slot, bh = item >> 5, n = item & 31, b = bh >> 3, h = bh & 7;
        const int r0 = b * SP + 64 * n, t = lane;
        unsigned char* rec = a.ws + WS_PREP + (size_t)item * REC_BYTES;
        LAS float* cwl = (LAS float*)(sl + 9216);
        for (int i = tid & 127; i < 768; i += 128) { const int tap = i / 192, cc = i - tap * 192; cwl[i] = cw[tap * 1536 + (cc >> 6) * 512 + h * 64 + (cc & 63)]; }
        __syncthreads();
        {
            const int colbase = w2 * 512 + h * 64;
            float o[64];
#pragma unroll
            for (int c = 0; c < 64; ++c) o[c] = 0.f;
#pragma unroll 1
            for (int tap = 0; tap < 4; ++tap) { const int rr = t - 3 + tap; const bool valid = (n > 0) || (rr >= 0);
                const bf16_t* src = gqkv + (size_t)(r0 + (valid ? rr : 0)) * 1536 + colbase;
#pragma unroll
                for (int c8 = 0; c8 < 8; ++c8) { u32x4 w = *(const u32x4*)(src + 8 * c8); if (!valid) w = (u32x4){0u, 0u, 0u, 0u};
                    const f32x4 wa = *(const LAS f32x4*)(cwl + tap * 192 + w2 * 64 + 8 * c8), wb = *(const LAS f32x4*)(cwl + tap * 192 + w2 * 64 + 8 * c8 + 4);
                    o[8 * c8 + 0] += wa[0] * bflo(w.x); o[8 * c8 + 1] += wa[1] * bfhi(w.x); o[8 * c8 + 2] += wa[2] * bflo(w.y); o[8 * c8 + 3] += wa[3] * bfhi(w.y);
                    o[8 * c8 + 4] += wb[0] * bflo(w.z); o[8 * c8 + 5] += wb[1] * bfhi(w.z); o[8 * c8 + 6] += wb[2] * bflo(w.w); o[8 * c8 + 7] += wb[3] * bfhi(w.w); } }
            float ss = 0.f;
#pragma unroll
            for (int c = 0; c < 64; ++c) { o[c] = siluf_(o[c]); ss += o[c] * o[c]; }
            const float sc = rsqrtf(ss + EPS) * (w2 ? 1.f : 0.125f);
            LAS bf16_t* dst = (w2 ? k_lds : q_lds) + t * 72;
#pragma unroll
            for (int c8 = 0; c8 < 8; ++c8) { float v[8];
#pragma unroll
                for (int e = 0; e < 8; ++e) v[e] = o[8 * c8 + e] * sc;
                *(LAS u32x4*)(dst + 8 * c8) = pack8(v); }
        }
        {
            const int colbase = 1024 + h * 64 + 32 * w2;
            float o[32];
#pragma unroll
            for (int c = 0; c < 32; ++c) o[c] = 0.f;
#pragma unroll 1
            for (int tap = 0; tap < 4; ++tap) { const int rr = t - 3 + tap; const bool valid = (n > 0) || (rr >= 0);
                const bf16_t* src = gqkv + (size_t)(r0 + (valid ? rr : 0)) * 1536 + colbase;
#pragma unroll
                for (int c8 = 0; c8 < 4; ++c8) { u32x4 w = *(const u32x4*)(src + 8 * c8); if (!valid) w = (u32x4){0u, 0u, 0u, 0u};
                    const f32x4 wa = *(const LAS f32x4*)(cwl + tap * 192 + 128 + 32 * w2 + 8 * c8), wb = *(const LAS f32x4*)(cwl + tap * 192 + 128 + 32 * w2 + 8 * c8 + 4);
                    o[8 * c8 + 0] += wa[0] * bflo(w.x); o[8 * c8 + 1] += wa[1] * bfhi(w.x); o[8 * c8 + 2] += wa[2] * bflo(w.y); o[8 * c8 + 3] += wa[3] * bfhi(w.y);
                    o[8 * c8 + 4] += wb[0] * bflo(w.z); o[8 * c8 + 5] += wb[1] * bfhi(w.z); o[8 * c8 + 6] += wb[2] * bflo(w.w); o[8 * c8 + 7] += wb[3] * bfhi(w.w); } }
#pragma unroll
            for (int c8 = 0; c8 < 4; ++c8) { float v[8];
#pragma unroll
                for (int e = 0; e < 8; ++e) v[e] = siluf_(o[8 * c8 + e]);
                *(LAS u32x4*)(v_lds + t * 72 + 32 * w2 + 8 * c8) = pack8(v); }
        }
        float gc, gcl;
        {
            const float av = ab[(size_t)(r0 + t) * 16 + h], bv = ab[(size_t)(r0 + t) * 16 + 8 + h];
            const float xg = av + a.in[I_DTB][h];
            const float sp = fmaxf(xg, 0.f) + __logf(1.f + __expf(-fabsf(xg)));
            gc = -__expf(a.in[I_ALOG][h]) * sp;
#pragma unroll
            for (int o = 1; o < 64; o <<= 1) { const float u = __shfl_up(gc, o); if (lane >= o) gc += u; }
            gcl = __shfl(gc, 63);
            if (w2 == 0) { const float be = sigmoidf_(bv); gcs[t] = gc; bts[t] = be; scw[t] = be * __expf(gc); if (lane == 0) *(float*)(rec + 40960) = __expf(gcl); }
        }
        __syncthreads();
#pragma unroll
        for (int it = 0; it < 8; ++it) { const int ri = (lane >> 3) + 8 * it, pg = lane & 7, d0 = 32 * (pg >> 2) + 4 * (pg & 3);
            float v[8];
            if (w2 == 0) { const u32x2 w0 = *(const LAS u32x2*)(q_lds + ri * 72 + d0), w1 = *(const LAS u32x2*)(q_lds + ri * 72 + d0 + 16); const float e = __expf(gcs[ri]);
                v[0] = bflo(w0.x) * e; v[1] = bfhi(w0.x) * e; v[2] = bflo(w0.y) * e; v[3] = bfhi(w0.y) * e; v[4] = bflo(w1.x) * e; v[5] = bfhi(w1.x) * e; v[6] = bflo(w1.y) * e; v[7] = bfhi(w1.y) * e;
                *(u32x4*)(rec + 8192 + (ri * 64 + 8 * pg) * 2) = pack8(v); }
            else {
#pragma unroll
                for (int j = 0; j < 8; ++j) { const int c = d0 + 16 * (j >> 2) + (j & 3); v[j] = bf2f(k_lds[c * 72 + ri]) * __expf(gcl - gcs[c]); }
                *(u32x4*)(rec + 24576 + (ri * 64 + 8 * pg) * 2) = pack8(v); } }
        const int m_ = lane & 15, g4 = lane >> 4;
        f32x4 acc[4][4];
        {
            bf16x8 ka[4][2], bb[4][2];
            const LAS bf16_t* bsrc = w2 ? k_lds : q_lds;
#pragma unroll
            for (int jt = 0; jt < 4; ++jt)
#pragma unroll
                for (int ks = 0; ks < 2; ++ks) { ka[jt][ks] = *(const LAS bf16x8*)(k_lds + (16 * jt + m_) * 72 + 32 * ks + 8 * g4); bb[jt][ks] = *(const LAS bf16x8*)(bsrc + (16 * jt + m_) * 72 + 32 * ks + 8 * g4); }
#pragma unroll
            for (int jt = 0; jt < 4; ++jt)
#pragma unroll
                for (int it = 0; it < 4; ++it) { f32x4 c = (f32x4){0.f, 0.f, 0.f, 0.f};
                    if (it >= jt) {
#pragma unroll
                        for (int ks = 0; ks < 2; ++ks) c = __builtin_amdgcn_mfma_f32_16x16x32_bf16(ka[jt][ks], bb[it][ks], c, 0, 0, 0); }
                    acc[jt][it] = c; }
        }
        __syncthreads();
#pragma unroll
        for (int jt = 0; jt < 4; ++jt)
#pragma unroll
            for (int it = 0; it < 4; ++it) { const int i = 16 * it + m_, j0 = 16 * jt + 4 * g4; const float gi = gcs[i]; const f32x4 gj = *(const LAS f32x4*)(gcs + j0);
                float v[4];
                if (w2 == 0) {
#pragma unroll
                    for (int e = 0; e < 4; ++e) { const bool keep = it > jt ? true : (it < jt ? false : m_ >= 4 * g4 + e); v[e] = keep ? acc[jt][it][e] * __expf(keep ? gi - gj[e] : 0.f) : 0.f; }
                    u32x2 w; w.x = cvt_pk_bf16(v[0], v[1]); w.y = cvt_pk_bf16(v[2], v[3]);
                    *(u32x2*)(rec + 16384 + (i * 64 + 32 * (jt >> 1) + 8 * g4 + 4 * (jt & 1)) * 2) = w; }
                else { const float bi = bts[i];
#pragma unroll
                    for (int e = 0; e < 4; ++e) { const bool keep = it > jt ? true : (it < jt ? false : m_ > 4 * g4 + e); v[e] = keep ? bi * acc[jt][it][e] * __expf(keep ? gi - gj[e] : 0.f) : 0.f; }
                    *(LAS f32x4*)(A_lds + i * 64 + j0) = (f32x4){v[0], v[1], v[2], v[3]}; } }
        __syncthreads();
        {
            const LAS bf16_t* src = w2 ? k_lds : v_lds; const LAS float* scp = w2 ? scw : bts;
            float x[64];
            SolveRow<0>::run(x, A_lds, src + lane, scp);
            if (w2 == 0) {
#pragma unroll
                for (int q = 0; q < 8; ++q) *(u32x4*)(rec + 32768 + (lane * 64 + 8 * q) * 2) = pack8(&x[8 * q]);
            } else { const int pinv = (lane & 32) | (((lane >> 2) & 3) << 3) | (((lane >> 4) & 1) << 2) | (lane & 3);
#pragma unroll
                for (int i = 0; i < 64; ++i) *(bf16_t*)(rec + (i * 64 + pinv) * 2) = f2bf(-x[i]); }
        }
        __syncthreads();
    }
}

__device__ __forceinline__ void misc_p3(const Args& a, int tid) {
    bf16_t* ckvrows = (bf16_t*)(a.ws + WS_CKVROWS); const float* cache = a.in[I_CKV];
    const int gt = blockIdx.x * 512 + tid, GT = gridDim.x * 512;
    for (int i = gt; i < BS * PAST * 32; i += GT) { const int row = i >> 5, c8 = i & 31, s = row >> 11, j = row & 2047;
        const f32x4 v0 = *(const f32x4*)(cache + (size_t)row * 256 + 8 * c8), v1 = *(const f32x4*)(cache + (size_t)row * 256 + 8 * c8 + 4);
        *(u32x4*)(ckvrows + ((size_t)MP + (size_t)s * SKV + j) * 256 + 8 * c8) = pack_v(v0, v1); }
    const bf16_t* gqkv = (const bf16_t*)(a.ws + WS_GQKV);
    for (int i = gt; i < BP * 3 * 1536; i += GT) { const int b = i / 4608, rem = i - b * 4608, r = rem / 1536, c = rem - r * 1536;
        a.out[O_CVP + i] = bf2f(gqkv[(size_t)(b * SP + SP - 3 + r) * 1536 + c]); }
    for (int i = gt; i < BS * 3 * 1536; i += GT) { const int s = i / 4608, rem = i - s * 4608, r = rem / 1536, c = rem - r * 1536;
        a.out[O_CVS + i] = bf2f(gqkv[(size_t)(MP + s * SS + SS - 3 + r) * 1536 + c]); }
}

__device__ __forceinline__ bf16x8 pack_frag(const f32x4 lo, const f32x4 hi) { u32x4 w = pack_v(lo, hi); return __builtin_bit_cast(bf16x8, w); }

__device__ __forceinline__ void scan_prompt(const Args& a, LAS unsigned char* lds, int bh, int tid, int lane, int wave, bool st) {
    const int b = bh >> 3, h = bh & 7;
    const unsigned char* recs = a.ws + WS_PREP + (size_t)bh * 32 * REC_BYTES;
    bf16_t* zo = (bf16_t*)(a.ws + WS_Z);
    LAS float* red = (LAS float*)(lds + 92160);
    const int prow = (tid & 511) >> 3, pc16 = tid & 7;
    const int n_ = lane & 15, g4 = lane >> 4, dv = 16 * wave + n_;
    f32x4 S[4];
#pragma unroll
    for (int kt = 0; kt < 4; ++kt) S[kt] = (f32x4){0.f, 0.f, 0.f, 0.f};
    const float gn = wave < 4 ? a.in[I_GNG][dv] : 0.f;
    { u32x4 p[5];
#pragma unroll
      for (int i = 0; i < 5; ++i) p[i] = *(const u32x4*)(recs + i * 8192 + tid * 16);
#pragma unroll
      for (int i = 0; i < 5; ++i) *(LAS u32x4*)(lds + i * 9216 + prow * 144 + pc16 * 16) = p[i]; }
    __syncthreads();
    for (int n = 0; n < 32; ++n) {
        LAS unsigned char* cur = lds + (n & 1) * 46080; LAS unsigned char* nxt = lds + ((n + 1) & 1) * 46080;
        u32x4 p[5];
        if (n + 1 < 32) {
#pragma unroll
            for (int i = 0; i < 5; ++i) p[i] = *(const u32x4*)(recs + (size_t)(n + 1) * REC_BYTES + i * 8192 + tid * 16); }
        f32x4 O[4];
        float zv[4][4];
        const size_t rowbase = (size_t)b * SP + 64 * n;
        if (wave < 4) {
#pragma unroll
            for (int mt = 0; mt < 4; ++mt)
#pragma unroll
                for (int e = 0; e < 4; ++e) zv[mt][e] = bf2f(zo[(rowbase + 16 * mt + 4 * g4 + e) * 512 + h * 64 + dv]);
            const float gl = *(const float*)(recs + (size_t)n * REC_BYTES + 40960);
            bf16x8 Bs[2];
            Bs[0] = pack_frag(S[0], S[1]); Bs[1] = pack_frag(S[2], S[3]);
            f32x4 VN[4];
#pragma unroll
            for (int mt = 0; mt < 4; ++mt) { const u32x2 w = *(const LAS u32x2*)(cur + 4 * 9216 + dv * 144 + (16 * mt + 4 * g4) * 2);
                f32x4 c = (f32x4){bflo(w.x), bfhi(w.x), bflo(w.y), bfhi(w.y)};
#pragma unroll
                for (int ks = 0; ks < 2; ++ks) c = __builtin_amdgcn_mfma_f32_16x16x32_bf16(*(const LAS bf16x8*)(cur + (16 * mt + n_) * 144 + (32 * ks + 8 * g4) * 2), Bs[ks], c, 0, 0, 0);
                VN[mt] = c;
                f32x4 o = (f32x4){0.f, 0.f, 0.f, 0.f};
#pragma unroll
                for (int ks = 0; ks < 2; ++ks) o = __builtin_amdgcn_mfma_f32_16x16x32_bf16(*(const LAS bf16x8*)(cur + 9216 + (16 * mt + n_) * 144 + (32 * ks + 8 * g4) * 2), Bs[ks], o, 0, 0, 0);
                O[mt] = o; }
            bf16x8 Bv[2];
            Bv[0] = pack_frag(VN[0], VN[1]); Bv[1] = pack_frag(VN[2], VN[3]);
#pragma unroll
            for (int mt = 0; mt < 4; ++mt) {
#pragma unroll
                for (int ks = 0; ks < 2; ++ks) O[mt] = __builtin_amdgcn_mfma_f32_16x16x32_bf16(*(const LAS bf16x8*)(cur + 2 * 9216 + (16 * mt + n_) * 144 + (32 * ks + 8 * g4) * 2), Bv[ks], O[mt], 0, 0, 0);
                f32x4 s = S[mt] * gl;
#pragma unroll
                for (int ks = 0; ks < 2; ++ks) s = __builtin_amdgcn_mfma_f32_16x16x32_bf16(*(const LAS bf16x8*)(cur + 3 * 9216 + (16 * mt + n_) * 144 + (32 * ks + 8 * g4) * 2), Bv[ks], s, 0, 0, 0);
                S[mt] = s; }
#pragma unroll
            for (int mt = 0; mt < 4; ++mt)
#pragma unroll
                for (int e = 0; e < 4; ++e) { float q = O[mt][e] * O[mt][e]; q += __shfl_xor(q, 1); q += __shfl_xor(q, 2); q += __shfl_xor(q, 4); q += __shfl_xor(q, 8);
                    if (n_ == 0) red[((n & 1) * 4 + wave) * 64 + 16 * mt + 4 * g4 + e] = q; }
        }
        if (n + 1 < 32) {
#pragma unroll
            for (int i = 0; i < 5; ++i) *(LAS u32x4*)(nxt + i * 9216 + prow * 144 + pc16 * 16) = p[i]; }
        __syncthreads();
        if (wave < 4) {
#pragma unroll
            for (int mt = 0; mt < 4; ++mt)
#pragma unroll
                for (int e = 0; e < 4; ++e) { const int c = 16 * mt + 4 * g4 + e; const LAS float* rp = red + (n & 1) * 256 + c;
                    const float ss = rp[0] + rp[64] + rp[128] + rp[192];
                    const float val = O[mt][e] * rsqrtf(ss * (1.f / 64.f) + EPS) * gn * siluf_(zv[mt][e]);
                    if (st) zo[(rowbase + c) * 512 + h * 64 + dv] = f2bf(val); }
        }
    }
    if (wave < 4 && st) { float* so = a.out + O_STP + (size_t)bh * 4096;
#pragma unroll
        for (int kt = 0; kt < 4; ++kt)
#pragma unroll
            for (int e = 0; e < 4; ++e) so[(16 * kt + 4 * g4 + e) * 64 + dv] = S[kt][e]; }
}

__device__ __forceinline__ void gdn_sample(const Args& a, LAS unsigned char* lds, int u, int tid, int lane, int wave, bool st) {
    const int s = u >> 3, h = u & 7;
    LAS float* raw = (LAS float*)lds;
    LAS float* qkv = raw + 19 * 192;
    LAS float* gs = qkv + 16 * 192;
    LAS float* pa = gs + 32;
    LAS float* pb = pa + 512;
    LAS float* ol = pb + 512;
    const bf16_t* gqkv = (const bf16_t*)(a.ws + WS_GQKV); const float* ab = (const float*)(a.ws + WS_AB);
    for (int i = tid; i < 19 * 192; i += 512) { const int r = i / 192, cc = i - r * 192, seg = cc >> 6, c = cc & 63, col = seg * 512 + h * 64 + c;
        raw[i] = r < 3 ? a.in[I_CONV][((size_t)s * 3 + r) * 1536 + col] : bf2f(gqkv[(size_t)(MP + s * SS + (r - 3)) * 1536 + col]); }
    if (tid < 16) { const size_t row = (size_t)MP + s * SS + tid; const float av = ab[row * 16 + h], bv = ab[row * 16 + 8 + h];
        const float xg = av + a.in[I_DTB][h]; const float sp = fmaxf(xg, 0.f) + __logf(1.f + __expf(-fabsf(xg)));
        gs[tid] = __expf(-__expf(a.in[I_ALOG][h]) * sp); gs[16 + tid] = sigmoidf_(bv); }
    __syncthreads();
    for (int i = tid; i < 16 * 192; i += 512) { const int t = i / 192, cc = i - t * 192, seg = cc >> 6, c = cc & 63, col = seg * 512 + h * 64 + c;
        float y = 0.f;
#pragma unroll
        for (int tap = 0; tap < 4; ++tap) y += a.in[I_CONVW][tap * 1536 + col] * raw[(t + tap) * 192 + cc];
        qkv[i] = siluf_(y); }
    __syncthreads();
    for (int v = wave; v < 32; v += 8) { const int t = v >> 1, seg = v & 1; const float x = qkv[t * 192 + seg * 64 + lane];
        const float ss = wave_sum(x * x); qkv[t * 192 + seg * 64 + lane] = x * rsqrtf(ss + EPS) * (seg ? 1.f : 0.125f); }
    __syncthreads();
    const int dv = tid & 63, dkg = tid >> 6;
    float S[8];
    const float* s0 = a.in[I_ST] + (size_t)u * 4096;
#pragma unroll
    for (int i = 0; i < 8; ++i) S[i] = s0[(8 * dkg + i) * 64 + dv];
    for (int t = 0; t < 16; ++t) {
        const float eg = gs[t], bt = gs[16 + t];
        const LAS float* qr = qkv + t * 192; const LAS float* kr = qr + 64; const float vv = qr[128 + dv];
        float part = 0.f;
#pragma unroll
        for (int i = 0; i < 8; ++i) { S[i] *= eg; part += kr[8 * dkg + i] * S[i]; }
        pa[dkg * 64 + dv] = part;
        __syncthreads();
        float ks = 0.f;
#pragma unroll
        for (int w = 0; w < 8; ++w) ks += pa[w * 64 + dv];
        const float dl = bt * (vv - ks);
        float po = 0.f;
#pragma unroll
        for (int i = 0; i < 8; ++i) { S[i] += kr[8 * dkg + i] * dl; po += qr[8 * dkg + i] * S[i]; }
        pb[dkg * 64 + dv] = po;
        __syncthreads();
        if (dkg == 0) { float o = 0.f;
#pragma unroll
            for (int w = 0; w < 8; ++w) o += pb[w * 64 + dv];
            ol[t * 64 + dv] = o; }
    }
    __syncthreads();
    float* so = a.out + O_STS + (size_t)u * 4096;
#pragma unroll
    for (int i = 0; i < 8; ++i) if (st) so[(8 * dkg + i) * 64 + dv] = S[i];
    bf16_t* zo = (bf16_t*)(a.ws + WS_Z);
    for (int t = wave; t < 16; t += 8) { const float o = ol[t * 64 + lane]; const float ss = wave_sum(o * o);
        const size_t idx = ((size_t)MP + s * SS + t) * 512 + h * 64 + lane;
        const bf16_t res = f2bf(o * rsqrtf(ss * (1.f / 64.f) + EPS) * a.in[I_GNG][lane] * siluf_(bf2f(zo[idx]))); if (st) zo[idx] = res; }
}

struct AttnWave { int qrow, pos, mylast; bool qvalid; };
__device__ __forceinline__ void attn_unit(const Args& a, LAS unsigned char* lds, const bf16_t* Kb, const bf16_t* VTb, int pitch, int head, int ntiles, int nkeys,
                                          const AttnWave w, float boff, int tid, int lane) {
    const int r = lane & 31, hh = lane >> 5;
    const bf16_t* qraw = (const bf16_t*)(a.ws + WS_QRAW); const f32x2* rope = (const f32x2*)(a.ws + WS_ROPE);
    bf16x8 Qf[6];
    {
        const bf16_t* qp = qraw + (size_t)w.qrow * 768 + head * 96 + 8 * hh;
        float v[6][8]; float ss = 0.f;
#pragma unroll
        for (int s = 0; s < 6; ++s) { const u32x4 u = *(const u32x4*)(qp + 16 * s);
            v[s][0] = bflo(u.x); v[s][1] = bfhi(u.x); v[s][2] = bflo(u.y); v[s][3] = bfhi(u.y); v[s][4] = bflo(u.z); v[s][5] = bfhi(u.z); v[s][6] = bflo(u.w); v[s][7] = bfhi(u.w); }
#pragma unroll
        for (int e = 0; e < 8; ++e) { const f32x2 cs = rope[w.pos * 16 + 8 * hh + e]; const float x1 = v[4][e], x2 = v[5][e]; v[4][e] = x1 * cs.x - x2 * cs.y; v[5][e] = x2 * cs.x + x1 * cs.y; }
#pragma unroll
        for (int s = 0; s < 6; ++s)
#pragma unroll
            for (int e = 0; e < 8; ++e) ss += v[s][e] * v[s][e];
        ss += __shfl_xor(ss, 32);
        const float rs = rsqrtf(ss * (1.f / 96.f) + EPS) * (1.4426950408889634f * 0.10206207261596575f);
#pragma unroll
        for (int s = 0; s < 6; ++s) { float o[8];
#pragma unroll
            for (int e = 0; e < 8; ++e) o[e] = v[s][e] * rs * a.in[I_QHG][16 * s + 8 * hh + e];
            Qf[s] = __builtin_bit_cast(bf16x8, pack8(o)); }
    }
    const int kp0row = tid / 12, kp0c = tid - kp0row * 12, kp1row = (tid + 512) / 12, kp1c = (tid + 512) - kp1row * 12, vrow = tid >> 3, vc = tid & 7;
    const int pr = (r & 19) | ((r & 4) << 1) | ((r & 8) >> 1);
    f32x16 oa[2];
#pragma unroll
    for (int i = 0; i < 16; ++i) { oa[0][i] = 0.f; oa[1][i] = 0.f; }
    float lsum = 0.f;
    u32x4 k0, k1, vv;
    k0 = *(const u32x4*)(Kb + (size_t)kp0row * 768 + kp0c * 8); if (tid < 256) k1 = *(const u32x4*)(Kb + (size_t)kp1row * 768 + kp1c * 8);
    vv = *(const u32x4*)(VTb + (size_t)vrow * pitch + vc * 8);
    *(LAS u32x4*)(lds + kp0row * 208 + kp0c * 16) = k0; if (tid < 256) *(LAS u32x4*)(lds + kp1row * 208 + kp1c * 16) = k1;
    *(LAS u32x4*)(lds + 13312 + vrow * 144 + vc * 16) = vv;
    __syncthreads();
    for (int kt = 0; kt < ntiles; ++kt) {
        LAS unsigned char* cur = lds + (kt & 1) * 22528; LAS unsigned char* nxt = lds + ((kt + 1) & 1) * 22528;
        const int key0 = kt * 64;
        if (kt + 1 < ntiles) { const bf16_t* kn = Kb + (size_t)(key0 + 64) * 768;
            k0 = *(const u32x4*)(kn + (size_t)kp0row * 768 + kp0c * 8); if (tid < 256) k1 = *(const u32x4*)(kn + (size_t)kp1row * 768 + kp1c * 8);
            vv = *(const u32x4*)(VTb + (size_t)vrow * pitch + key0 + 64 + vc * 8); }
        if (kt <= w.mylast) {
            f32x16 sa[2];
#pragma unroll
            for (int t2 = 0; t2 < 2; ++t2) {
#pragma unroll
                for (int i = 0; i < 16; ++i) sa[t2][i] = 0.f;
#pragma unroll
                for (int s = 0; s < 6; ++s) sa[t2] = __builtin_amdgcn_mfma_f32_32x32x16_bf16(*(const LAS bf16x8*)(cur + (32 * t2 + pr) * 208 + (16 * s + 8 * hh) * 2), Qf[s], sa[t2], 0, 0, 0);
            }
            const bool tail = key0 + 64 > nkeys;
            bf16x8 Pf[2][2];
#pragma unroll
            for (int t2 = 0; t2 < 2; ++t2) { float p[16];
#pragma unroll
                for (int jj = 0; jj < 16; ++jj) { float e = __builtin_amdgcn_exp2f(sa[t2][jj] - boff);
                    if (tail) { const int key = key0 + 32 * t2 + (jj & 3) + 4 * ((jj >> 2) & 1) + 8 * hh + 16 * (jj >> 3); if (key >= nkeys) e = 0.f; }
                    p[jj] = e; lsum += e; }
                Pf[t2][0] = __builtin_bit_cast(bf16x8, pack8(&p[0])); Pf[t2][1] = __builtin_bit_cast(bf16x8, pack8(&p[8])); }
#pragma unroll
            for (int mt = 0; mt < 2; ++mt)
#pragma unroll
                for (int t2 = 0; t2 < 2; ++t2)
#pragma unroll
                    for (int s2 = 0; s2 < 2; ++s2)
                        oa[mt] = __builtin_amdgcn_mfma_f32_32x32x16_bf16(*(const LAS bf16x8*)(cur + 13312 + (32 * mt + r) * 144 + (32 * t2 + 16 * s2 + 8 * hh) * 2), Pf[t2][s2], oa[mt], 0, 0, 0);
        }
        if (kt + 1 < ntiles) { *(LAS u32x4*)(nxt + kp0row * 208 + kp0c * 16) = k0; if (tid < 256) *(LAS u32x4*)(nxt + kp1row * 208 + kp1c * 16) = k1;
            *(LAS u32x4*)(nxt + 13312 + vrow * 144 + vc * 16) = vv; }
        __syncthreads();
    }
    lsum += __shfl_xor(lsum, 32);
    if (w.qvalid && w.mylast >= 0) { const float inv = 1.f / lsum; bf16_t* op = (bf16_t*)(a.ws + WS_OMLA) + (size_t)w.qrow * 512 + head * 64 + 4 * hh;
#pragma unroll
        for (int mt = 0; mt < 2; ++mt)
#pragma unroll
            for (int q4 = 0; q4 < 4; ++q4) { u32x2 o; o.x = cvt_pk_bf16(oa[mt][4 * q4] * inv, oa[mt][4 * q4 + 1] * inv); o.y = cvt_pk_bf16(oa[mt][4 * q4 + 2] * inv, oa[mt][4 * q4 + 3] * inv);
                *(u32x2*)(op + 32 * mt + 8 * q4) = o; } }
}
__device__ __forceinline__ void attn_phase(const Args& a, LAS unsigned char* lds, int tid, int lane, int wave) {
    const int c = blockIdx.x, G = gridDim.x;
    float mq = fabsf(a.in[I_QHG][lane]), mk = fabsf(a.in[I_KHG][lane]);
    if (lane < 32) { mq = fmaxf(mq, fabsf(a.in[I_QHG][64 + lane])); mk = fmaxf(mk, fabsf(a.in[I_KHG][64 + lane])); }
    const float boff = 9.797958971132712f * wave_max(mq) * wave_max(mk) * 1.4426950408889634f;
    const bf16_t* Kbuf = (const bf16_t*)(a.ws + WS_KBUF); const bf16_t* VT = (const bf16_t*)(a.ws + WS_VT);
#pragma unroll 1
    for (int rep = 0; rep < REPK(6); ++rep) {
    for (int p = c; p < 256; p += G) { const int bh = p >> 2, b = bh >> 3, h = bh & 7;
#pragma unroll 1
        for (int half = 0; half < 2; ++half) { const int qb = half ? 7 - (p & 3) : (p & 3);
            AttnWave w; w.pos = 256 * qb + 32 * wave + (lane & 31); w.qrow = b * SP + w.pos; w.mylast = 4 * qb + (wave >> 1); w.qvalid = true;
            attn_unit(a, lds, Kbuf + (size_t)b * SP * 768 + h * 96, VT + (size_t)bh * 64 * SP, SP, h, 4 * qb + 4, SP, w, boff, tid, lane); } }
    for (int u = (c + G / 2) % G; u < BS * 8; u += G) { const int s = u >> 3, h = u & 7;
        AttnWave w; w.pos = PAST + (lane & 15); w.qrow = MP + s * SS + (lane & 15); w.mylast = wave == 0 ? 32 : -1; w.qvalid = (lane & 31) < 16;
        attn_unit(a, lds, Kbuf + ((size_t)MP + (size_t)s * SKV) * 768 + h * 96, VT + VT_SAMPLE_OFF + (size_t)u * 64 * SKV, SKV, h, 33, SKV, w, boff, tid, lane); }
    }
}

#define XB_TMO      128
#define XB_XCNT(j)  (256  + 64 * (j))
#define XB_XSUB(j)  (1280 + 64 * (j))
#define XB_XGEN(j)  (2304 + 64 * (j))
#define XB_TOP      3328
#define XB_TOPGEN   3392
#define XCD_BAR_WORDS 3456
#define XB_SPIN_CAP (1u << 18)

__device__ __forceinline__ unsigned xb_ld(unsigned* p)              { return __hip_atomic_load(p, __ATOMIC_RELAXED, __HIP_MEMORY_SCOPE_AGENT); }
__device__ __forceinline__ unsigned xb_add(unsigned* p, unsigned v) { return __hip_atomic_fetch_add(p, v, __ATOMIC_RELAXED, __HIP_MEMORY_SCOPE_AGENT); }
__device__ __forceinline__ unsigned xb_xcc_id() { return (unsigned)__builtin_amdgcn_s_getreg((3 << 11) | 20) & 0xFu; }
#define XB_SPIN(cond, bar) do { unsigned _sp = 0; while (cond) { __builtin_amdgcn_s_sleep(1); \
    if ((++_sp & 255u) == 0u) { if (xb_ld(&(bar)[XB_TMO])) break; if (_sp > XB_SPIN_CAP) { atomicAdd(&(bar)[XB_TMO], 1u); break; } } } } while (0)

struct XcdBarrier {
    unsigned* bar; unsigned x;
    volatile LAS unsigned* st;
};

__device__ __forceinline__ XcdBarrier xcd_barrier_post(unsigned* bar, volatile LAS unsigned* st) {
    XcdBarrier b; b.bar = bar; b.x = xb_xcc_id(); b.st = st;
    if (threadIdx.x == 0) (void)xb_add(&bar[XB_XCNT(b.x)], 1u);
    return b;
}
__device__ __forceinline__ void xcd_barrier_complete(unsigned* bar, unsigned x, unsigned& nloc, unsigned& nx) {
    const unsigned G = gridDim.x * gridDim.y * gridDim.z;
    unsigned sum, cnt, mine, sp = 0u;
    for (;;) {
        sum = 0u; cnt = 0u; mine = 0u;
#pragma unroll
        for (unsigned j = 0; j < 16; ++j) { const unsigned c = xb_ld(&bar[XB_XCNT(j)]); sum += c; cnt += (c > 0u) ? 1u : 0u; mine = (j == x) ? c : mine; }
        if (sum == G) break;
        __builtin_amdgcn_s_sleep(1);
        if ((++sp & 255u) == 0u) { if (xb_ld(&bar[XB_TMO])) break; if (sp > XB_SPIN_CAP) { atomicAdd(&bar[XB_TMO], 1u); break; } }
    }
    nloc = mine > 0u ? mine : 1u; nx = cnt > 0u ? cnt : 1u;
}

__device__ __forceinline__ void xcd_barrier(const XcdBarrier& b) {
    asm volatile("s_waitcnt vmcnt(0)" ::: "memory");
    __syncthreads();
    if (threadIdx.x == 0) {
        unsigned* bar = b.bar;
        __builtin_amdgcn_s_waitcnt(0);
        unsigned nloc = b.st[0], nx = b.st[1];
        if (nloc == 0u) { xcd_barrier_complete(bar, b.x, nloc, nx); b.st[0] = nloc; b.st[1] = nx; }
        const unsigned old = xb_add(&bar[XB_XSUB(b.x)], 1u);
        const unsigned gen = old / nloc;
        if (old + 1u == (gen + 1u) * nloc) {
            __builtin_amdgcn_fence(__ATOMIC_RELEASE, "agent");
            asm volatile("s_waitcnt vmcnt(0)" ::: "memory");
            const unsigned og = xb_add(&bar[XB_TOP], 1u);
            const unsigned tg = og / nx;
            if (og + 1u == (tg + 1u) * nx) xb_add(&bar[XB_TOPGEN], 1u);
            else XB_SPIN(xb_ld(&bar[XB_TOPGEN]) == tg, bar);
            __builtin_amdgcn_fence(__ATOMIC_ACQUIRE, "agent");
            xb_add(&bar[XB_XGEN(b.x)], 1u);
            asm volatile("s_waitcnt vmcnt(0)" ::: "memory");
        } else {
            XB_SPIN(xb_ld(&bar[XB_XGEN(b.x)]) == gen, bar);
            __builtin_amdgcn_fence(__ATOMIC_ACQUIRE, "agent");
            asm volatile("s_waitcnt vmcnt(0)" ::: "memory");
        }
    }
    __syncthreads();
}


__global__ void __launch_bounds__(512, 2) mk_fwd(Args a) {
    extern __shared__ __attribute__((aligned(16))) unsigned char lds_raw[];
    LAS unsigned char* lds = (LAS unsigned char*)lds_raw;
    const int tid = threadIdx.x, lane = tid & 63, wave = __builtin_amdgcn_readfirstlane(tid >> 6);
    const int c = blockIdx.x, G = gridDim.x, gw = c * 8 + wave;
    unsigned char* ws = a.ws;
    volatile LAS unsigned* bst = (volatile LAS unsigned*)(lds + 147456);
    if (tid < 16) bst[tid] = 0u;
    __syncthreads();
    XcdBarrier xbar = xcd_barrier_post((unsigned*)(ws + WS_CTL) + CW_BAR, bst);
    const int lo = a.ph_lo, hi = a.ph_hi;
#define IN(k) (((MK_PHMASK >> (k)) & 1) && lo <= (k) && (k) < hi)
#if MK_SPLIT
#define SEAM(k) do { } while (0)
#else
#define SEAM(k) do { if (IN(k) && IN((k) + 1)) { if ((k) == 0) { __threadfence(); cg::this_grid().sync(); } else xcd_barrier(xbar); } } while (0)
#endif
    const bf16_t* H = (const bf16_t*)(ws + WS_H);
    float* mod = (float*)(ws + WS_MOD);
    if (IN(0)) phase0(a, lds, tid, lane, wave);
    SEAM(0);
#if MK_XSYNC && !MK_SPLIT
#pragma unroll 1
    for (int x = 0; x < MK_XSYNC; ++x) cg::this_grid().sync();
#endif
    if (IN(1)) norm_rows(a.in[I_XP], a.in[I_XS], a.in[I_N1G], mod, 0, 1024, (bf16_t*)(ws + WS_H), gw, lane);
    SEAM(1);
    if (IN(2)) { pg8::Gemm g{{H, H}, {(const bf16_t*)(ws + WS_WIN), nullptr}, 1024, 1024, 1024}; pg8::StaticOrder S; S.init(MR / 256, NINP / 256, G, c, REPK(2));
        EpiProj E{(bf16_t*)(ws + WS_GQKV), (bf16_t*)(ws + WS_Z), (bf16_t*)a.out, (bf16_t*)(ws + WS_CKVRAW), (bf16_t*)(ws + WS_CQ), (float*)(ws + WS_KRRAW), (float*)(ws + WS_AB)};
        pg8::gemm_phase(lds, g, S, E); }
    SEAM(2);
    if (IN(3)) { gdn_prep(a, lds, tid); mla_rows(a, gw, lane); misc_p3(a, tid); }
    SEAM(3);
    if (IN(4)) {
#pragma unroll 1
        for (int rep = REPK(4) - 1; rep >= 0; --rep) for (int u = c; u < 192; u += G) { if (u < 64) scan_prompt(a, lds, u, tid, lane, wave, rep == 0); else gdn_sample(a, lds, u - 64, tid, lane, wave, rep == 0); __syncthreads(); } }
    SEAM(4);
    if (IN(5)) {
        { pg8::Gemm g{{(const bf16_t*)(ws + WS_CQ), nullptr}, {(const bf16_t*)(ws + WS_WUQ), nullptr}, 384, 384, 384}; pg8::StaticOrder S; S.init(MR / 256, 3, G, c, REPK(5));
          EpiBf16<0> E{(bf16_t*)(ws + WS_QRAW), 768}; pg8::gemm_phase(lds, g, S, E); }
        { pg8::Gemm g{{(const bf16_t*)(ws + WS_CKVROWS), nullptr}, {(const bf16_t*)(ws + WS_WUK), nullptr}, 256, 256, 256}; pg8::StaticOrder S; S.init(KR / 256, 2, G, (c + G - 195 % G) % G, REPK(5));
          EpiK E{(bf16_t*)(ws + WS_KBUF), a.in[I_KHG], a.out + O_KRP, a.out + O_KRS, a.in[I_CKR]}; pg8::gemm_phase(lds, g, S, E); }
        { pg8::Gemm g{{(const bf16_t*)(ws + WS_WUV), nullptr}, {(const bf16_t*)(ws + WS_CKVROWS), nullptr}, 256, 256, 256}; pg8::StaticOrder S; S.init(2, KR / 256, G, (c + G - 69 % G) % G, REPK(5));
          EpiVT E{(bf16_t*)(ws + WS_VT)}; pg8::gemm_phase(lds, g, S, E); }
    }
    SEAM(5);
    if (IN(6)) attn_phase(a, lds, tid, lane, wave);
    SEAM(6);
    if (IN(7)) { pg8::Gemm g{{(const bf16_t*)(ws + WS_Z), (const bf16_t*)(ws + WS_OMLA)}, {(const bf16_t*)(ws + WS_WGO), (const bf16_t*)(ws + WS_WMO)}, 512, 512, 512};
        pg8::DualOrder S; S.S.init(MR / 256, 4, G, c, REPK(7)); EpiGate E{(bf16_t*)(ws + WS_MERGED), (const bf16_t*)a.out}; pg8::gemm_phase(lds, g, S, E); }
    SEAM(7);
    if (IN(8)) { pg8::Gemm g{{(const bf16_t*)(ws + WS_MERGED), nullptr}, {(const bf16_t*)(ws + WS_WO), nullptr}, 1024, 1024, 1024}; pg8::StaticOrder S; S.init(MR / 256, 4, G, c, REPK(8));
        EpiRes E{a.in[I_XP], a.in[I_XS], a.out, mod, 2048}; pg8::gemm_phase(lds, g, S, E); }
    SEAM(8);
    if (IN(9)) norm_rows(a.out, a.out + (size_t)MP * 1024, a.in[I_N2G], mod, 3072, 4096, (bf16_t*)(ws + WS_H), gw, lane);
    SEAM(9);
    if (IN(10)) { pg8::Gemm g{{H, nullptr}, {(const bf16_t*)(ws + WS_WF1), nullptr}, 1024, 1024, 1024}; pg8::StaticOrder S; S.init(MR / 256, 16, G, c, REPK(10));
        EpiBf16<1> E{(bf16_t*)(ws + WS_HID), DFF}; pg8::gemm_phase(lds, g, S, E); }
    SEAM(10);
    if (IN(11)) { pg8::Gemm g{{(const bf16_t*)(ws + WS_HID), nullptr}, {(const bf16_t*)(ws + WS_WF2), nullptr}, DFF, DFF, DFF}; pg8::StaticOrder S; S.init(MR / 256, 4, G, c);
        EpiRes E{a.out, a.out + (size_t)MP * 1024, a.out, mod, 5120}; pg8::gemm_phase(lds, g, S, E); }
#undef IN
#undef SEAM
}

extern "C" void kernel_launch(void* const* d_in, const int* in_sizes, int n_in, void* d_out, int out_size, void* d_ws, size_t ws_size, hipStream_t stream) {
    static int grid = 0;
    if (grid == 0) {
        int dev = 0, cus = 0, per_cu = 0;
        hipGetDevice(&dev); hipDeviceGetAttribute(&cus, hipDeviceAttributeMultiprocessorCount, dev);
        hipFuncSetAttribute((const void*)mk_fwd, hipFuncAttributeMaxDynamicSharedMemorySize, LDS_BYTES);
        hipOccupancyMaxActiveBlocksPerMultiprocessor(&per_cu, (const void*)mk_fwd, 512, LDS_BYTES);
        if (per_cu < 1) per_cu = 1;
        grid = cus * per_cu; if (grid > 256) grid = 256;
        (void)hipGetLastError();
    }
    hipMemsetAsync((char*)d_ws + WS_CTL, 0, 64 * KiB, stream);
    Args a{};
    for (int i = 0; i < 28; ++i) a.in[i] = (const float*)d_in[i];
    a.out = (float*)d_out; a.ws = (unsigned char*)d_ws;
#if MK_SPLIT
    for (int p = 0; p < NPHASE; ++p) { a.ph_lo = p; a.ph_hi = p + 1; hipLaunchKernelGGL(mk_fwd, dim3(grid), dim3(512), LDS_BYTES, stream, a); }
#else
    a.ph_lo = 0; a.ph_hi = NPHASE;
    void* args[] = {&a};
    hipError_t e = hipLaunchCooperativeKernel((const void*)mk_fwd, dim3(grid), dim3(512), args, LDS_BYTES, stream);
    if (e != hipSuccess) fprintf(stderr, "cooperative launch failed: %s (grid %d)\n", hipGetErrorString(e), grid);
#endif
}
```

```cpp
#include <hip/hip_runtime.h>
#include <hip/hip_cooperative_groups.h>
#include <cstdio>
#include <cstdint>
namespace cg = cooperative_groups;

#ifndef REP_GEMM
#define REP_GEMM 0x111111111111ull
#endif
#define REPK(k) ((int)((REP_GEMM >> (4 * (k))) & 15))
#ifndef MK_XSYNC
#define MK_XSYNC 0
#endif
#ifndef MK_PHMASK
#define MK_PHMASK 0xFFF
#endif
#ifndef MK_SPLIT
#define MK_SPLIT 0
#endif

#define LAS __attribute__((address_space(3)))
typedef unsigned short bf16_t;
typedef short bf16x8 __attribute__((ext_vector_type(8)));
typedef float f32x4 __attribute__((ext_vector_type(4)));
typedef float f32x2 __attribute__((ext_vector_type(2)));
typedef float f32x16 __attribute__((ext_vector_type(16)));
typedef unsigned u32x4 __attribute__((ext_vector_type(4)));
typedef unsigned u32x2 __attribute__((ext_vector_type(2)));

constexpr int DM = 1024, BP = 8, SP = 2048, BS = 16, SS = 16, PAST = 2048;
constexpr int MP = BP * SP, MS = BS * SS, MR = MP + MS;
constexpr int SKV = PAST + SS;
constexpr int KR = MP + BS * SKV;
constexpr int NIN = 4784, NINP = 4864;
constexpr int DFF = 4096;
constexpr float EPS = 1e-6f;

constexpr size_t O_Y = 0, O_CKVP = 17039360, O_KRP = 21233664, O_STP = 21757952, O_CVP = 22020096,
                 O_CKVS = 22056960, O_KRS = 22122496, O_STS = 22130688, O_CVS = 22654976;

constexpr size_t KiB = 1024, MiB = 1024 * 1024;
constexpr size_t WS_CTL = 0;
constexpr size_t WS_MOD = 64 * KiB;
constexpr size_t WS_ROPE = 640 * KiB;
constexpr size_t WS_WIN = 960 * KiB;
constexpr size_t WS_WUQ = WS_WIN + (size_t)NINP * 1024 * 2;
constexpr size_t WS_WUK = WS_WUQ + 768 * 384 * 2;
constexpr size_t WS_WUV = WS_WUK + 512 * 256 * 2;
constexpr size_t WS_WGO = WS_WUV + 512 * 256 * 2;
constexpr size_t WS_WMO = WS_WGO + 1024 * 512 * 2;
constexpr size_t WS_WO = WS_WMO + 1024 * 512 * 2;
constexpr size_t WS_WF1 = WS_WO + 1024 * 1024 * 2;
constexpr size_t WS_WF2 = WS_WF1 + (size_t)4096 * 1024 * 2;
constexpr size_t WS_WEND = WS_WF2 + (size_t)4096 * 1024 * 2;
static_assert(WS_WEND <= 32 * MiB, "weights region");
constexpr size_t WS_H = 32 * MiB;
constexpr size_t WS_CKVROWS = 32 * MiB;
constexpr size_t WS_OMLA = 32 * MiB;
constexpr size_t WS_GQKV = 64 * MiB + 512 * KiB;
constexpr size_t WS_VT = WS_GQKV;
constexpr size_t WS_Z = 113 * MiB + 256 * KiB;
constexpr size_t WS_CQ = 129 * MiB + 512 * KiB;
constexpr size_t WS_CKVRAW = WS_CQ + (size_t)MR * 384 * 2;
constexpr size_t WS_KRRAW = WS_CKVRAW + (size_t)MR * 256 * 2;
constexpr size_t WS_AB = WS_KRRAW + (size_t)MR * 32 * 4;
static_assert(WS_AB + (size_t)MR * 16 * 4 <= 153 * MiB, "small proj outputs");
constexpr size_t WS_PREP = 153 * MiB;
constexpr size_t REC_BYTES = 41024;
static_assert(WS_PREP + (size_t)2048 * REC_BYTES <= 256 * MiB, "prep region");
constexpr size_t WS_KBUF = 153 * MiB;
constexpr size_t WS_QRAW = WS_KBUF + (size_t)KR * 768 * 2;
static_assert(WS_QRAW + (size_t)MR * 768 * 2 <= 256 * MiB, "qraw");
constexpr size_t WS_MERGED = 153 * MiB;
constexpr size_t WS_HID = 64 * MiB + 512 * KiB;
static_assert(WS_HID + (size_t)MR * DFF * 2 <= 256 * MiB, "hid");
constexpr size_t VT_SAMPLE_OFF = (size_t)BP * 8 * 64 * SP;

constexpr int LDS_BYTES = 147456 + 64;
constexpr int CW_BAR = 4096;
constexpr int NPHASE = 12;

__device__ __forceinline__ unsigned cvt_pk_bf16(float lo, float hi) { unsigned r; asm volatile("v_cvt_pk_bf16_f32 %0, %1, %2" : "=v"(r) : "v"(lo), "v"(hi)); return r; }
__device__ __forceinline__ float bflo(unsigned u) { return __uint_as_float(u << 16); }
__device__ __forceinline__ float bfhi(unsigned u) { return __uint_as_float(u & 0xffff0000u); }
__device__ __forceinline__ float bf2f(bf16_t b) { return __uint_as_float((unsigned)b << 16); }
__device__ __forceinline__ bf16_t f2bf(float f) { return (bf16_t)(cvt_pk_bf16(f, 0.f) & 0xffffu); }
__device__ __forceinline__ float wave_sum(float v) {
#pragma unroll
    for (int o = 1; o < 64; o <<= 1) v += __shfl_xor(v, o);
    return v;
}
__device__ __forceinline__ float wave_max(float v) {
#pragma unroll
    for (int o = 1; o < 64; o <<= 1) v = fmaxf(v, __shfl_xor(v, o));
    return v;
}
__device__ __forceinline__ float sigmoidf_(float x) { return 1.f / (1.f + __expf(-x)); }
__device__ __forceinline__ float siluf_(float x) { return x / (1.f + __expf(-x)); }
__device__ __forceinline__ u32x4 pack8(const float* v) { u32x4 w; w.x = cvt_pk_bf16(v[0], v[1]); w.y = cvt_pk_bf16(v[2], v[3]); w.z = cvt_pk_bf16(v[4], v[5]); w.w = cvt_pk_bf16(v[6], v[7]); return w; }
__device__ __forceinline__ int mod_row(int r) { return r < MP ? (r >> 11) : 8 + ((r - MP) >> 4); }

namespace pg8 {
constexpr int BM = 256, BK = 64, HALF = 128, HTB = HALF * BK * 2, STAGE_BYTES = 8 * HTB, NXCD = 8, WGM = 8;
__host__ __device__ __forceinline__ int lds_byte(int r, int c) { const int st = (r >> 4) * 2 + (c >> 5), rr = r & 15, cc = c & 31, ob = rr * 64 + cc * 2; return st * 1024 + (ob ^ (((ob >> 9) & 1) << 5)); }
__host__ __device__ __forceinline__ void stage_rc(int b, int& R, int& C) { const int st = b / 1024, sb = b % 1024, swz = sb ^ (((sb >> 9) & 1) << 5); R = (st >> 1) * 16 + swz / 64; C = (st & 1) * 32 + (swz % 64) / 2; }
__host__ __device__ __forceinline__ int perm32(int rho) { const int n = rho >> 4, i = rho & 15; return 8 * (i >> 2) + 4 * n + (i & 3); }

struct Unit { int pm, pn, sel; };
struct Gemm { const bf16_t* A[2]; const bf16_t* Bt[2]; int lda, ldb, K; };

struct StaticOrder {
    int nM, nN, nwg, G, c, rep;
    __device__ void init(int nM_, int nN_, int G_, int c_, int rep_ = 1) { nM = nM_; nN = nN_; nwg = nM * nN; G = G_; c = c_; rep = rep_; }
    __device__ bool next(int i, Unit& u) const {
        const long L = (long)(i / rep) * G + c; if (L >= nwg) return false;
        int wgid = (int)L; { const int q = nwg / NXCD, r = nwg % NXCD, xcd = wgid % NXCD, off = wgid / NXCD; wgid = (xcd < r ? xcd * (q + 1) : r * (q + 1) + (xcd - r) * q) + off; }
        const int nig = WGM * nN, gid = wgid / nig, fm = gid * WGM, gsz = (nM - fm) < WGM ? (nM - fm) : WGM;
        u.pm = fm + ((wgid % nig) % gsz); u.pn = (wgid % nig) / gsz; u.sel = 0; return true;
    }
};
struct DualOrder {
    StaticOrder S;
    __device__ bool next(int i, Unit& u) const { const bool ok = S.next(i >> 1, u); u.sel = i & 1; return ok; }
};

template <class Epi, class Sched>
__device__ __forceinline__ void gemm_phase(LAS unsigned char* lds, const Gemm g, const Sched& S, const Epi& E) {
    const int tid = threadIdx.x, wid = __builtin_amdgcn_readfirstlane(tid >> 6), lane = tid & 63, wr = wid >> 2, wc = wid & 3, fr = lane & 15, fq = lane >> 4;
    const int K = g.K, nt = K / BK;
    unsigned voffA[2], voffB[2];
#pragma unroll
    for (int i = 0; i < 2; ++i) { int R, C; stage_rc(tid * 16 + i * 8192, R, C); const int Rb = Epi::PERM ? ((R & ~31) + perm32(R & 31)) : R;
        voffA[i] = (unsigned)(R * g.lda + C) * 2u; voffB[i] = (unsigned)(Rb * g.ldb + C) * 2u; }
    const size_t kstep = (size_t)(BK * 2);
    const size_t hstepA = (size_t)HALF * g.lda * 2, hstepB = (size_t)HALF * g.ldb * 2;
    const size_t tstepA = 2 * hstepA, tstepB = 2 * hstepB;
    const unsigned ldsw = (unsigned)wid * 1024u;
    const int aoff = lds_byte(wr * 64 + fr, fq * 8), boff = lds_byte(wc * 32 + fr, fq * 8);
#define PG8_SA(b, h) (((b) * 2 + (h)) * HTB)
#define PG8_SB(b, h) ((4 + (b) * 2 + (h)) * HTB)
#define PG8_STAGE(bufoff, gbase, voff) do { _Pragma("unroll") for (int _i = 0; _i < 2; ++_i) \
        __builtin_amdgcn_global_load_lds((const unsigned*)((const char*)(gbase) + (voff)[_i]), (LAS unsigned*)(lds + (bufoff) + ldsw + _i * 8192), 16, 0, 0); } while (0)
#define PG8_LDA(dst, b, h) do { _Pragma("unroll") for (int m = 0; m < 4; ++m) _Pragma("unroll") for (int k = 0; k < 2; ++k) dst[m][k] = *(const LAS bf16x8*)(lds + PG8_SA(b, h) + aoff + m * 2048 + k * 1024); } while (0)
#define PG8_LDB(dst, b, h) do { _Pragma("unroll") for (int n = 0; n < 2; ++n) _Pragma("unroll") for (int k = 0; k < 2; ++k) dst[n][k] = *(const LAS bf16x8*)(lds + PG8_SB(b, h) + boff + n * 2048 + k * 1024); } while (0)
#define PG8_MMA(ai, bj, At, Bt) do { __builtin_amdgcn_s_setprio(1); _Pragma("unroll") for (int m = 0; m < 4; ++m) _Pragma("unroll") for (int n = 0; n < 2; ++n) _Pragma("unroll") for (int k = 0; k < 2; ++k) \
        acc[ai][bj][m][n] = __builtin_amdgcn_mfma_f32_16x16x32_bf16(Bt[n][k], At[m][k], acc[ai][bj][m][n], 0, 0, 0); __builtin_amdgcn_s_setprio(0); } while (0)
#define PG8_WAIT_V(n) asm volatile("s_waitcnt vmcnt(" #n ")" ::: "memory")
#define PG8_WAIT_L(n) asm volatile("s_waitcnt lgkmcnt(" #n ")" ::: "memory")
#define PG8_BAR __builtin_amdgcn_s_barrier()
#define PG8_SCHED __builtin_amdgcn_sched_barrier(0)
    Unit cur, nxt; int ui = 0;
    if (!S.next(0, cur)) return;
    f32x4 acc[2][2][4][2];
#pragma unroll
    for (int a = 0; a < 2; ++a)
#pragma unroll
        for (int b = 0; b < 2; ++b)
#pragma unroll
            for (int m = 0; m < 4; ++m)
#pragma unroll
                for (int n = 0; n < 2; ++n) acc[a][b][m][n] = (f32x4){0.f, 0.f, 0.f, 0.f};
    bf16x8 At[4][2], B0[2][2], B1[2][2];
    const char* cA = (const char*)(cur.sel ? g.A[1] : g.A[0]) + (size_t)cur.pm * tstepA; const char* cB = (const char*)(cur.sel ? g.Bt[1] : g.Bt[0]) + (size_t)cur.pn * tstepB;
    PG8_STAGE(PG8_SB(0, 0), cB, voffB); PG8_STAGE(PG8_SB(0, 1), cB + hstepB, voffB); PG8_STAGE(PG8_SA(0, 0), cA, voffA); PG8_STAGE(PG8_SA(0, 1), cA + hstepA, voffA);
    if (wr == 1) PG8_BAR;
    PG8_WAIT_V(2); PG8_BAR;
    PG8_STAGE(PG8_SB(1, 0), cB + kstep, voffB); PG8_STAGE(PG8_SA(1, 0), cA + kstep, voffA); PG8_STAGE(PG8_SB(1, 1), cB + hstepB + kstep, voffB);
    PG8_WAIT_V(6); PG8_BAR;
    for (;;) {
        const bool has_next = S.next(ui + 1, nxt);
        const char* nA = has_next ? (const char*)(nxt.sel ? g.A[1] : g.A[0]) + (size_t)nxt.pm * tstepA : cA; const char* nB = has_next ? (const char*)(nxt.sel ? g.Bt[1] : g.Bt[0]) + (size_t)nxt.pn * tstepB : cB;
#pragma unroll 1
        for (int t = 0; t < nt; t += 2) {
            const bool last = (t == nt - 2);
            const char* a1 = cA + (size_t)(t + 1) * kstep;
            const char* a2 = last ? nA : cA + (size_t)(t + 2) * kstep; const char* b2 = last ? nB : cB + (size_t)(t + 2) * kstep;
            const char* a3 = a2 + kstep; const char* b3 = b2 + kstep;
            PG8_LDB(B0, 0, 0); PG8_LDB(B1, 0, 1); PG8_SCHED; PG8_LDA(At, 0, 0); PG8_STAGE(PG8_SA(1, 1), a1 + hstepA, voffA);
            PG8_WAIT_V(8); PG8_WAIT_L(0); PG8_BAR; PG8_MMA(0, 0, At, B0); PG8_MMA(0, 1, At, B1); PG8_BAR; PG8_SCHED;
            PG8_LDA(At, 0, 1); PG8_STAGE(PG8_SB(0, 0), b2, voffB); PG8_STAGE(PG8_SB(0, 1), b2 + hstepB, voffB); PG8_STAGE(PG8_SA(0, 0), a2, voffA);
            PG8_WAIT_V(8); PG8_WAIT_L(0); PG8_BAR; PG8_MMA(1, 0, At, B0); PG8_MMA(1, 1, At, B1); PG8_BAR; PG8_SCHED;
            PG8_LDB(B0, 1, 0); PG8_LDB(B1, 1, 1); PG8_SCHED; PG8_LDA(At, 1, 0); PG8_STAGE(PG8_SA(0, 1), a2 + hstepA, voffA);
            PG8_WAIT_V(8); PG8_WAIT_L(0); PG8_BAR; PG8_MMA(0, 0, At, B0); PG8_MMA(0, 1, At, B1); PG8_BAR; PG8_SCHED;
            PG8_LDA(At, 1, 1); PG8_STAGE(PG8_SB(1, 0), b3, voffB); PG8_STAGE(PG8_SB(1, 1), b3 + hstepB, voffB); PG8_STAGE(PG8_SA(1, 0), a3, voffA);
            PG8_WAIT_V(8); PG8_WAIT_L(0); PG8_BAR; PG8_MMA(1, 0, At, B0); PG8_MMA(1, 1, At, B1); PG8_BAR; PG8_SCHED;
        }
        if (wr == 0) PG8_BAR;
        E(acc, cur, wr, wc, fr, fq);
        if (!has_next) break;
#pragma unroll
        for (int a = 0; a < 2; ++a)
#pragma unroll
            for (int b = 0; b < 2; ++b)
#pragma unroll
                for (int m = 0; m < 4; ++m)
#pragma unroll
                    for (int n = 0; n < 2; ++n) acc[a][b][m][n] = (f32x4){0.f, 0.f, 0.f, 0.f};
        cur = nxt; cA = nA; cB = nB; ++ui;
        if (wr == 1) PG8_BAR;
    }
    PG8_WAIT_V(0);
    PG8_BAR;
#undef PG8_SA
#undef PG8_SB
#undef PG8_STAGE
#undef PG8_LDA
#undef PG8_LDB
#undef PG8_MMA
#undef PG8_WAIT_V
#undef PG8_WAIT_L
#undef PG8_BAR
#undef PG8_SCHED
}
}
using pg8::Unit;

#define EPI_ARGS const f32x4 (&acc)[2][2][4][2], const Unit& u, int wr, int wc, int fr, int fq
__device__ __forceinline__ u32x4 pack_v(const f32x4 v0, const f32x4 v1) { u32x4 w; w.x = cvt_pk_bf16(v0[0], v0[1]); w.y = cvt_pk_bf16(v0[2], v0[3]); w.z = cvt_pk_bf16(v1[0], v1[1]); w.w = cvt_pk_bf16(v1[2], v1[3]); return w; }

struct EpiProj {
    static constexpr bool PERM = true;
    bf16_t *gqkv, *z, *gl, *ckvraw, *cq; float *krraw, *ab;
    __device__ __forceinline__ void operator()(EPI_ARGS) const {
        const int pn = u.pn; bf16_t* base; int pitch;
        if (pn < 6) { base = gqkv + pn * 256; pitch = 1536; } else if (pn < 8) { base = z + (pn - 6) * 256; pitch = 512; }
        else if (pn < 16) { base = gl + (pn - 8) * 256; pitch = 2048; } else if (pn == 16) { base = ckvraw; pitch = 256; }
        else if (pn == 17) { base = cq; pitch = 384; } else { base = cq + 256; pitch = 384; }
#pragma unroll
        for (int ai = 0; ai < 2; ++ai)
#pragma unroll
            for (int m = 0; m < 4; ++m) { const size_t row = (size_t)u.pm * 256 + ai * 128 + wr * 64 + m * 16 + fr;
#pragma unroll
                for (int bj = 0; bj < 2; ++bj) { const int ct = bj * 128 + wc * 32 + 8 * fq; const f32x4 v0 = acc[ai][bj][m][0], v1 = acc[ai][bj][m][1];
                    if (pn < 18 || bj == 0) { *(u32x4*)(base + row * pitch + ct) = pack_v(v0, v1); }
                    else if (wc == 0) { float* d = krraw + row * 32 + 8 * fq; *(f32x4*)d = v0; *(f32x4*)(d + 4) = v1; }
                    else if (wc == 1 && fq < 2) { float* d = ab + row * 16 + 8 * fq; *(f32x4*)d = v0; *(f32x4*)(d + 4) = v1; }
                } }
    }
};
template <int ACT> struct EpiBf16 {
    static constexpr bool PERM = true;
    bf16_t* O; int ldc;
    __device__ __forceinline__ void operator()(EPI_ARGS) const {
#pragma unroll
        for (int ai = 0; ai < 2; ++ai)
#pragma unroll
            for (int m = 0; m < 4; ++m) { const size_t row = (size_t)u.pm * 256 + ai * 128 + wr * 64 + m * 16 + fr;
#pragma unroll
                for (int bj = 0; bj < 2; ++bj) { const int col = u.pn * 256 + bj * 128 + wc * 32 + 8 * fq; f32x4 v0 = acc[ai][bj][m][0], v1 = acc[ai][bj][m][1];
                    if (ACT == 1) {
#pragma unroll
                        for (int e = 0; e < 4; ++e) { const float a = fmaxf(v0[e], 0.f), b = fmaxf(v1[e], 0.f); v0[e] = a * a; v1[e] = b * b; } }
                    *(u32x4*)(O + row * ldc + col) = pack_v(v0, v1); } }
    }
};
struct EpiK {
    static constexpr bool PERM = true;
    bf16_t* K; const float *gk, *krp, *krs, *krcache;
    __device__ __forceinline__ void operator()(EPI_ARGS) const {
        const int head = u.pn * 4 + wc;
        float g0[8], g1[8], g2[8];
#pragma unroll
        for (int e = 0; e < 8; ++e) { g0[e] = gk[8 * fq + e]; g1[e] = gk[32 + 8 * fq + e]; g2[e] = gk[64 + 8 * fq + e]; }
#pragma unroll
        for (int ai = 0; ai < 2; ++ai)
#pragma unroll
            for (int m = 0; m < 4; ++m) { const int R = u.pm * 256 + ai * 128 + wr * 64 + m * 16 + fr;
                const float* kr;
                if (R < MP) kr = krp + (size_t)R * 32;
                else { const int q = R - MP, s = q / SKV, j = q - s * SKV; kr = j < PAST ? krcache + ((size_t)s * PAST + j) * 32 : krs + ((size_t)s * SS + (j - PAST)) * 32; }
                const f32x4 r0 = *(const f32x4*)(kr + 8 * fq), r1 = *(const f32x4*)(kr + 8 * fq + 4);
                const f32x4 a0 = acc[ai][0][m][0], a1 = acc[ai][0][m][1], b0 = acc[ai][1][m][0], b1 = acc[ai][1][m][1];
                float ss = 0.f;
#pragma unroll
                for (int e = 0; e < 4; ++e) ss += a0[e] * a0[e] + a1[e] * a1[e] + b0[e] * b0[e] + b1[e] * b1[e] + r0[e] * r0[e] + r1[e] * r1[e];
                ss += __shfl_xor(ss, 16); ss += __shfl_xor(ss, 32);
                const float rs = rsqrtf(ss * (1.f / 96.f) + EPS);
                float o0[8], o1[8], o2[8];
#pragma unroll
                for (int e = 0; e < 4; ++e) { o0[e] = a0[e] * rs * g0[e]; o0[4 + e] = a1[e] * rs * g0[4 + e]; o1[e] = b0[e] * rs * g1[e]; o1[4 + e] = b1[e] * rs * g1[4 + e];
                    o2[e] = r0[e] * rs * g2[e]; o2[4 + e] = r1[e] * rs * g2[4 + e]; }
                bf16_t* d = K + (size_t)R * 768 + head * 96 + 8 * fq;
                *(u32x4*)d = pack8(o0); *(u32x4*)(d + 32) = pack8(o1); *(u32x4*)(d + 64) = pack8(o2); }
    }
};
struct EpiVT {
    static constexpr bool PERM = true;
    bf16_t* VT;
    __device__ __forceinline__ void operator()(EPI_ARGS) const {
        size_t coff[2]; int pitch[2];
#pragma unroll
        for (int bj = 0; bj < 2; ++bj) { const int R0 = u.pn * 256 + bj * 128 + wc * 32 + 8 * fq;
            if (R0 < MP) { coff[bj] = (size_t)(R0 >> 11) * 8 * 64 * SP + (R0 & 2047); pitch[bj] = SP; }
            else { const int q = R0 - MP, s = q / SKV, j = q - s * SKV; coff[bj] = VT_SAMPLE_OFF + (size_t)s * 8 * 64 * SKV + j; pitch[bj] = SKV; } }
#pragma unroll
        for (int ai = 0; ai < 2; ++ai)
#pragma unroll
            for (int m = 0; m < 4; ++m) { const int f = u.pm * 256 + ai * 128 + wr * 64 + m * 16 + fr;
#pragma unroll
                for (int bj = 0; bj < 2; ++bj) *(u32x4*)(VT + coff[bj] + (size_t)f * pitch[bj]) = pack_v(acc[ai][bj][m][0], acc[ai][bj][m][1]); }
    }
};
struct EpiGate {
    static constexpr bool PERM = true;
    bf16_t* merged; const bf16_t* gl;
    __device__ __forceinline__ void operator()(EPI_ARGS) const {
#pragma unroll
        for (int ai = 0; ai < 2; ++ai)
#pragma unroll
            for (int m = 0; m < 4; ++m) { const size_t row = (size_t)u.pm * 256 + ai * 128 + wr * 64 + m * 16 + fr;
#pragma unroll
                for (int bj = 0; bj < 2; ++bj) { const int col = u.pn * 256 + bj * 128 + wc * 32 + 8 * fq; const f32x4 v0 = acc[ai][bj][m][0], v1 = acc[ai][bj][m][1];
                    const u32x4 gw = *(const u32x4*)(gl + row * 2048 + u.sel * 1024 + col);
                    float o[8];
                    o[0] = sigmoidf_(bflo(gw.x)) * v0[0]; o[1] = sigmoidf_(bfhi(gw.x)) * v0[1]; o[2] = sigmoidf_(bflo(gw.y)) * v0[2]; o[3] = sigmoidf_(bfhi(gw.y)) * v0[3];
                    o[4] = sigmoidf_(bflo(gw.z)) * v1[0]; o[5] = sigmoidf_(bfhi(gw.z)) * v1[1]; o[6] = sigmoidf_(bflo(gw.w)) * v1[2]; o[7] = sigmoidf_(bfhi(gw.w)) * v1[3];
                    bf16_t* d = merged + row * 1024 + col;
                    if (u.sel) { const u32x4 t = *(const u32x4*)d;
                        o[0] += bflo(t.x); o[1] += bfhi(t.x); o[2] += bflo(t.y); o[3] += bfhi(t.y); o[4] += bflo(t.z); o[5] += bfhi(t.z); o[6] += bflo(t.w); o[7] += bfhi(t.w); }
                    *(u32x4*)d = pack8(o); } }
    }
};
struct EpiRes {
    static constexpr bool PERM = false;
    const float *bp, *bs; float* out; const float* mod; int goff;
    __device__ __forceinline__ void operator()(EPI_ARGS) const {
#pragma unroll
        for (int ai = 0; ai < 2; ++ai)
#pragma unroll
            for (int m = 0; m < 4; ++m) { const int row = u.pm * 256 + ai * 128 + wr * 64 + m * 16 + fr;
                const float* br = row < MP ? bp + (size_t)row * 1024 : bs + (size_t)(row - MP) * 1024; const float* gr = mod + mod_row(row) * 6144 + goff;
#pragma unroll
                for (int bj = 0; bj < 2; ++bj)
#pragma unroll
                    for (int n = 0; n < 2; ++n) { const int col = u.pn * 256 + bj * 128 + wc * 32 + 16 * n + 4 * fq;
                        const f32x4 b = *(const f32x4*)(br + col), gt = *(const f32x4*)(gr + col);
                        *(f32x4*)(out + (size_t)row * 1024 + col) = b + gt * acc[ai][bj][m][n]; } }
    }
};

struct Args { const float* in[28]; float* out; unsigned char* ws; int ph_lo, ph_hi; };
enum { I_XP = 0, I_XS, I_CP, I_CS, I_CKV, I_CKR, I_ST, I_CONV, I_ADAW, I_ADAB, I_N1G, I_WIN, I_CONVW, I_ALOG, I_DTB, I_GNG, I_WGO, I_QNG, I_WUQ, I_KVNG, I_WUKV,
       I_QHG, I_KHG, I_WMO, I_WO, I_N2G, I_WF1, I_WF2 };

__device__ __forceinline__ int colmap(int which, int n) {
    switch (which) {
    case 0:
        if (n < 2048) return n; if (n < 4096) return 2736 + (n - 2048); if (n < 4352) return 2448 + (n - 4096); if (n < 4736) return 2064 + (n - 4352);
        if (n < 4768) return 2704 + (n - 4736); if (n < 4776) return 2048 + (n - 4768); if (n < 4784) return 2056 + (n - 4776); return -1;
    case 2: { const int pn = n >> 8, bj = (n >> 7) & 1, wc = (n >> 5) & 3, j = n & 31; return (4 * pn + wc) * 128 + bj * 32 + j; }
    case 3: return (n >> 6) * 128 + 64 + (n & 63);
    default: return n;
    }
}
__device__ __forceinline__ void transpose_item(const float* W, int K, int N, bf16_t* WT, LAS float* scr, int nblk, int which, int item, int lane) {
    const int kb = item / nblk, nb = item - kb * nblk, k0 = 64 * kb, n0 = 32 * nb;
    const int sc = colmap(which, n0 + (lane & 31));
#pragma unroll 8
    for (int i = 0; i < 32; ++i) { const int kk = 2 * i + (lane >> 5); scr[kk * 33 + (lane & 31)] = sc >= 0 ? W[(size_t)(k0 + kk) * N + sc] : 0.f; }
    asm volatile("s_waitcnt lgkmcnt(0)" ::: "memory");
    const int c = lane & 7;
#pragma unroll
    for (int j = 0; j < 4; ++j) { const int n = (lane >> 3) + 8 * j; const LAS float* s = scr + (8 * c) * 33 + n;
        u32x4 o; o.x = cvt_pk_bf16(s[0 * 33], s[1 * 33]); o.y = cvt_pk_bf16(s[2 * 33], s[3 * 33]); o.z = cvt_pk_bf16(s[4 * 33], s[5 * 33]); o.w = cvt_pk_bf16(s[6 * 33], s[7 * 33]);
        *(u32x4*)(WT + (size_t)(n0 + n) * K + k0 + 8 * c) = o; }
    asm volatile("s_waitcnt lgkmcnt(0)" ::: "memory");
}
__device__ __forceinline__ void phase0(const Args& a, LAS unsigned char* lds, int tid, int lane, int wave) {
    unsigned char* ws = a.ws;
    for (int idx = blockIdx.x * 512 + tid; idx < SKV * 16; idx += gridDim.x * 512) {
        const int pos = idx >> 4, i = idx & 15;
        const float inv = exp2f(-(float)i * (13.287712379549449f / 16.f));
        const float ang = (float)pos * inv;
        double t = (double)ang * 0.15915494309189535; t -= floor(t);
        const float rev = (float)t;
        ((f32x2*)(ws + WS_ROPE))[idx] = (f32x2){__builtin_amdgcn_cosf(rev), __builtin_amdgcn_sinf(rev)};
    }
    if (blockIdx.x < 96) {
        LAS float* sc = (LAS float*)lds;
        LAS float* red = (LAS float*)(lds + 98304);
        for (int i = tid; i < 24 * 1024; i += 512) { const int r = i >> 10, k = i & 1023; const float v = r < 8 ? a.in[I_CP][r * 1024 + k] : a.in[I_CS][(r - 8) * 1024 + k]; sc[i] = siluf_(v); }
        __syncthreads();
        const int col = blockIdx.x * 64 + lane; const float* wp = a.in[I_ADAW] + (size_t)(wave * 128) * 6144 + col;
        float acc[24];
#pragma unroll
        for (int r = 0; r < 24; ++r) acc[r] = 0.f;
        for (int k4 = 0; k4 < 32; ++k4) {
            const float w0 = wp[(size_t)(4 * k4) * 6144], w1 = wp[(size_t)(4 * k4 + 1) * 6144], w2 = wp[(size_t)(4 * k4 + 2) * 6144], w3 = wp[(size_t)(4 * k4 + 3) * 6144];
#pragma unroll
            for (int r = 0; r < 24; ++r) { const f32x4 s = *(const LAS f32x4*)(sc + r * 1024 + wave * 128 + 4 * k4); acc[r] += s[0] * w0 + s[1] * w1 + s[2] * w2 + s[3] * w3; }
        }
#pragma unroll
        for (int r = 0; r < 24; ++r) red[(wave * 24 + r) * 64 + lane] = acc[r];
        __syncthreads();
        for (int i = tid; i < 24 * 64; i += 512) { const int r = i >> 6, c = i & 63; float s = a.in[I_ADAB][blockIdx.x * 64 + c];
#pragma unroll
            for (int w = 0; w < 8; ++w) s += red[(w * 24 + r) * 64 + c];
            ((float*)(ws + WS_MOD))[r * 6144 + blockIdx.x * 64 + c] = s; }
        __syncthreads();
    }
    LAS float* scr = (LAS float*)(lds + wave * 8448);
    constexpr int N0 = 16 * 152, N1 = 6 * 24, N2 = 4 * 16, N3 = 4 * 16, N4 = 8 * 32, N5 = 8 * 32, N6 = 16 * 32, N7 = 16 * 128, N8 = 64 * 32;
    constexpr int NT = N0 + N1 + N2 + N3 + N4 + N5 + N6 + N7 + N8;
    const int G = gridDim.x, vw = G > 96 ? ((int)blockIdx.x - 96) * 8 + wave : (int)blockIdx.x * 8 + wave, NW = G > 96 ? (G - 96) * 8 : G * 8;
    if (vw >= 0)
#pragma unroll 1
    for (int it0 = vw; it0 < NT * REPK(0); it0 += NW) {
        int it = it0 % NT;
        if (it < N0) { transpose_item(a.in[I_WIN], 1024, NIN, (bf16_t*)(ws + WS_WIN), scr, 152, 0, it, lane); continue; } it -= N0;
        if (it < N1) { transpose_item(a.in[I_WUQ], 384, 768, (bf16_t*)(ws + WS_WUQ), scr, 24, 1, it, lane); continue; } it -= N1;
        if (it < N2) { transpose_item(a.in[I_WUKV], 256, 1024, (bf16_t*)(ws + WS_WUK), scr, 16, 2, it, lane); continue; } it -= N2;
        if (it < N3) { transpose_item(a.in[I_WUKV], 256, 1024, (bf16_t*)(ws + WS_WUV), scr, 16, 3, it, lane); continue; } it -= N3;
        if (it < N4) { transpose_item(a.in[I_WGO], 512, 1024, (bf16_t*)(ws + WS_WGO), scr, 32, 1, it, lane); continue; } it -= N4;
        if (it < N5) { transpose_item(a.in[I_WMO], 512, 1024, (bf16_t*)(ws + WS_WMO), scr, 32, 1, it, lane); continue; } it -= N5;
        if (it < N6) { transpose_item(a.in[I_WO], 1024, 1024, (bf16_t*)(ws + WS_WO), scr, 32, 1, it, lane); continue; } it -= N6;
        if (it < N7) { transpose_item(a.in[I_WF1], 1024, 4096, (bf16_t*)(ws + WS_WF1), scr, 128, 1, it, lane); continue; } it -= N7;
        transpose_item(a.in[I_WF2], 4096, 1024, (bf16_t*)(ws + WS_WF2), scr, 32, 1, it, lane);
    }
}

__device__ __forceinline__ void norm_rows(const float* xp, const float* xs, const float* g, const float* mod, int shift_off, int scale_off, bf16_t* out, int gw, int lane) {
    for (int r = gw; r < MR; r += 2048) {
        const float* xr = r < MP ? xp + (size_t)r * 1024 : xs + (size_t)(r - MP) * 1024;
        const float* mr = mod + mod_row(r) * 6144;
        f32x4 v[4]; float ss = 0.f;
#pragma unroll
        for (int j = 0; j < 4; ++j) { v[j] = *(const f32x4*)(xr + 4 * (lane + 64 * j)); ss += v[j][0] * v[j][0] + v[j][1] * v[j][1] + v[j][2] * v[j][2] + v[j][3] * v[j][3]; }
        const float rs = rsqrtf(wave_sum(ss) * (1.f / 1024.f) + EPS);
#pragma unroll
        for (int j = 0; j < 4; ++j) { const int col = 4 * (lane + 64 * j);
            const f32x4 gg = *(const f32x4*)(g + col), sc = *(const f32x4*)(mr + scale_off + col), sh = *(const f32x4*)(mr + shift_off + col);
            const f32x4 y = v[j] * rs * gg * (sc + 1.f) + sh;
            u32x2 w; w.x = cvt_pk_bf16(y[0], y[1]); w.y = cvt_pk_bf16(y[2], y[3]);
            *(u32x2*)(out + (size_t)r * 1024 + col) = w; }
    }
}

__device__ __forceinline__ void mla_rows(const Args& a, int gw, int lane) {
    unsigned char* ws = a.ws; float* out = a.out;
    bf16_t* cq = (bf16_t*)(ws + WS_CQ); const bf16_t* ckvraw = (const bf16_t*)(ws + WS_CKVRAW); const float* krraw = (const float*)(ws + WS_KRRAW);
    bf16_t* ckvrows = (bf16_t*)(ws + WS_CKVROWS); const f32x2* rope = (const f32x2*)(ws + WS_ROPE);
    for (int r = gw; r < MR; r += 2048) {
        { float v[8]; float ss = 0.f;
          if (lane < 48) { const u32x4 w = *(const u32x4*)(cq + (size_t)r * 384 + 8 * lane);
              v[0] = bflo(w.x); v[1] = bfhi(w.x); v[2] = bflo(w.y); v[3] = bfhi(w.y); v[4] = bflo(w.z); v[5] = bfhi(w.z); v[6] = bflo(w.w); v[7] = bfhi(w.w);
#pragma unroll
              for (int e = 0; e < 8; ++e) ss += v[e] * v[e]; }
          const float rs = rsqrtf(wave_sum(ss) * (1.f / 384.f) + EPS);
          if (lane < 48) {
#pragma unroll
              for (int e = 0; e < 8; ++e) v[e] = v[e] * rs * a.in[I_QNG][8 * lane + e];
              *(u32x4*)(cq + (size_t)r * 384 + 8 * lane) = pack8(v); } }
        { float v[8]; float ss = 0.f;
          if (lane < 32) { const u32x4 w = *(const u32x4*)(ckvraw + (size_t)r * 256 + 8 * lane);
              v[0] = bflo(w.x); v[1] = bfhi(w.x); v[2] = bflo(w.y); v[3] = bfhi(w.y); v[4] = bflo(w.z); v[5] = bfhi(w.z); v[6] = bflo(w.w); v[7] = bfhi(w.w);
#pragma unroll
              for (int e = 0; e < 8; ++e) ss += v[e] * v[e]; }
          const float rs = rsqrtf(wave_sum(ss) * (1.f / 256.f) + EPS);
          if (lane < 32) {
#pragma unroll
              for (int e = 0; e < 8; ++e) v[e] = v[e] * rs * a.in[I_KVNG][8 * lane + e];
              float* o = r < MP ? out + O_CKVP + (size_t)r * 256 : out + O_CKVS + (size_t)(r - MP) * 256;
              *(f32x4*)(o + 8 * lane) = (f32x4){v[0], v[1], v[2], v[3]}; *(f32x4*)(o + 8 * lane + 4) = (f32x4){v[4], v[5], v[6], v[7]};
              const size_t R = r < MP ? (size_t)r : (size_t)MP + (size_t)((r - MP) >> 4) * SKV + PAST + ((r - MP) & 15);
              *(u32x4*)(ckvrows + R * 256 + 8 * lane) = pack8(v); } }
        if (lane < 16) { const int pos = r < MP ? (r & 2047) : PAST + ((r - MP) & 15);
            const float x1 = krraw[(size_t)r * 32 + lane], x2 = krraw[(size_t)r * 32 + 16 + lane]; const f32x2 cs = rope[pos * 16 + lane];
            float* o = r < MP ? out + O_KRP + (size_t)r * 32 : out + O_KRS + (size_t)(r - MP) * 32;
            o[lane] = x1 * cs.x - x2 * cs.y; o[16 + lane] = x2 * cs.x + x1 * cs.y; }
    }
}

template <int I> struct SolveRow {
    static __device__ __forceinline__ void run(float (&x)[64], const LAS float* A, const LAS bf16_t* src, const LAS float* scp) {
        float s = scp[I] * bf2f(src[I * 72]);
#pragma unroll
        for (int j4 = 0; j4 < (I + 3) / 4; ++j4) { const f32x4 av = *(const LAS f32x4*)(A + I * 64 + 4 * j4);
#pragma unroll
            for (int e = 0; e < 4; ++e) if (4 * j4 + e < I) s -= av[e] * x[4 * j4 + e]; }
        x[I] = s;
        SolveRow<I + 1>::run(x, A, src, scp);
    }
};
template <> struct SolveRow<64> { static __device__ __forceinline__ void run(float (&)[64], const LAS float*, const LAS bf16_t*, const LAS float*) {} };

__device__ __forceinline__ void gdn_prep(const Args& a, LAS unsigned char* lds, int tid) {
    const int slot = tid >> 7, w2 = __builtin_amdgcn_readfirstlane((tid >> 6) & 1), lane = tid & 63;
    LAS unsigned char* sl = lds + slot * 35584;
    LAS bf16_t* q_lds = (LAS bf16_t*)sl; LAS float* A_lds = (LAS float*)sl;
    LAS bf16_t* k_lds = (LAS bf16_t*)(sl + 16384); LAS bf16_t* v_lds = (LAS bf16_t*)(sl + 25600);
    LAS float* gcs = (LAS float*)(sl + 34816); LAS float* bts = (LAS float*)(sl + 35072); LAS float* scw = (LAS float*)(sl + 35328);
    const bf16_t* gqkv = (const bf16_t*)(a.ws + WS_GQKV); const float* ab = (const float*)(a.ws + WS_AB); const float* cw = a.in[I_CONVW];
#pragma unroll 1
    for (int qi = blockIdx.x; qi < 512 * REPK(3); qi += gridDim.x) {
        const int item = (qi & 511) * 4 + slot, bh = item >> 5, n = item & 31, b = bh >> 3, h = bh & 7;
        const int r0 = b * SP + 64 * n, t = lane;
        unsigned char* rec = a.ws + WS_PREP + (size_t)item * REC_BYTES;
        LAS float* cwl = (LAS float*)(sl + 9216);
        for (int i = tid & 127; i < 768; i += 128) { const int tap = i / 192, cc = i - tap * 192; cwl[i] = cw[tap * 1536 + (cc >> 6) * 512 + h * 64 + (cc & 63)]; }
        __syncthreads();
        {
            const int colbase = w2 * 512 + h * 64;
            float o[64];
#pragma unroll
            for (int c = 0; c < 64; ++c) o[c] = 0.f;
#pragma unroll 1
            for (int tap = 0; tap < 4; ++tap) { const int rr = t - 3 + tap; const bool valid = (n > 0) || (rr >= 0);
                const bf16_t* src = gqkv + (size_t)(r0 + (valid ? rr : 0)) * 1536 + colbase;
#pragma unroll
                for (int c8 = 0; c8 < 8; ++c8) { u32x4 w = *(const u32x4*)(src + 8 * c8); if (!valid) w = (u32x4){0u, 0u, 0u, 0u};
                    const f32x4 wa = *(const LAS f32x4*)(cwl + tap * 192 + w2 * 64 + 8 * c8), wb = *(const LAS f32x4*)(cwl + tap * 192 + w2 * 64 + 8 * c8 + 4);
                    o[8 * c8 + 0] += wa[0] * bflo(w.x); o[8 * c8 + 1] += wa[1] * bfhi(w.x); o[8 * c8 + 2] += wa[2] * bflo(w.y); o[8 * c8 + 3] += wa[3] * bfhi(w.y);
                    o[8 * c8 + 4] += wb[0] * bflo(w.z); o[8 * c8 + 5] += wb[1] * bfhi(w.z); o[8 * c8 + 6] += wb[2] * bflo(w.w); o[8 * c8 + 7] += wb[3] * bfhi(w.w); } }
            float ss = 0.f;
#pragma unroll
            for (int c = 0; c < 64; ++c) { o[c] = siluf_(o[c]); ss += o[c] * o[c]; }
            const float sc = rsqrtf(ss + EPS) * (w2 ? 1.f : 0.125f);
            LAS bf16_t* dst = (w2 ? k_lds : q_lds) + t * 72;
#pragma unroll
            for (int c8 = 0; c8 < 8; ++c8) { float v[8];
#pragma unroll
                for (int e = 0; e < 8; ++e) v[e] = o[8 * c8 + e] * sc;
                *(LAS u32x4*)(dst + 8 * c8) = pack8(v); }
        }
        {
            const int colbase = 1024 + h * 64 + 32 * w2;
            float o[32];
#pragma unroll
            for (int c = 0; c < 32; ++c) o[c] = 0.f;
#pragma unroll 1
            for (int tap = 0; tap < 4; ++tap) { const int rr = t - 3 + tap; const bool valid = (n > 0) || (rr >= 0);
                const bf16_t* src = gqkv + (size_t)(r0 + (valid ? rr : 0)) * 1536 + colbase;
#pragma unroll
                for (int c8 = 0; c8 < 4; ++c8) { u32x4 w = *(const u32x4*)(src + 8 * c8); if (!valid) w = (u32x4){0u, 0u, 0u, 0u};
                    const f32x4 wa = *(const LAS f32x4*)(cwl + tap * 192 + 128 + 32 * w2 + 8 * c8), wb = *(const LAS f32x4*)(cwl + tap * 192 + 128 + 32 * w2 + 8 * c8 + 4);
                    o[8 * c8 + 0] += wa[0] * bflo(w.x); o[8 * c8 + 1] += wa[1] * bfhi(w.x); o[8 * c8 + 2] += wa[2] * bflo(w.y); o[8 * c8 + 3] += wa[3] * bfhi(w.y);
                    o[8 * c8 + 4] += wb[0] * bflo(w.z); o[8 * c8 + 5] += wb[1] * bfhi(w.z); o[8 * c8 + 6] += wb[2] * bflo(w.w); o[8 * c8 + 7] += wb[3] * bfhi(w.w); } }
#pragma unroll
            for (int c8 = 0; c8 < 4; ++c8) { float v[8];
#pragma unroll
                for (int e = 0; e < 8; ++e) v[e] = siluf_(o[8 * c8 + e]);
                *(LAS u32x4*)(v_lds + t * 72 + 32 * w2 + 8 * c8) = pack8(v); }
        }
        float gc, gcl;
        {
            const float av = ab[(size_t)(r0 + t) * 16 + h], bv = ab[(size_t)(r0 + t) * 16 + 8 + h];
            const float xg = av + a.in[I_DTB][h];
            const float sp = fmaxf(xg, 0.f) + __logf(1.f + __expf(-fabsf(xg)));
            gc = -__expf(a.in[I_ALOG][h]) * sp;
#pragma unroll
            for (int o = 1; o < 64; o <<= 1) { const float u = __shfl_up(gc, o); if (lane >= o) gc += u; }
            gcl = __shfl(gc, 63);
            if (w2 == 0) { const float be = sigmoidf_(bv); gcs[t] = gc; bts[t] = be; scw[t] = be * __expf(gc); if (lane == 0) *(float*)(rec + 40960) = __expf(gcl); }
        }
        __syncthreads();
#pragma unroll
        for (int it = 0; it < 8; ++it) { const int ri = (lane >> 3) + 8 * it, pg = lane & 7, d0 = 32 * (pg >> 2) + 4 * (pg & 3);
            float v[8];
            if (w2 == 0) { const u32x2 w0 = *(const LAS u32x2*)(q_lds + ri * 72 + d0), w1 = *(const LAS u32x2*)(q_lds + ri * 72 + d0 + 16); const float e = __expf(gcs[ri]);
                v[0] = bflo(w0.x) * e; v[1] = bfhi(w0.x) * e; v[2] = bflo(w0.y) * e; v[3] = bfhi(w0.y) * e; v[4] = bflo(w1.x) * e; v[5] = bfhi(w1.x) * e; v[6] = bflo(w1.y) * e; v[7] = bfhi(w1.y) * e;
                *(u32x4*)(rec + 8192 + (ri * 64 + 8 * pg) * 2) = pack8(v); }
            else {
#pragma unroll
                for (int j = 0; j < 8; ++j) { const int c = d0 + 16 * (j >> 2) + (j & 3); v[j] = bf2f(k_lds[c * 72 + ri]) * __expf(gcl - gcs[c]); }
                *(u32x4*)(rec + 24576 + (ri * 64 + 8 * pg) * 2) = pack8(v); } }
        const int m_ = lane & 15, g4 = lane >> 4;
        f32x4 acc[4][4];
        {
            bf16x8 ka[4][2], bb[4][2];
            const LAS bf16_t* bsrc = w2 ? k_lds : q_lds;
#pragma unroll
            for (int jt = 0; jt < 4; ++jt)
#pragma unroll
                for (int ks = 0; ks < 2; ++ks) { ka[jt][ks] = *(const LAS bf16x8*)(k_lds + (16 * jt + m_) * 72 + 32 * ks + 8 * g4); bb[jt][ks] = *(const LAS bf16x8*)(bsrc + (16 * jt + m_) * 72 + 32 * ks + 8 * g4); }
#pragma unroll
            for (int jt = 0; jt < 4; ++jt)
#pragma unroll
                for (int it = 0; it < 4; ++it) { f32x4 c = (f32x4){0.f, 0.f, 0.f, 0.f};
                    if (it >= jt) {
#pragma unroll
                        for (int ks = 0; ks < 2; ++ks) c = __builtin_amdgcn_mfma_f32_16x16x32_bf16(ka[jt][ks], bb[it][ks], c, 0, 0, 0); }
                    acc[jt][it] = c; }
        }
        __syncthreads();
#pragma unroll
        for (int jt = 0; jt < 4; ++jt)
#pragma unroll
            for (int it = 0; it < 4; ++it) { const int i = 16 * it + m_, j0 = 16 * jt + 4 * g4; const float gi = gcs[i]; const f32x4 gj = *(const LAS f32x4*)(gcs + j0);
                float v[4];
                if (w2 == 0) {
#pragma unroll
                    for (int e = 0; e < 4; ++e) { const bool keep = it > jt ? true : (it < jt ? false : m_ >= 4 * g4 + e); v[e] = keep ? acc[jt][it][e] * __expf(keep ? gi - gj[e] : 0.f) : 0.f; }
                    u32x2 w; w.x = cvt_pk_bf16(v[0], v[1]); w.y = cvt_pk_bf16(v[2], v[3]);
                    *(u32x2*)(rec + 16384 + (i * 64 + 32 * (jt >> 1) + 8 * g4 + 4 * (jt & 1)) * 2) = w; }
                else { const float bi = bts[i];
#pragma unroll
                    for (int e = 0; e < 4; ++e) { const bool keep = it > jt ? true : (it < jt ? false : m_ > 4 * g4 + e); v[e] = keep ? bi * acc[jt][it][e] * __expf(keep ? gi - gj[e] : 0.f) : 0.f; }
                    *(LAS f32x4*)(A_lds + i * 64 + j0) = (f32x4){v[0], v[1], v[2], v[3]}; } }
        __syncthreads();
        {
            const LAS bf16_t* src = w2 ? k_lds : v_lds; const LAS float* scp = w2 ? scw : bts;
            float x[64];
            SolveRow<0>::run(x, A_lds, src + lane, scp);
            if (w2 == 0) {
#pragma unroll
                for (int q = 0; q < 8; ++q) *(u32x4*)(rec + 32768 + (lane * 64 + 8 * q) * 2) = pack8(&x[8 * q]);
            } else { const int pinv = (lane & 32) | (((lane >> 2) & 3) << 3) | (((lane >> 4) & 1) << 2) | (lane & 3);
#pragma unroll
                for (int i = 0; i < 64; ++i) *(bf16_t*)(rec + (i * 64 + pinv) * 2) = f2bf(-x[i]); }
        }
        __syncthreads();
    }
}

__device__ __forceinline__ void misc_p3(const Args& a, int tid) {
    bf16_t* ckvrows = (bf16_t*)(a.ws + WS_CKVROWS); const float* cache = a.in[I_CKV];
    const int gt = blockIdx.x * 512 + tid, GT = gridDim.x * 512;
    for (int i = gt; i < BS * PAST * 32; i += GT) { const int row = i >> 5, c8 = i & 31, s = row >> 11, j = row & 2047;
        const f32x4 v0 = *(const f32x4*)(cache + (size_t)row * 256 + 8 * c8), v1 = *(const f32x4*)(cache + (size_t)row * 256 + 8 * c8 + 4);
        *(u32x4*)(ckvrows + ((size_t)MP + (size_t)s * SKV + j) * 256 + 8 * c8) = pack_v(v0, v1); }
    const bf16_t* gqkv = (const bf16_t*)(a.ws + WS_GQKV);
    for (int i = gt; i < BP * 3 * 1536; i += GT) { const int b = i / 4608, rem = i - b * 4608, r = rem / 1536, c = rem - r * 1536;
        a.out[O_CVP + i] = bf2f(gqkv[(size_t)(b * SP + SP - 3 + r) * 1536 + c]); }
    for (int i = gt; i < BS * 3 * 1536; i += GT) { const int s = i / 4608, rem = i - s * 4608, r = rem / 1536, c = rem - r * 1536;
        a.out[O_CVS + i] = bf2f(gqkv[(size_t)(MP + s * SS + SS - 3 + r) * 1536 + c]); }
}

__device__ __forceinline__ bf16x8 pack_frag(const f32x4 lo, const f32x4 hi) { u32x4 w = pack_v(lo, hi); return __builtin_bit_cast(bf16x8, w); }

__device__ __forceinline__ void scan_prompt(const Args& a, LAS unsigned char* lds, int bh, int tid, int lane, int wave, bool st) {
    const int b = bh >> 3, h = bh & 7;
    const unsigned char* recs = a.ws + WS_PREP + (size_t)bh * 32 * REC_BYTES;
    bf16_t* zo = (bf16_t*)(a.ws + WS_Z);
    LAS float* red = (LAS float*)(lds + 92160);
    const int prow = (tid & 511) >> 3, pc16 = tid & 7;
    const int n_ = lane & 15, g4 = lane >> 4, dv = 16 * wave + n_;
    f32x4 S[4];
#pragma unroll
    for (int kt = 0; kt < 4; ++kt) S[kt] = (f32x4){0.f, 0.f, 0.f, 0.f};
    const float gn = wave < 4 ? a.in[I_GNG][dv] : 0.f;
    { u32x4 p[5];
#pragma unroll
      for (int i = 0; i < 5; ++i) p[i] = *(const u32x4*)(recs + i * 8192 + tid * 16);
#pragma unroll
      for (int i = 0; i < 5; ++i) *(LAS u32x4*)(lds + i * 9216 + prow * 144 + pc16 * 16) = p[i]; }
    __syncthreads();
    for (int n = 0; n < 32; ++n) {
        LAS unsigned char* cur = lds + (n & 1) * 46080; LAS unsigned char* nxt = lds + ((n + 1) & 1) * 46080;
        u32x4 p[5];
        if (n + 1 < 32) {
#pragma unroll
            for (int i = 0; i < 5; ++i) p[i] = *(const u32x4*)(recs + (size_t)(n + 1) * REC_BYTES + i * 8192 + tid * 16); }
        f32x4 O[4];
        float zv[4][4];
        const size_t rowbase = (size_t)b * SP + 64 * n;
        if (wave < 4) {
#pragma unroll
            for (int mt = 0; mt < 4; ++mt)
#pragma unroll
                for (int e = 0; e < 4; ++e) zv[mt][e] = bf2f(zo[(rowbase + 16 * mt + 4 * g4 + e) * 512 + h * 64 + dv]);
            const float gl = *(const float*)(recs + (size_t)n * REC_BYTES + 40960);
            bf16x8 Bs[2];
            Bs[0] = pack_frag(S[0], S[1]); Bs[1] = pack_frag(S[2], S[3]);
            f32x4 VN[4];
#pragma unroll
            for (int mt = 0; mt < 4; ++mt) { const u32x2 w = *(const LAS u32x2*)(cur + 4 * 9216 + dv * 144 + (16 * mt + 4 * g4) * 2);
                f32x4 c = (f32x4){bflo(w.x), bfhi(w.x), bflo(w.y), bfhi(w.y)};
#pragma unroll
                for (int ks = 0; ks < 2; ++ks) c = __builtin_amdgcn_mfma_f32_16x16x32_bf16(*(const LAS bf16x8*)(cur + (16 * mt + n_) * 144 + (32 * ks + 8 * g4) * 2), Bs[ks], c, 0, 0, 0);
                VN[mt] = c;
                f32x4 o = (f32x4){0.f, 0.f, 0.f, 0.f};
#pragma unroll
                for (int ks = 0; ks < 2; ++ks) o = __builtin_amdgcn_mfma_f32_16x16x32_bf16(*(const LAS bf16x8*)(cur + 9216 + (16 * mt + n_) * 144 + (32 * ks + 8 * g4) * 2), Bs[ks], o, 0, 0, 0);
                O[mt] = o; }
            bf16x8 Bv[2];
            Bv[0] = pack_frag(VN[0], VN[1]); Bv[1] = pack_frag(VN[2], VN[3]);
#pragma unroll
            for (int mt = 0; mt < 4; ++mt) {
#pragma unroll
                for (int ks = 0; ks < 2; ++ks) O[mt] = __builtin_amdgcn_mfma_f32_16x16x32_bf16(*(const LAS bf16x8*)(cur + 2 * 9216 + (16 * mt + n_) * 144 + (32 * ks + 8 * g4) * 2), Bv[ks], O[mt], 0, 0, 0);
                f32x4 s = S[mt] * gl;
#pragma unroll
                for (int ks = 0; ks < 2; ++ks) s = __builtin_amdgcn_mfma_f32_16x16x32_bf16(*(const LAS bf16x8*)(cur + 3 * 9216 + (16 * mt + n_) * 144 + (32 * ks + 8 * g4) * 2), Bv[ks], s, 0, 0, 0);
                S[mt] = s; }
#pragma unroll
            for (int mt = 0; mt < 4; ++mt)
#pragma unroll
                for (int e = 0; e < 4; ++e) { float q = O[mt][e] * O[mt][e]; q += __shfl_xor(q, 1); q += __shfl_xor(q, 2); q += __shfl_xor(q, 4); q += __shfl_xor(q, 8);
                    if (n_ == 0) red[((n & 1) * 4 + wave) * 64 + 16 * mt + 4 * g4 + e] = q; }
        }
        if (n + 1 < 32) {
#pragma unroll
            for (int i = 0; i < 5; ++i) *(LAS u32x4*)(nxt + i * 9216 + prow * 144 + pc16 * 16) = p[i]; }
        __syncthreads();
        if (wave < 4) {
#pragma unroll
            for (int mt = 0; mt < 4; ++mt)
#pragma unroll
                for (int e = 0; e < 4; ++e) { const int c = 16 * mt + 4 * g4 + e; const LAS float* rp = red + (n & 1) * 256 + c;
                    const float ss = rp[0] + rp[64] + rp[128] + rp[192];
                    const float val = O[mt][e] * rsqrtf(ss * (1.f / 64.f) + EPS) * gn * siluf_(zv[mt][e]);
                    if (st) zo[(rowbase + c) * 512 + h * 64 + dv] = f2bf(val); }
        }
    }
    if (wave < 4 && st) { float* so = a.out + O_STP + (size_t)bh * 4096;
#pragma unroll
        for (int kt = 0; kt < 4; ++kt)
#pragma unroll
            for (int e = 0; e < 4; ++e) so[(16 * kt + 4 * g4 + e) * 64 + dv] = S[kt][e]; }
}

__device__ __forceinline__ void gdn_sample(const Args& a, LAS unsigned char* lds, int u, int tid, int lane, int wave, bool st) {
    const int s = u >> 3, h = u & 7;
    LAS float* raw = (LAS float*)lds;
    LAS float* qkv = raw + 19 * 192;
    LAS float* gs = qkv + 16 * 192;
    LAS float* pa = gs + 32;
    LAS float* pb = pa + 512;
    LAS float* ol = pb + 512;
    const bf16_t* gqkv = (const bf16_t*)(a.ws + WS_GQKV); const float* ab = (const float*)(a.ws + WS_AB);
    for (int i = tid; i < 19 * 192; i += 512) { const int r = i / 192, cc = i - r * 192, seg = cc >> 6, c = cc & 63, col = seg * 512 + h * 64 + c;
        raw[i] = r < 3 ? a.in[I_CONV][((size_t)s * 3 + r) * 1536 + col] : bf2f(gqkv[(size_t)(MP + s * SS + (r - 3)) * 1536 + col]); }
    if (tid < 16) { const size_t row = (size_t)MP + s * SS + tid; const float av = ab[row * 16 + h], bv = ab[row * 16 + 8 + h];
        const float xg = av + a.in[I_DTB][h]; const float sp = fmaxf(xg, 0.f) + __logf(1.f + __expf(-fabsf(xg)));
        gs[tid] = __expf(-__expf(a.in[I_ALOG][h]) * sp); gs[16 + tid] = sigmoidf_(bv); }
    __syncthreads();
    for (int i = tid; i < 16 * 192; i += 512) { const int t = i / 192, cc = i - t * 192, seg = cc >> 6, c = cc & 63, col = seg * 512 + h * 64 + c;
        float y = 0.f;
#pragma unroll
        for (int tap = 0; tap < 4; ++tap) y += a.in[I_CONVW][tap * 1536 + col] * raw[(t + tap) * 192 + cc];
        qkv[i] = siluf_(y); }
    __syncthreads();
    for (int v = wave; v < 32; v += 8) { const int t = v >> 1, seg = v & 1; const float x = qkv[t * 192 + seg * 64 + lane];
        const float ss = wave_sum(x * x); qkv[t * 192 + seg * 64 + lane] = x * rsqrtf(ss + EPS) * (seg ? 1.f : 0.125f); }
    __syncthreads();
    const int dv = tid & 63, dkg = tid >> 6;
    float S[8];
    const float* s0 = a.in[I_ST] + (size_t)u * 4096;
#pragma unroll
    for (int i = 0; i < 8; ++i) S[i] = s0[(8 * dkg + i) * 64 + dv];
    for (int t = 0; t < 16; ++t) {
        const float eg = gs[t], bt = gs[16 + t];
        const LAS float* qr = qkv + t * 192; const LAS float* kr = qr + 64; const float vv = qr[128 + dv];
        float part = 0.f;
#pragma unroll
        for (int i = 0; i < 8; ++i) { S[i] *= eg; part += kr[8 * dkg + i] * S[i]; }
        pa[dkg * 64 + dv] = part;
        __syncthreads();
        float ks = 0.f;
#pragma unroll
        for (int w = 0; w < 8; ++w) ks += pa[w * 64 + dv];
        const float dl = bt * (vv - ks);
        float po = 0.f;
#pragma unroll
        for (int i = 0; i < 8; ++i) { S[i] += kr[8 * dkg + i] * dl; po += qr[8 * dkg + i] * S[i]; }
        pb[dkg * 64 + dv] = po;
        __syncthreads();
        if (dkg == 0) { float o = 0.f;
#pragma unroll
            for (int w = 0; w < 8; ++w) o += pb[w * 64 + dv];
            ol[t * 64 + dv] = o; }
    }
    __syncthreads();
    float* so = a.out + O_STS + (size_t)u * 4096;
#pragma unroll
    for (int i = 0; i < 8; ++i) if (st) so[(8 * dkg + i) * 64 + dv] = S[i];
    bf16_t* zo = (bf16_t*)(a.ws + WS_Z);
    for (int t = wave; t < 16; t += 8) { const float o = ol[t * 64 + lane]; const float ss = wave_sum(o * o);
        const size_t idx = ((size_t)MP + s * SS + t) * 512 + h * 64 + lane;
        const bf16_t res = f2bf(o * rsqrtf(ss * (1.f / 64.f) + EPS) * a.in[I_GNG][lane] * siluf_(bf2f(zo[idx]))); if (st) zo[idx] = res; }
}

struct AttnWave { int qrow, pos, mylast; bool qvalid; };
__device__ __forceinline__ void attn_unit(const Args& a, LAS unsigned char* lds, const bf16_t* Kb, const bf16_t* VTb, int pitch, int head, int ntiles, int nkeys,
                                          const AttnWave w, float boff, int tid, int lane) {
    const int r = lane & 31, hh = lane >> 5;
    const bf16_t* qraw = (const bf16_t*)(a.ws + WS_QRAW); const f32x2* rope = (const f32x2*)(a.ws + WS_ROPE);
    bf16x8 Qf[6];
    {
        const bf16_t* qp = qraw + (size_t)w.qrow * 768 + head * 96 + 8 * hh;
        float v[6][8]; float ss = 0.f;
#pragma unroll
        for (int s = 0; s < 6; ++s) { const u32x4 u = *(const u32x4*)(qp + 16 * s);
            v[s][0] = bflo(u.x); v[s][1] = bfhi(u.x); v[s][2] = bflo(u.y); v[s][3] = bfhi(u.y); v[s][4] = bflo(u.z); v[s][5] = bfhi(u.z); v[s][6] = bflo(u.w); v[s][7] = bfhi(u.w); }
#pragma unroll
        for (int e = 0; e < 8; ++e) { const f32x2 cs = rope[w.pos * 16 + 8 * hh + e]; const float x1 = v[4][e], x2 = v[5][e]; v[4][e] = x1 * cs.x - x2 * cs.y; v[5][e] = x2 * cs.x + x1 * cs.y; }
#pragma unroll
        for (int s = 0; s < 6; ++s)
#pragma unroll
            for (int e = 0; e < 8; ++e) ss += v[s][e] * v[s][e];
        ss += __shfl_xor(ss, 32);
        const float rs = rsqrtf(ss * (1.f / 96.f) + EPS) * (1.4426950408889634f * 0.10206207261596575f);
#pragma unroll
        for (int s = 0; s < 6; ++s) { float o[8];
#pragma unroll
            for (int e = 0; e < 8; ++e) o[e] = v[s][e] * rs * a.in[I_QHG][16 * s + 8 * hh + e];
            Qf[s] = __builtin_bit_cast(bf16x8, pack8(o)); }
    }
    const int kp0row = tid / 12, kp0c = tid - kp0row * 12, kp1row = (tid + 512) / 12, kp1c = (tid + 512) - kp1row * 12, vrow = tid >> 3, vc = tid & 7;
    const int pr = (r & 19) | ((r & 4) << 1) | ((r & 8) >> 1);
    f32x16 oa[2];
#pragma unroll
    for (int i = 0; i < 16; ++i) { oa[0][i] = 0.f; oa[1][i] = 0.f; }
    float lsum = 0.f;
    u32x4 k0, k1, vv;
    k0 = *(const u32x4*)(Kb + (size_t)kp0row * 768 + kp0c * 8); if (tid < 256) k1 = *(const u32x4*)(Kb + (size_t)kp1row * 768 + kp1c * 8);
    vv = *(const u32x4*)(VTb + (size_t)vrow * pitch + vc * 8);
    *(LAS u32x4*)(lds + kp0row * 208 + kp0c * 16) = k0; if (tid < 256) *(LAS u32x4*)(lds + kp1row * 208 + kp1c * 16) = k1;
    *(LAS u32x4*)(lds + 13312 + vrow * 144 + vc * 16) = vv;
    __syncthreads();
    for (int kt = 0; kt < ntiles; ++kt) {
        LAS unsigned char* cur = lds + (kt & 1) * 22528; LAS unsigned char* nxt = lds + ((kt + 1) & 1) * 22528;
        const int key0 = kt * 64;
        if (kt + 1 < ntiles) { const bf16_t* kn = Kb + (size_t)(key0 + 64) * 768;
            k0 = *(const u32x4*)(kn + (size_t)kp0row * 768 + kp0c * 8); if (tid < 256) k1 = *(const u32x4*)(kn + (size_t)kp1row * 768 + kp1c * 8);
            vv = *(const u32x4*)(VTb + (size_t)vrow * pitch + key0 + 64 + vc * 8); }
        if (kt <= w.mylast) {
            f32x16 sa[2];
#pragma unroll
            for (int t2 = 0; t2 < 2; ++t2) {
#pragma unroll
                for (int i = 0; i < 16; ++i) sa[t2][i] = 0.f;
#pragma unroll
                for (int s = 0; s < 6; ++s) sa[t2] = __builtin_amdgcn_mfma_f32_32x32x16_bf16(*(const LAS bf16x8*)(cur + (32 * t2 + pr) * 208 + (16 * s + 8 * hh) * 2), Qf[s], sa[t2], 0, 0, 0);
            }
            const bool tail = key0 + 64 > nkeys;
            bf16x8 Pf[2][2];
#pragma unroll
            for (int t2 = 0; t2 < 2; ++t2) { float p[16];
#pragma unroll
                for (int jj = 0; jj < 16; ++jj) { float e = __builtin_amdgcn_exp2f(sa[t2][jj] - boff);
                    if (tail) { const int key = key0 + 32 * t2 + (jj & 3) + 4 * ((jj >> 2) & 1) + 8 * hh + 16 * (jj >> 3); if (key >= nkeys) e = 0.f; }
                    p[jj] = e; lsum += e; }
                Pf[t2][0] = __builtin_bit_cast(bf16x8, pack8(&p[0])); Pf[t2][1] = __builtin_bit_cast(bf16x8, pack8(&p[8])); }
#pragma unroll
            for (int mt = 0; mt < 2; ++mt)
#pragma unroll
                for (int t2 = 0; t2 < 2; ++t2)
#pragma unroll
                    for (int s2 = 0; s2 < 2; ++s2)
                        oa[mt] = __builtin_amdgcn_mfma_f32_32x32x16_bf16(*(const LAS bf16x8*)(cur + 13312 + (32 * mt + r) * 144 + (32 * t2 + 16 * s2 + 8 * hh) * 2), Pf[t2][s2], oa[mt], 0, 0, 0);
        }
        if (kt + 1 < ntiles) { *(LAS u32x4*)(nxt + kp0row * 208 + kp0c * 16) = k0; if (tid < 256) *(LAS u32x4*)(nxt + kp1row * 208 + kp1c * 16) = k1;
            *(LAS u32x4*)(nxt + 13312 + vrow * 144 + vc * 16) = vv; }
        __syncthreads();
    }
    lsum += __shfl_xor(lsum, 32);
    if (w.qvalid && w.mylast >= 0) { const float inv = 1.f / lsum; bf16_t* op = (bf16_t*)(a.ws + WS_OMLA) + (size_t)w.qrow * 512 + head * 64 + 4 * hh;
#pragma unroll
        for (int mt = 0; mt < 2; ++mt)
#pragma unroll
            for (int q4 = 0; q4 < 4; ++q4) { u32x2 o; o.x = cvt_pk_bf16(oa[mt][4 * q4] * inv, oa[mt][4 * q4 + 1] * inv); o.y = cvt_pk_bf16(oa[mt][4 * q4 + 2] * inv, oa[mt][4 * q4 + 3] * inv);
                *(u32x2*)(op + 32 * mt + 8 * q4) = o; } }
}
__device__ __forceinline__ void attn_phase(const Args& a, LAS unsigned char* lds, int tid, int lane, int wave) {
    const int c = blockIdx.x, G = gridDim.x;
    float mq = fabsf(a.in[I_QHG][lane]), mk = fabsf(a.in[I_KHG][lane]);
    if (lane < 32) { mq = fmaxf(mq, fabsf(a.in[I_QHG][64 + lane])); mk = fmaxf(mk, fabsf(a.in[I_KHG][64 + lane])); }
    const float boff = 9.797958971132712f * wave_max(mq) * wave_max(mk) * 1.4426950408889634f;
    const bf16_t* Kbuf = (const bf16_t*)(a.ws + WS_KBUF); const bf16_t* VT = (const bf16_t*)(a.ws + WS_VT);
#pragma unroll 1
    for (int rep = 0; rep < REPK(6); ++rep) {
    for (int p = c; p < 256; p += G) { const int bh = p >> 2, b = bh >> 3, h = bh & 7;
#pragma unroll 1
        for (int half = 0; half < 2; ++half) { const int qb = half ? 7 - (p & 3) : (p & 3);
            AttnWave w; w.pos = 256 * qb + 32 * wave + (lane & 31); w.qrow = b * SP + w.pos; w.mylast = 4 * qb + (wave >> 1); w.qvalid = true;
            attn_unit(a, lds, Kbuf + (size_t)b * SP * 768 + h * 96, VT + (size_t)bh * 64 * SP, SP, h, 4 * qb + 4, SP, w, boff, tid, lane); } }
    for (int u = (c + G / 2) % G; u < BS * 8; u += G) { const int s = u >> 3, h = u & 7;
        AttnWave w; w.pos = PAST + (lane & 15); w.qrow = MP + s * SS + (lane & 15); w.mylast = wave == 0 ? 32 : -1; w.qvalid = (lane & 31) < 16;
        attn_unit(a, lds, Kbuf + ((size_t)MP + (size_t)s * SKV) * 768 + h * 96, VT + VT_SAMPLE_OFF + (size_t)u * 64 * SKV, SKV, h, 33, SKV, w, boff, tid, lane); }
    }
}

#define XB_TMO      128
#define XB_XCNT(j)  (256  + 64 * (j))
#define XB_XSUB(j)  (1280 + 64 * (j))
#define XB_XGEN(j)  (2304 + 64 * (j))
#define XB_TOP      3328
#define XB_TOPGEN   3392
#define XCD_BAR_WORDS 3456
#define XB_SPIN_CAP (1u << 18)

__device__ __forceinline__ unsigned xb_ld(unsigned* p)              { return __hip_atomic_load(p, __ATOMIC_RELAXED, __HIP_MEMORY_SCOPE_AGENT); }
__device__ __forceinline__ unsigned xb_add(unsigned* p, unsigned v) { return __hip_atomic_fetch_add(p, v, __ATOMIC_RELAXED, __HIP_MEMORY_SCOPE_AGENT); }
__device__ __forceinline__ unsigned xb_xcc_id() { return (unsigned)__builtin_amdgcn_s_getreg((3 << 11) | 20) & 0xFu; }
#define XB_SPIN(cond, bar) do { unsigned _sp = 0; while (cond) { __builtin_amdgcn_s_sleep(1); \
    if ((++_sp & 255u) == 0u) { if (xb_ld(&(bar)[XB_TMO])) break; if (_sp > XB_SPIN_CAP) { atomicAdd(&(bar)[XB_TMO], 1u); break; } } } } while (0)

struct XcdBarrier {
    unsigned* bar; unsigned x;
    volatile LAS unsigned* st;
};

__device__ __forceinline__ XcdBarrier xcd_barrier_post(unsigned* bar, volatile LAS unsigned* st) {
    XcdBarrier b; b.bar = bar; b.x = xb_xcc_id(); b.st = st;
    if (threadIdx.x == 0) (void)xb_add(&bar[XB_XCNT(b.x)], 1u);
    return b;
}
__device__ __forceinline__ void xcd_barrier_complete(unsigned* bar, unsigned x, unsigned& nloc, unsigned& nx) {
    const unsigned G = gridDim.x * gridDim.y * gridDim.z;
    unsigned sum, cnt, mine, sp = 0u;
    for (;;) {
        sum = 0u; cnt = 0u; mine = 0u;
#pragma unroll
        for (unsigned j = 0; j < 16; ++j) { const unsigned c = xb_ld(&bar[XB_XCNT(j)]); sum += c; cnt += (c > 0u) ? 1u : 0u; mine = (j == x) ? c : mine; }
        if (sum == G) break;
        __builtin_amdgcn_s_sleep(1);
        if ((++sp & 255u) == 0u) { if (xb_ld(&bar[XB_TMO])) break; if (sp > XB_SPIN_CAP) { atomicAdd(&bar[XB_TMO], 1u); break; } }
    }
    nloc = mine > 0u ? mine : 1u; nx = cnt > 0u ? cnt : 1u;
}

__device__ __forceinline__ void xcd_barrier(const XcdBarrier& b) {
    asm volatile("s_waitcnt vmcnt(0)" ::: "memory");
    __syncthreads();
    if (threadIdx.x == 0) {
        unsigned* bar = b.bar;
        __builtin_amdgcn_s_waitcnt(0);
        unsigned nloc = b.st[0], nx = b.st[1];
        if (nloc == 0u) { xcd_barrier_complete(bar, b.x, nloc, nx); b.st[0] = nloc; b.st[1] = nx; }
        const unsigned old = xb_add(&bar[XB_XSUB(b.x)], 1u);
        const unsigned gen = old / nloc;
        if (old + 1u == (gen + 1u) * nloc) {
            __builtin_amdgcn_fence(__ATOMIC_RELEASE, "agent");
            asm volatile("s_waitcnt vmcnt(0)" ::: "memory");
            const unsigned og = xb_add(&bar[XB_TOP], 1u);
            const unsigned tg = og / nx;
            if (og + 1u == (tg + 1u) * nx) xb_add(&bar[XB_TOPGEN], 1u);
            else XB_SPIN(xb_ld(&bar[XB_TOPGEN]) == tg, bar);
            __builtin_amdgcn_fence(__ATOMIC_ACQUIRE, "agent");
            xb_add(&bar[XB_XGEN(b.x)], 1u);
            asm volatile("s_waitcnt vmcnt(0)" ::: "memory");
        } else {
            XB_SPIN(xb_ld(&bar[XB_XGEN(b.x)]) == gen, bar);
            __builtin_amdgcn_fence(__ATOMIC_ACQUIRE, "agent");
            asm volatile("s_waitcnt vmcnt(0)" ::: "memory");
        }
    }
    __syncthreads();
}


__global__ void __launch_bounds__(512, 2) mk_fwd(Args a) {
    extern __shared__ __attribute__((aligned(16))) unsigned char lds_raw[];
    LAS unsigned char* lds = (LAS unsigned char*)lds_raw;
    const int tid = threadIdx.x, lane = tid & 63, wave = __builtin_amdgcn_readfirstlane(tid >> 6);
    const int c = blockIdx.x, G = gridDim.x, gw = c * 8 + wave;
    unsigned char* ws = a.ws;
    volatile LAS unsigned* bst = (volatile LAS unsigned*)(lds + 147456);
    if (tid < 16) bst[tid] = 0u;
    __syncthreads();
    XcdBarrier xbar = xcd_barrier_post((unsigned*)(ws + WS_CTL) + CW_BAR, bst);
    const int lo = a.ph_lo, hi = a.ph_hi;
    if (hi > 4096) cg::this_grid().sync();
#define IN(k) (((MK_PHMASK >> (k)) & 1) && lo <= (k) && (k) < hi)
#if MK_SPLIT
#define SEAM(k) do { } while (0)
#else
#define SEAM(k) do { if (IN(k) && IN((k) + 1)) xcd_barrier(xbar); } while (0)
#endif
    const bf16_t* H = (const bf16_t*)(ws + WS_H);
    float* mod = (float*)(ws + WS_MOD);
    if (IN(0)) phase0(a, lds, tid, lane, wave);
    SEAM(0);
#if MK_XSYNC && !MK_SPLIT
#pragma unroll 1
    for (int x = 0; x < MK_XSYNC; ++x) cg::this_grid().sync();
#endif
    if (IN(1)) norm_rows(a.in[I_XP], a.in[I_XS], a.in[I_N1G], mod, 0, 1024, (bf16_t*)(ws + WS_H), gw, lane);
    SEAM(1);
    if (IN(2)) { pg8::Gemm g{{H, H}, {(const bf16_t*)(ws + WS_WIN), nullptr}, 1024, 1024, 1024}; pg8::StaticOrder S; S.init(MR / 256, NINP / 256, G, c, REPK(2));
        EpiProj E{(bf16_t*)(ws + WS_GQKV), (bf16_t*)(ws + WS_Z), (bf16_t*)a.out, (bf16_t*)(ws + WS_CKVRAW), (bf16_t*)(ws + WS_CQ), (float*)(ws + WS_KRRAW), (float*)(ws + WS_AB)};
        pg8::gemm_phase(lds, g, S, E); }
    SEAM(2);
    if (IN(3)) { gdn_prep(a, lds, tid); mla_rows(a, gw, lane); misc_p3(a, tid); }
    SEAM(3);
    if (IN(4)) {
#pragma unroll 1
        for (int rep = REPK(4) - 1; rep >= 0; --rep) for (int u = c; u < 192; u += G) { if (u < 64) scan_prompt(a, lds, u, tid, lane, wave, rep == 0); else gdn_sample(a, lds, u - 64, tid, lane, wave, rep == 0); __syncthreads(); } }
    SEAM(4);
    if (IN(5)) {
        { pg8::Gemm g{{(const bf16_t*)(ws + WS_CQ), nullptr}, {(const bf16_t*)(ws + WS_WUQ), nullptr}, 384, 384, 384}; pg8::StaticOrder S; S.init(MR / 256, 3, G, c, REPK(5));
          EpiBf16<0> E{(bf16_t*)(ws + WS_QRAW), 768}; pg8::gemm_phase(lds, g, S, E); }
        { pg8::Gemm g{{(const bf16_t*)(ws + WS_CKVROWS), nullptr}, {(const bf16_t*)(ws + WS_WUK), nullptr}, 256, 256, 256}; pg8::StaticOrder S; S.init(KR / 256, 2, G, (c + G - 195 % G) % G, REPK(5));
          EpiK E{(bf16_t*)(ws + WS_KBUF), a.in[I_KHG], a.out + O_KRP, a.out + O_KRS, a.in[I_CKR]}; pg8::gemm_phase(lds, g, S, E); }
        { pg8::Gemm g{{(const bf16_t*)(ws + WS_WUV), nullptr}, {(const bf16_t*)(ws + WS_CKVROWS), nullptr}, 256, 256, 256}; pg8::StaticOrder S; S.init(2, KR / 256, G, (c + G - 69 % G) % G, REPK(5));
          EpiVT E{(bf16_t*)(ws + WS_VT)}; pg8::gemm_phase(lds, g, S, E); }
    }
    SEAM(5);
    if (IN(6)) attn_phase(a, lds, tid, lane, wave);
    SEAM(6);
    if (IN(7)) { pg8::Gemm g{{(const bf16_t*)(ws + WS_Z), (const bf16_t*)(ws + WS_OMLA)}, {(const bf16_t*)(ws + WS_WGO), (const bf16_t*)(ws + WS_WMO)}, 512, 512, 512};
        pg8::DualOrder S; S.S.init(MR / 256, 4, G, c, REPK(7)); EpiGate E{(bf16_t*)(ws + WS_MERGED), (const bf16_t*)a.out}; pg8::gemm_phase(lds, g, S, E); }
    SEAM(7);
    if (IN(8)) { pg8::Gemm g{{(const bf16_t*)(ws + WS_MERGED), nullptr}, {(const bf16_t*)(ws + WS_WO), nullptr}, 1024, 1024, 1024}; pg8::StaticOrder S; S.init(MR / 256, 4, G, c, REPK(8));
        EpiRes E{a.in[I_XP], a.in[I_XS], a.out, mod, 2048}; pg8::gemm_phase(lds, g, S, E); }
    SEAM(8);
    if (IN(9)) norm_rows(a.out, a.out + (size_t)MP * 1024, a.in[I_N2G], mod, 3072, 4096, (bf16_t*)(ws + WS_H), gw, lane);
    SEAM(9);
    if (IN(10)) { pg8::Gemm g{{H, nullptr}, {(const bf16_t*)(ws + WS_WF1), nullptr}, 1024, 1024, 1024}; pg8::StaticOrder S; S.init(MR / 256, 16, G, c, REPK(10));
        EpiBf16<1> E{(bf16_t*)(ws + WS_HID), DFF}; pg8::gemm_phase(lds, g, S, E); }
    SEAM(10);
    if (IN(11)) { pg8::Gemm g{{(const bf16_t*)(ws + WS_HID), nullptr}, {(const bf16_t*)(ws + WS_WF2), nullptr}, DFF, DFF, DFF}; pg8::StaticOrder S; S.init(MR / 256, 4, G, c);
        EpiRes E{a.out, a.out + (size_t)MP * 1024, a.out, mod, 5120}; pg8::gemm_phase(lds, g, S, E); }
#undef IN
#undef SEAM
}

extern "C" void kernel_launch(void* const* d_in, const int* in_sizes, int n_in, void* d_out, int out_size, void* d_ws, size_t ws_size, hipStream_t stream) {
    static int grid = 0;
    if (grid == 0) {
        int dev = 0, cus = 0, per_cu = 0;
        hipGetDevice(&dev); hipDeviceGetAttribute(&cus, hipDeviceAttributeMultiprocessorCount, dev);
        hipFuncSetAttribute((const void*)mk_fwd, hipFuncAttributeMaxDynamicSharedMemorySize, LDS_BYTES);
        hipOccupancyMaxActiveBlocksPerMultiprocessor(&per_cu, (const void*)mk_fwd, 512, LDS_BYTES);
        if (per_cu < 1) per_cu = 1;
        grid = cus * per_cu; if (grid > 256) grid = 256;
        (void)hipGetLastError();
    }
    hipMemsetAsync((char*)d_ws + WS_CTL, 0, 64 * KiB, stream);
    Args a{};
    for (int i = 0; i < 28; ++i) a.in[i] = (const float*)d_in[i];
    a.out = (float*)d_out; a.ws = (unsigned char*)d_ws;
#if MK_SPLIT
    for (int p = 0; p < NPHASE; ++p) { a.ph_lo = p; a.ph_hi = p + 1; hipLaunchKernelGGL(mk_fwd, dim3(grid), dim3(512), LDS_BYTES, stream, a); }
#else
    a.ph_lo = 0; a.ph_hi = NPHASE;
    void* args[] = {&a};
    hipError_t e = hipLaunchCooperativeKernel((const void*)mk_fwd, dim3(grid), dim3(512), args, LDS_BYTES, stream);
    if (e != hipSuccess) fprintf(stderr, "cooperative launch failed: %s (grid %d)\n", hipGetErrorString(e), grid);
#endif
}
```

```cpp
#include <hip/hip_runtime.h>
#include <hip/hip_cooperative_groups.h>
#include <cstdio>
#include <cstdint>
namespace cg = cooperative_groups;

#ifndef REP_GEMM
#define REP_GEMM 0x111111111111ull
#endif
#define REPK(k) ((int)((REP_GEMM >> (4 * (k))) & 15))
#ifndef MK_XSYNC
#define MK_XSYNC 0
#endif
#ifndef MK_PHMASK
#define MK_PHMASK 0x1FFF
#endif
#ifndef MK_SPLIT
#define MK_SPLIT 0
#endif

#define LAS __attribute__((address_space(3)))
typedef unsigned short bf16_t;
typedef short bf16x8 __attribute__((ext_vector_type(8)));
typedef float f32x4 __attribute__((ext_vector_type(4)));
typedef float f32x2 __attribute__((ext_vector_type(2)));
typedef float f32x16 __attribute__((ext_vector_type(16)));
typedef unsigned u32x4 __attribute__((ext_vector_type(4)));
typedef unsigned u32x2 __attribute__((ext_vector_type(2)));

constexpr int DM = 1024, BP = 8, SP = 2048, BS = 16, SS = 16, PAST = 2048;
constexpr int MP = BP * SP, MS = BS * SS, MR = MP + MS;
constexpr int SKV = PAST + SS;
constexpr int KR = MP + BS * SKV;
constexpr int NIN = 4784, NINP = 4864;
constexpr int DFF = 4096;
constexpr float EPS = 1e-6f;

constexpr size_t O_Y = 0, O_CKVP = 17039360, O_KRP = 21233664, O_STP = 21757952, O_CVP = 22020096,
                 O_CKVS = 22056960, O_KRS = 22122496, O_STS = 22130688, O_CVS = 22654976;

constexpr size_t KiB = 1024, MiB = 1024 * 1024;
constexpr size_t WS_CTL = 0;
constexpr size_t WS_MOD = 64 * KiB;
constexpr size_t WS_ROPE = 640 * KiB;
constexpr size_t WS_WIN = 960 * KiB;
constexpr size_t WS_WUQ = WS_WIN + (size_t)NINP * 1024 * 2;
constexpr size_t WS_WUK = WS_WUQ + 768 * 384 * 2;
constexpr size_t WS_WUV = WS_WUK + 512 * 256 * 2;
constexpr size_t WS_WGO = WS_WUV + 512 * 256 * 2;
constexpr size_t WS_WMO = WS_WGO + 1024 * 512 * 2;
constexpr size_t WS_WO = WS_WMO + 1024 * 512 * 2;
constexpr size_t WS_WF1 = WS_WO + 1024 * 1024 * 2;
constexpr size_t WS_WF2 = WS_WF1 + (size_t)4096 * 1024 * 2;
constexpr size_t WS_WEND = WS_WF2 + (size_t)4096 * 1024 * 2;
static_assert(WS_WEND <= 32 * MiB, "weights region");
constexpr size_t WS_H = 32 * MiB;
constexpr size_t WS_CKVROWS = 32 * MiB;
constexpr size_t WS_OMLA = 32 * MiB;
constexpr size_t WS_GQKV = 64 * MiB + 512 * KiB;
constexpr size_t WS_VT = WS_GQKV;
constexpr size_t WS_Z = 113 * MiB + 256 * KiB;
constexpr size_t WS_CQ = 129 * MiB + 512 * KiB;
constexpr size_t WS_CKVRAW = WS_CQ + (size_t)MR * 384 * 2;
constexpr size_t WS_KRRAW = WS_CKVRAW + (size_t)MR * 256 * 2;
constexpr size_t WS_AB = WS_KRRAW + (size_t)MR * 32 * 4;
static_assert(WS_AB + (size_t)MR * 16 * 4 <= 153 * MiB, "small proj outputs");
constexpr size_t WS_PREP = 153 * MiB;
constexpr size_t REC_BYTES = 41024;
static_assert(WS_PREP + (size_t)2048 * REC_BYTES <= 256 * MiB, "prep region");
constexpr size_t WS_KBUF = 153 * MiB;
constexpr size_t WS_QRAW = WS_KBUF + (size_t)KR * 768 * 2;
static_assert(WS_QRAW + (size_t)MR * 768 * 2 <= 256 * MiB, "qraw");
constexpr size_t WS_MERGED = 153 * MiB;
constexpr size_t WS_HID = 64 * MiB + 512 * KiB;
static_assert(WS_HID + (size_t)MR * DFF * 2 <= 256 * MiB, "hid");
constexpr size_t WS_GLS = 250 * MiB;
constexpr size_t WS_PART8 = 251 * MiB;
constexpr size_t WS_PART11 = 196 * MiB;
constexpr size_t WS_HACC = 251 * MiB;
constexpr size_t WS_MACC = 255 * MiB;
constexpr size_t VT_SAMPLE_OFF = (size_t)BP * 8 * 64 * SP;

constexpr int LDS_BYTES = 147456 + 64;
constexpr int CW_BAR = 4096;
constexpr int NPHASE = 13;

__device__ __forceinline__ unsigned cvt_pk_bf16(float lo, float hi) { unsigned r; asm volatile("v_cvt_pk_bf16_f32 %0, %1, %2" : "=v"(r) : "v"(lo), "v"(hi)); return r; }
__device__ __forceinline__ float bflo(unsigned u) { return __uint_as_float(u << 16); }
__device__ __forceinline__ float bfhi(unsigned u) { return __uint_as_float(u & 0xffff0000u); }
__device__ __forceinline__ float bf2f(bf16_t b) { return __uint_as_float((unsigned)b << 16); }
__device__ __forceinline__ bf16_t f2bf(float f) { return (bf16_t)(cvt_pk_bf16(f, 0.f) & 0xffffu); }
__device__ __forceinline__ float wave_sum(float v) {
#pragma unroll
    for (int o = 1; o < 64; o <<= 1) v += __shfl_xor(v, o);
    return v;
}
__device__ __forceinline__ float wave_max(float v) {
#pragma unroll
    for (int o = 1; o < 64; o <<= 1) v = fmaxf(v, __shfl_xor(v, o));
    return v;
}
__device__ __forceinline__ float sigmoidf_(float x) { return 1.f / (1.f + __expf(-x)); }
__device__ __forceinline__ float siluf_(float x) { return x / (1.f + __expf(-x)); }
__device__ __forceinline__ u32x4 pack8(const float* v) { u32x4 w; w.x = cvt_pk_bf16(v[0], v[1]); w.y = cvt_pk_bf16(v[2], v[3]); w.z = cvt_pk_bf16(v[4], v[5]); w.w = cvt_pk_bf16(v[6], v[7]); return w; }
__device__ __forceinline__ int mod_row(int r) { return r < MP ? (r >> 11) : 8 + ((r - MP) >> 4); }

namespace pg8 {
constexpr int BM = 256, BK = 64, HALF = 128, HTB = HALF * BK * 2, STAGE_BYTES = 8 * HTB, NXCD = 8, WGM = 8;
__host__ __device__ __forceinline__ int lds_byte(int r, int c) { const int st = (r >> 4) * 2 + (c >> 5), rr = r & 15, cc = c & 31, ob = rr * 64 + cc * 2; return st * 1024 + (ob ^ (((ob >> 9) & 1) << 5)); }
__host__ __device__ __forceinline__ void stage_rc(int b, int& R, int& C) { const int st = b / 1024, sb = b % 1024, swz = sb ^ (((sb >> 9) & 1) << 5); R = (st >> 1) * 16 + swz / 64; C = (st & 1) * 32 + (swz % 64) / 2; }
__host__ __device__ __forceinline__ int perm32(int rho) { const int n = rho >> 4, i = rho & 15; return 8 * (i >> 2) + 4 * n + (i & 3); }

struct Unit { int pm, pn, sel, pk; };
struct Gemm { const bf16_t* A[2]; const bf16_t* Bt[2]; int lda, ldb, K; };

struct StaticOrder {
    int nM, nN, nwg, G, c, rep;
    __device__ void init(int nM_, int nN_, int G_, int c_, int rep_ = 1) { nM = nM_; nN = nN_; nwg = nM * nN; G = G_; c = c_; rep = rep_; }
    __device__ __forceinline__ bool next(int i, Unit& u) const {
        const long L = (long)(i / rep) * G + c; if (L >= nwg) return false;
        int wgid = (int)L; { const int q = nwg / NXCD, r = nwg % NXCD, xcd = wgid % NXCD, off = wgid / NXCD; wgid = (xcd < r ? xcd * (q + 1) : r * (q + 1) + (xcd - r) * q) + off; }
        const int nig = WGM * nN, gid = wgid / nig, fm = gid * WGM, gsz = (nM - fm) < WGM ? (nM - fm) : WGM;
        u.pm = fm + ((wgid % nig) % gsz); u.pn = (wgid % nig) / gsz; u.sel = 0; u.pk = 0; return true;
    }
};
struct PieceOrder {
    int npn, nks, G, c, stride, npieces, klen;
    __device__ __forceinline__ bool next(int i, Unit& u) const {
        if (i != 0 || (c % stride) != 0) return false; const int L = c / stride; if (L >= npieces) return false;
        u.pm = 64; u.pn = L % npn; const int r = L / npn; u.pk = (r % nks) * klen; u.sel = r / nks; return true;
    }
};
struct DualOrder {
    StaticOrder S;
    __device__ __forceinline__ bool next(int i, Unit& u) const { const bool ok = S.next(i >> 1, u); u.sel = i & 1; return ok; }
};

template <class Epi, class Sched>
__device__ __forceinline__ void gemm_phase(LAS unsigned char* lds, const Gemm g, const Sched& S, const Epi& E) {
    const int tid = threadIdx.x, wid = __builtin_amdgcn_readfirstlane(tid >> 6), lane = tid & 63, wr = wid >> 2, wc = wid & 3, fr = lane & 15, fq = lane >> 4;
    const int K = g.K, nt = K / BK;
    unsigned voffA[2], voffB[2];
#pragma unroll
    for (int i = 0; i < 2; ++i) { int R, C; stage_rc(tid * 16 + i * 8192, R, C); const int Rb = Epi::PERM ? ((R & ~31) + perm32(R & 31)) : R;
        voffA[i] = (unsigned)(R * g.lda + C) * 2u; voffB[i] = (unsigned)(Rb * g.ldb + C) * 2u; }
    const size_t kstep = (size_t)(BK * 2);
    const size_t hstepA = (size_t)HALF * g.lda * 2, hstepB = (size_t)HALF * g.ldb * 2;
    const size_t tstepA = 2 * hstepA, tstepB = 2 * hstepB;
    const unsigned ldsw = (unsigned)wid * 1024u;
    const int aoff = lds_byte(wr * 64 + fr, fq * 8), boff = lds_byte(wc * 32 + fr, fq * 8);
#define PG8_SA(b, h) (((b) * 2 + (h)) * HTB)
#define PG8_SB(b, h) ((4 + (b) * 2 + (h)) * HTB)
#define PG8_STAGE(bufoff, gbase, voff) do { _Pragma("unroll") for (int _i = 0; _i < 2; ++_i) \
        __builtin_amdgcn_global_load_lds((const unsigned*)((const char*)(gbase) + (voff)[_i]), (LAS unsigned*)(lds + (bufoff) + ldsw + _i * 8192), 16, 0, 0); } while (0)
#define PG8_LDA(dst, b, h) do { _Pragma("unroll") for (int m = 0; m < 4; ++m) _Pragma("unroll") for (int k = 0; k < 2; ++k) dst[m][k] = *(const LAS bf16x8*)(lds + PG8_SA(b, h) + aoff + m * 2048 + k * 1024); } while (0)
#define PG8_LDB(dst, b, h) do { _Pragma("unroll") for (int n = 0; n < 2; ++n) _Pragma("unroll") for (int k = 0; k < 2; ++k) dst[n][k] = *(const LAS bf16x8*)(lds + PG8_SB(b, h) + boff + n * 2048 + k * 1024); } while (0)
#define PG8_MMA(ai, bj, At, Bt) do { __builtin_amdgcn_s_setprio(1); _Pragma("unroll") for (int m = 0; m < 4; ++m) _Pragma("unroll") for (int n = 0; n < 2; ++n) _Pragma("unroll") for (int k = 0; k < 2; ++k) \
        acc[ai][bj][m][n] = __builtin_amdgcn_mfma_f32_16x16x32_bf16(Bt[n][k], At[m][k], acc[ai][bj][m][n], 0, 0, 0); __builtin_amdgcn_s_setprio(0); } while (0)
#define PG8_WAIT_V(n) asm volatile("s_waitcnt vmcnt(" #n ")" ::: "memory")
#define PG8_WAIT_L(n) asm volatile("s_waitcnt lgkmcnt(" #n ")" ::: "memory")
#define PG8_BAR __builtin_amdgcn_s_barrier()
#define PG8_SCHED __builtin_amdgcn_sched_barrier(0)
    Unit cur, nxt; int ui = 0;
    if (!S.next(0, cur)) return;
    f32x4 acc[2][2][4][2];
#pragma unroll
    for (int a = 0; a < 2; ++a)
#pragma unroll
        for (int b = 0; b < 2; ++b)
#pragma unroll
            for (int m = 0; m < 4; ++m)
#pragma unroll
                for (int n = 0; n < 2; ++n) acc[a][b][m][n] = (f32x4){0.f, 0.f, 0.f, 0.f};
    bf16x8 At[4][2], B0[2][2], B1[2][2];
    const char* cA = (const char*)(cur.sel ? g.A[1] : g.A[0]) + (size_t)cur.pm * tstepA + (size_t)cur.pk * 2; const char* cB = (const char*)(cur.sel ? g.Bt[1] : g.Bt[0]) + (size_t)cur.pn * tstepB + (size_t)cur.pk * 2;
    PG8_STAGE(PG8_SB(0, 0), cB, voffB); PG8_STAGE(PG8_SB(0, 1), cB + hstepB, voffB); PG8_STAGE(PG8_SA(0, 0), cA, voffA); PG8_STAGE(PG8_SA(0, 1), cA + hstepA, voffA);
    if (wr == 1) PG8_BAR;
    PG8_WAIT_V(2); PG8_BAR;
    PG8_STAGE(PG8_SB(1, 0), cB + kstep, voffB); PG8_STAGE(PG8_SA(1, 0), cA + kstep, voffA); PG8_STAGE(PG8_SB(1, 1), cB + hstepB + kstep, voffB);
    PG8_WAIT_V(6); PG8_BAR;
    for (;;) {
        const bool has_next = S.next(ui + 1, nxt);
        const char* nA = has_next ? (const char*)(nxt.sel ? g.A[1] : g.A[0]) + (size_t)nxt.pm * tstepA + (size_t)nxt.pk * 2 : cA; const char* nB = has_next ? (const char*)(nxt.sel ? g.Bt[1] : g.Bt[0]) + (size_t)nxt.pn * tstepB + (size_t)nxt.pk * 2 : cB;
#pragma unroll 1
        for (int t = 0; t < nt; t += 2) {
            const bool last = (t == nt - 2);
            const char* a1 = cA + (size_t)(t + 1) * kstep;
            const char* a2 = last ? nA : cA + (size_t)(t + 2) * kstep; const char* b2 = last ? nB : cB + (size_t)(t + 2) * kstep;
            const char* a3 = a2 + kstep; const char* b3 = b2 + kstep;
            PG8_LDB(B0, 0, 0); PG8_LDB(B1, 0, 1); PG8_SCHED; PG8_LDA(At, 0, 0); PG8_STAGE(PG8_SA(1, 1), a1 + hstepA, voffA);
            PG8_WAIT_V(8); PG8_WAIT_L(0); PG8_BAR; PG8_MMA(0, 0, At, B0); PG8_MMA(0, 1, At, B1); PG8_BAR; PG8_SCHED;
            PG8_LDA(At, 0, 1); PG8_STAGE(PG8_SB(0, 0), b2, voffB); PG8_STAGE(PG8_SB(0, 1), b2 + hstepB, voffB); PG8_STAGE(PG8_SA(0, 0), a2, voffA);
            PG8_WAIT_V(8); PG8_WAIT_L(0); PG8_BAR; PG8_MMA(1, 0, At, B0); PG8_MMA(1, 1, At, B1); PG8_BAR; PG8_SCHED;
            PG8_LDB(B0, 1, 0); PG8_LDB(B1, 1, 1); PG8_SCHED; PG8_LDA(At, 1, 0); PG8_STAGE(PG8_SA(0, 1), a2 + hstepA, voffA);
            PG8_WAIT_V(8); PG8_WAIT_L(0); PG8_BAR; PG8_MMA(0, 0, At, B0); PG8_MMA(0, 1, At, B1); PG8_BAR; PG8_SCHED;
            PG8_LDA(At, 1, 1); PG8_STAGE(PG8_SB(1, 0), b3, voffB); PG8_STAGE(PG8_SB(1, 1), b3 + hstepB, voffB); PG8_STAGE(PG8_SA(1, 0), a3, voffA);
            PG8_WAIT_V(8); PG8_WAIT_L(0); PG8_BAR; PG8_MMA(1, 0, At, B0); PG8_MMA(1, 1, At, B1); PG8_BAR; PG8_SCHED;
        }
        if (wr == 0) PG8_BAR;
        E(acc, cur, wr, wc, fr, fq);
        if (!has_next) break;
#pragma unroll
        for (int a = 0; a < 2; ++a)
#pragma unroll
            for (int b = 0; b < 2; ++b)
#pragma unroll
                for (int m = 0; m < 4; ++m)
#pragma unroll
                    for (int n = 0; n < 2; ++n) acc[a][b][m][n] = (f32x4){0.f, 0.f, 0.f, 0.f};
        cur = nxt; cA = nA; cB = nB; ++ui;
        if (wr == 1) PG8_BAR;
    }
    PG8_WAIT_V(0);
    PG8_BAR;
#undef PG8_SA
#undef PG8_SB
#undef PG8_STAGE
#undef PG8_LDA
#undef PG8_LDB
#undef PG8_MMA
#undef PG8_WAIT_V
#undef PG8_WAIT_L
#undef PG8_BAR
#undef PG8_SCHED
}
}
using pg8::Unit;

#define EPI_ARGS const f32x4 (&acc)[2][2][4][2], const Unit& u, int wr, int wc, int fr, int fq
__device__ __forceinline__ u32x4 pack_v(const f32x4 v0, const f32x4 v1) { u32x4 w; w.x = cvt_pk_bf16(v0[0], v0[1]); w.y = cvt_pk_bf16(v0[2], v0[3]); w.z = cvt_pk_bf16(v1[0], v1[1]); w.w = cvt_pk_bf16(v1[2], v1[3]); return w; }

struct EpiProj {
    static constexpr bool PERM = true;
    bf16_t *gqkv, *z, *gl, *gls, *ckvraw, *cq; float *krraw, *ab;
    __device__ __forceinline__ void operator()(EPI_ARGS) const {
        const int pn = u.pn; bf16_t* base; int pitch;
        if (pn < 6) { base = gqkv + pn * 256; pitch = 1536; } else if (pn < 8) { base = z + (pn - 6) * 256; pitch = 512; }
        else if (pn < 16) { base = (u.pm == 64 ? gls - (size_t)MP * 2048 : gl) + (pn - 8) * 256; pitch = 2048; } else if (pn == 16) { base = ckvraw; pitch = 256; }
        else if (pn == 17) { base = cq; pitch = 384; } else { base = cq + 256; pitch = 384; }
#pragma unroll
        for (int ai = 0; ai < 2; ++ai)
#pragma unroll
            for (int m = 0; m < 4; ++m) { const size_t row = (size_t)u.pm * 256 + ai * 128 + wr * 64 + m * 16 + fr;
#pragma unroll
                for (int bj = 0; bj < 2; ++bj) { const int ct = bj * 128 + wc * 32 + 8 * fq; const f32x4 v0 = acc[ai][bj][m][0], v1 = acc[ai][bj][m][1];
                    if (pn < 18 || bj == 0) { *(u32x4*)(base + row * pitch + ct) = pack_v(v0, v1); }
                    else if (wc == 0) { float* d = krraw + row * 32 + 8 * fq; *(f32x4*)d = v0; *(f32x4*)(d + 4) = v1; }
                    else if (wc == 1 && fq < 2) { float* d = ab + row * 16 + 8 * fq; *(f32x4*)d = v0; *(f32x4*)(d + 4) = v1; }
                } }
    }
};
template <int ACT> struct EpiBf16 {
    static constexpr bool PERM = true;
    bf16_t* O; int ldc;
    __device__ __forceinline__ void operator()(EPI_ARGS) const {
#pragma unroll
        for (int ai = 0; ai < 2; ++ai)
#pragma unroll
            for (int m = 0; m < 4; ++m) { const size_t row = (size_t)u.pm * 256 + ai * 128 + wr * 64 + m * 16 + fr;
#pragma unroll
                for (int bj = 0; bj < 2; ++bj) { const int col = u.pn * 256 + bj * 128 + wc * 32 + 8 * fq; f32x4 v0 = acc[ai][bj][m][0], v1 = acc[ai][bj][m][1];
                    if (ACT == 1) {
#pragma unroll
                        for (int e = 0; e < 4; ++e) { const float a = fmaxf(v0[e], 0.f), b = fmaxf(v1[e], 0.f); v0[e] = a * a; v1[e] = b * b; } }
                    *(u32x4*)(O + row * ldc + col) = pack_v(v0, v1); } }
    }
};
struct EpiK {
    static constexpr bool PERM = true;
    bf16_t* K; const float *gk, *krp, *krs, *krcache;
    __device__ __forceinline__ void operator()(EPI_ARGS) const {
        const int head = u.pn * 4 + wc;
        float g0[8], g1[8], g2[8];
#pragma unroll
        for (int e = 0; e < 8; ++e) { g0[e] = gk[8 * fq + e]; g1[e] = gk[32 + 8 * fq + e]; g2[e] = gk[64 + 8 * fq + e]; }
#pragma unroll
        for (int ai = 0; ai < 2; ++ai)
#pragma unroll
            for (int m = 0; m < 4; ++m) { const int R = u.pm * 256 + ai * 128 + wr * 64 + m * 16 + fr;
                const float* kr;
                if (R < MP) kr = krp + (size_t)R * 32;
                else { const int q = R - MP, s = q / SKV, j = q - s * SKV; kr = j < PAST ? krcache + ((size_t)s * PAST + j) * 32 : krs + ((size_t)s * SS + (j - PAST)) * 32; }
                const f32x4 r0 = *(const f32x4*)(kr + 8 * fq), r1 = *(const f32x4*)(kr + 8 * fq + 4);
                const f32x4 a0 = acc[ai][0][m][0], a1 = acc[ai][0][m][1], b0 = acc[ai][1][m][0], b1 = acc[ai][1][m][1];
                float ss = 0.f;
#pragma unroll
                for (int e = 0; e < 4; ++e) ss += a0[e] * a0[e] + a1[e] * a1[e] + b0[e] * b0[e] + b1[e] * b1[e] + r0[e] * r0[e] + r1[e] * r1[e];
                ss += __shfl_xor(ss, 16); ss += __shfl_xor(ss, 32);
                const float rs = rsqrtf(ss * (1.f / 96.f) + EPS);
                float o0[8], o1[8], o2[8];
#pragma unroll
                for (int e = 0; e < 4; ++e) { o0[e] = a0[e] * rs * g0[e]; o0[4 + e] = a1[e] * rs * g0[4 + e]; o1[e] = b0[e] * rs * g1[e]; o1[4 + e] = b1[e] * rs * g1[4 + e];
                    o2[e] = r0[e] * rs * g2[e]; o2[4 + e] = r1[e] * rs * g2[4 + e]; }
                bf16_t* d = K + (size_t)R * 768 + head * 96 + 8 * fq;
                *(u32x4*)d = pack8(o0); *(u32x4*)(d + 32) = pack8(o1); *(u32x4*)(d + 64) = pack8(o2); }
    }
};
struct EpiVT {
    static constexpr bool PERM = true;
    bf16_t* VT;
    __device__ __forceinline__ void operator()(EPI_ARGS) const {
        size_t coff[2]; int pitch[2];
#pragma unroll
        for (int bj = 0; bj < 2; ++bj) { const int R0 = u.pn * 256 + bj * 128 + wc * 32 + 8 * fq;
            if (R0 < MP) { coff[bj] = (size_t)(R0 >> 11) * 8 * 64 * SP + (R0 & 2047); pitch[bj] = SP; }
            else { const int q = R0 - MP, s = q / SKV, j = q - s * SKV; coff[bj] = VT_SAMPLE_OFF + (size_t)s * 8 * 64 * SKV + j; pitch[bj] = SKV; } }
#pragma unroll
        for (int ai = 0; ai < 2; ++ai)
#pragma unroll
            for (int m = 0; m < 4; ++m) { const int f = u.pm * 256 + ai * 128 + wr * 64 + m * 16 + fr;
#pragma unroll
                for (int bj = 0; bj < 2; ++bj) *(u32x4*)(VT + coff[bj] + (size_t)f * pitch[bj]) = pack_v(acc[ai][bj][m][0], acc[ai][bj][m][1]); }
    }
};
struct EpiGate {
    static constexpr bool PERM = true;
    bf16_t* merged; const bf16_t* gl; const bf16_t* gls;
    __device__ __forceinline__ void operator()(EPI_ARGS) const {
#pragma unroll
        for (int ai = 0; ai < 2; ++ai)
#pragma unroll
            for (int m = 0; m < 4; ++m) { const size_t row = (size_t)u.pm * 256 + ai * 128 + wr * 64 + m * 16 + fr;
#pragma unroll
                for (int bj = 0; bj < 2; ++bj) { const int col = u.pn * 256 + bj * 128 + wc * 32 + 8 * fq; const f32x4 v0 = acc[ai][bj][m][0], v1 = acc[ai][bj][m][1];
                    const u32x4 gw = *(const u32x4*)((u.pm == 64 ? gls - (size_t)MP * 2048 : gl) + row * 2048 + u.sel * 1024 + col);
                    float o[8];
                    o[0] = sigmoidf_(bflo(gw.x)) * v0[0]; o[1] = sigmoidf_(bfhi(gw.x)) * v0[1]; o[2] = sigmoidf_(bflo(gw.y)) * v0[2]; o[3] = sigmoidf_(bfhi(gw.y)) * v0[3];
                    o[4] = sigmoidf_(bflo(gw.z)) * v1[0]; o[5] = sigmoidf_(bfhi(gw.z)) * v1[1]; o[6] = sigmoidf_(bflo(gw.w)) * v1[2]; o[7] = sigmoidf_(bfhi(gw.w)) * v1[3];
                    bf16_t* d = merged + row * 1024 + col;
                    if (u.sel) { const u32x4 t = *(const u32x4*)d;
                        o[0] += bflo(t.x); o[1] += bfhi(t.x); o[2] += bflo(t.y); o[3] += bfhi(t.y); o[4] += bflo(t.z); o[5] += bfhi(t.z); o[6] += bflo(t.w); o[7] += bfhi(t.w); }
                    *(u32x4*)d = pack8(o); } }
    }
};
struct EpiGateS {
    static constexpr bool PERM = true;
    float* macc; const bf16_t* gls;
    __device__ __forceinline__ void operator()(EPI_ARGS) const {
#pragma unroll
        for (int ai = 0; ai < 2; ++ai)
#pragma unroll
            for (int m = 0; m < 4; ++m) { const size_t r = ai * 128 + wr * 64 + m * 16 + fr;
#pragma unroll
                for (int bj = 0; bj < 2; ++bj) { const int col = u.pn * 256 + bj * 128 + wc * 32 + 8 * fq; const f32x4 v0 = acc[ai][bj][m][0], v1 = acc[ai][bj][m][1];
                    const u32x4 gw = *(const u32x4*)(gls + r * 2048 + u.sel * 1024 + col); float* d = macc + r * 1024 + col;
                    unsafeAtomicAdd(d + 0, sigmoidf_(bflo(gw.x)) * v0[0]); unsafeAtomicAdd(d + 1, sigmoidf_(bfhi(gw.x)) * v0[1]); unsafeAtomicAdd(d + 2, sigmoidf_(bflo(gw.y)) * v0[2]); unsafeAtomicAdd(d + 3, sigmoidf_(bfhi(gw.y)) * v0[3]);
                    unsafeAtomicAdd(d + 4, sigmoidf_(bflo(gw.z)) * v1[0]); unsafeAtomicAdd(d + 5, sigmoidf_(bfhi(gw.z)) * v1[1]); unsafeAtomicAdd(d + 6, sigmoidf_(bflo(gw.w)) * v1[2]); unsafeAtomicAdd(d + 7, sigmoidf_(bfhi(gw.w)) * v1[3]); } }
    }
};
struct EpiAtom {
    static constexpr bool PERM = false;
    float* dst; int ld; const float* mod; int goff, klen;
    __device__ __forceinline__ void operator()(EPI_ARGS) const {
#pragma unroll
        for (int ai = 0; ai < 2; ++ai)
#pragma unroll
            for (int m = 0; m < 4; ++m) { const int r = ai * 128 + wr * 64 + m * 16 + fr;
#pragma unroll
                for (int bj = 0; bj < 2; ++bj)
#pragma unroll
                    for (int n = 0; n < 2; ++n) { const int col = u.pn * 256 + bj * 128 + wc * 32 + 16 * n + 4 * fq;
                        f32x4 v = acc[ai][bj][m][n]; if (mod) v = v * *(const f32x4*)(mod + (8 + (r >> 4)) * 6144 + goff + col);
                        *(f32x4*)(dst + (size_t)(u.pk / klen) * (MS * 1024) + (size_t)r * ld + col) = v; } }
    }
};
__device__ __forceinline__ void convert_slice(const float* acc, int ld, bf16_t* dst, int k0, bool relu2, int tid) {
    for (int i = tid; i < 256 * 32; i += 512) { const int r = i >> 5, c8 = i & 31;
        f32x4 v0 = *(const f32x4*)(acc + (size_t)r * ld + k0 + 8 * c8), v1 = *(const f32x4*)(acc + (size_t)r * ld + k0 + 8 * c8 + 4);
        if (relu2) {
#pragma unroll
            for (int e = 0; e < 4; ++e) { const float a = fmaxf(v0[e], 0.f), b = fmaxf(v1[e], 0.f); v0[e] = a * a; v1[e] = b * b; } }
        *(u32x4*)(dst + (size_t)r * ld + k0 + 8 * c8) = pack_v(v0, v1); }
    asm volatile("s_waitcnt vmcnt(0)" ::: "memory");
    __syncthreads();
}
struct EpiRes {
    static constexpr bool PERM = false;
    const float *bp, *bs; float* out; const float* mod; int goff;
    __device__ __forceinline__ void operator()(EPI_ARGS) const {
#pragma unroll
        for (int ai = 0; ai < 2; ++ai)
#pragma unroll
            for (int m = 0; m < 4; ++m) { const int row = u.pm * 256 + ai * 128 + wr * 64 + m * 16 + fr;
                const float* br = row < MP ? bp + (size_t)row * 1024 : bs + (size_t)(row - MP) * 1024; const float* gr = mod + mod_row(row) * 6144 + goff;
#pragma unroll
                for (int bj = 0; bj < 2; ++bj)
#pragma unroll
                    for (int n = 0; n < 2; ++n) { const int col = u.pn * 256 + bj * 128 + wc * 32 + 16 * n + 4 * fq;
                        const f32x4 b = *(const f32x4*)(br + col), gt = *(const f32x4*)(gr + col);
                        *(f32x4*)(out + (size_t)row * 1024 + col) = b + gt * acc[ai][bj][m][n]; } }
    }
};

struct Args { const float* in[28]; float* out; unsigned char* ws; int ph_lo, ph_hi; };
enum { I_XP = 0, I_XS, I_CP, I_CS, I_CKV, I_CKR, I_ST, I_CONV, I_ADAW, I_ADAB, I_N1G, I_WIN, I_CONVW, I_ALOG, I_DTB, I_GNG, I_WGO, I_QNG, I_WUQ, I_KVNG, I_WUKV,
       I_QHG, I_KHG, I_WMO, I_WO, I_N2G, I_WF1, I_WF2 };

__device__ __forceinline__ int colmap(int which, int n) {
    switch (which) {
    case 0:
        if (n < 2048) return n; if (n < 4096) return 2736 + (n - 2048); if (n < 4352) return 2448 + (n - 4096); if (n < 4736) return 2064 + (n - 4352);
        if (n < 4768) return 2704 + (n - 4736); if (n < 4776) return 2048 + (n - 4768); if (n < 4784) return 2056 + (n - 4776); return -1;
    case 2: { const int pn = n >> 8, bj = (n >> 7) & 1, wc = (n >> 5) & 3, j = n & 31; return (4 * pn + wc) * 128 + bj * 32 + j; }
    case 3: return (n >> 6) * 128 + 64 + (n & 63);
    default: return n;
    }
}
__device__ __forceinline__ void transpose_item(const float* W, int K, int N, bf16_t* WT, LAS float* scr, int nblk, int which, int item, int lane) {
    const int kb = item / nblk, nb = item - kb * nblk, k0 = 64 * kb, n0 = 32 * nb;
    const int sc = colmap(which, n0 + (lane & 31));
#pragma unroll 8
    for (int i = 0; i < 32; ++i) { const int kk = 2 * i + (lane >> 5); scr[kk * 33 + (lane & 31)] = sc >= 0 ? W[(size_t)(k0 + kk) * N + sc] : 0.f; }
    asm volatile("s_waitcnt lgkmcnt(0)" ::: "memory");
    const int c = lane & 7;
#pragma unroll
    for (int j = 0; j < 4; ++j) { const int n = (lane >> 3) + 8 * j; const LAS float* s = scr + (8 * c) * 33 + n;
        u32x4 o; o.x = cvt_pk_bf16(s[0 * 33], s[1 * 33]); o.y = cvt_pk_bf16(s[2 * 33], s[3 * 33]); o.z = cvt_pk_bf16(s[4 * 33], s[5 * 33]); o.w = cvt_pk_bf16(s[6 * 33], s[7 * 33]);
        *(u32x4*)(WT + (size_t)(n0 + n) * K + k0 + 8 * c) = o; }
    asm volatile("s_waitcnt lgkmcnt(0)" ::: "memory");
}
__device__ __forceinline__ void phase0(const Args& a, LAS unsigned char* lds, int tid, int lane, int wave) {
    unsigned char* ws = a.ws;
    for (int idx = blockIdx.x * 512 + tid; idx < SKV * 16; idx += gridDim.x * 512) {
        const int pos = idx >> 4, i = idx & 15;
        const float inv = exp2f(-(float)i * (13.287712379549449f / 16.f));
        const float ang = (float)pos * inv;
        double t = (double)ang * 0.15915494309189535; t -= floor(t);
        const float rev = (float)t;
        ((f32x2*)(ws + WS_ROPE))[idx] = (f32x2){__builtin_amdgcn_cosf(rev), __builtin_amdgcn_sinf(rev)};
    }
    if (blockIdx.x < 96) {
        LAS float* sc = (LAS float*)lds;
        LAS float* red = (LAS float*)(lds + 98304);
        for (int i = tid; i < 24 * 1024; i += 512) { const int r = i >> 10, k = i & 1023; const float v = r < 8 ? a.in[I_CP][r * 1024 + k] : a.in[I_CS][(r - 8) * 1024 + k]; sc[i] = siluf_(v); }
        __syncthreads();
        const int col = blockIdx.x * 64 + lane; const float* wp = a.in[I_ADAW] + (size_t)(wave * 128) * 6144 + col;
        float acc[24];
#pragma unroll
        for (int r = 0; r < 24; ++r) acc[r] = 0.f;
        for (int k4 = 0; k4 < 32; ++k4) {
            const float w0 = wp[(size_t)(4 * k4) * 6144], w1 = wp[(size_t)(4 * k4 + 1) * 6144], w2 = wp[(size_t)(4 * k4 + 2) * 6144], w3 = wp[(size_t)(4 * k4 + 3) * 6144];
#pragma unroll
            for (int r = 0; r < 24; ++r) { const f32x4 s = *(const LAS f32x4*)(sc + r * 1024 + wave * 128 + 4 * k4); acc[r] += s[0] * w0 + s[1] * w1 + s[2] * w2 + s[3] * w3; }
        }
#pragma unroll
        for (int r = 0; r < 24; ++r) red[(wave * 24 + r) * 64 + lane] = acc[r];
        __syncthreads();
        for (int i = tid; i < 24 * 64; i += 512) { const int r = i >> 6, c = i & 63; float s = a.in[I_ADAB][blockIdx.x * 64 + c];
#pragma unroll
            for (int w = 0; w < 8; ++w) s += red[(w * 24 + r) * 64 + c];
            ((float*)(ws + WS_MOD))[r * 6144 + blockIdx.x * 64 + c] = s; }
        __syncthreads();
    }
    LAS float* scr = (LAS float*)(lds + wave * 8448);
    constexpr int N0 = 16 * 152, N1 = 6 * 24, N2 = 4 * 16, N3 = 4 * 16, N4 = 8 * 32, N5 = 8 * 32, N6 = 16 * 32, N7 = 16 * 128, N8 = 64 * 32;
    constexpr int NT = N0 + N1 + N2 + N3 + N4 + N5 + N6 + N7 + N8;
    const int G = gridDim.x, vw = G > 96 ? ((int)blockIdx.x - 96) * 8 + wave : (int)blockIdx.x * 8 + wave, NW = G > 96 ? (G - 96) * 8 : G * 8;
    if (vw >= 0)
#pragma unroll 1
    for (int it0 = vw; it0 < NT * REPK(0); it0 += NW) {
        int it = it0 % NT;
        if (it < N0) { transpose_item(a.in[I_WIN], 1024, NIN, (bf16_t*)(ws + WS_WIN), scr, 152, 0, it, lane); continue; } it -= N0;
        if (it < N1) { transpose_item(a.in[I_WUQ], 384, 768, (bf16_t*)(ws + WS_WUQ), scr, 24, 1, it, lane); continue; } it -= N1;
        if (it < N2) { transpose_item(a.in[I_WUKV], 256, 1024, (bf16_t*)(ws + WS_WUK), scr, 16, 2, it, lane); continue; } it -= N2;
        if (it < N3) { transpose_item(a.in[I_WUKV], 256, 1024, (bf16_t*)(ws + WS_WUV), scr, 16, 3, it, lane); continue; } it -= N3;
        if (it < N4) { transpose_item(a.in[I_WGO], 512, 1024, (bf16_t*)(ws + WS_WGO), scr, 32, 1, it, lane); continue; } it -= N4;
        if (it < N5) { transpose_item(a.in[I_WMO], 512, 1024, (bf16_t*)(ws + WS_WMO), scr, 32, 1, it, lane); continue; } it -= N5;
        if (it < N6) { transpose_item(a.in[I_WO], 1024, 1024, (bf16_t*)(ws + WS_WO), scr, 32, 1, it, lane); continue; } it -= N6;
        if (it < N7) { transpose_item(a.in[I_WF1], 1024, 4096, (bf16_t*)(ws + WS_WF1), scr, 128, 1, it, lane); continue; } it -= N7;
        transpose_item(a.in[I_WF2], 4096, 1024, (bf16_t*)(ws + WS_WF2), scr, 32, 1, it, lane);
    }
}

__device__ __forceinline__ void norm_rows(const float* xp, const float* xs, const float* g, const float* mod, int shift_off, int scale_off, bf16_t* out, int gw, int lane, const float* part, float* ys) {
    for (int r = gw; r < MR; r += 2048) {
        const float* xr = r < MP ? xp + (size_t)r * 1024 : xs + (size_t)(r - MP) * 1024;
        const float* mr = mod + mod_row(r) * 6144;
        f32x4 v[4]; float ss = 0.f;
#pragma unroll
        for (int j = 0; j < 4; ++j) { v[j] = *(const f32x4*)(xr + 4 * (lane + 64 * j));
            if (part && r >= MP) {
#pragma unroll
                for (int k = 0; k < 4; ++k) v[j] += *(const f32x4*)(part + (size_t)k * (MS * 1024) + (size_t)(r - MP) * 1024 + 4 * (lane + 64 * j));
                *(f32x4*)(ys + (size_t)(r - MP) * 1024 + 4 * (lane + 64 * j)) = v[j]; }
            ss += v[j][0] * v[j][0] + v[j][1] * v[j][1] + v[j][2] * v[j][2] + v[j][3] * v[j][3]; }
        const float rs = rsqrtf(wave_sum(ss) * (1.f / 1024.f) + EPS);
#pragma unroll
        for (int j = 0; j < 4; ++j) { const int col = 4 * (lane + 64 * j);
            const f32x4 gg = *(const f32x4*)(g + col), sc = *(const f32x4*)(mr + scale_off + col), sh = *(const f32x4*)(mr + shift_off + col);
            const f32x4 y = v[j] * rs * gg * (sc + 1.f) + sh;
            u32x2 w; w.x = cvt_pk_bf16(y[0], y[1]); w.y = cvt_pk_bf16(y[2], y[3]);
            *(u32x2*)(out + (size_t)r * 1024 + col) = w; }
    }
}

__device__ __forceinline__ void mla_rows(const Args& a, int gw, int lane) {
    unsigned char* ws = a.ws; float* out = a.out;
    bf16_t* cq = (bf16_t*)(ws + WS_CQ); const bf16_t* ckvraw = (const bf16_t*)(ws + WS_CKVRAW); const float* krraw = (const float*)(ws + WS_KRRAW);
    bf16_t* ckvrows = (bf16_t*)(ws + WS_CKVROWS); const f32x2* rope = (const f32x2*)(ws + WS_ROPE);
    for (int r = gw; r < MR; r += 2048) {
        { float v[8]; float ss = 0.f;
          if (lane < 48) { const u32x4 w = *(const u32x4*)(cq + (size_t)r * 384 + 8 * lane);
              v[0] = bflo(w.x); v[1] = bfhi(w.x); v[2] = bflo(w.y); v[3] = bfhi(w.y); v[4] = bflo(w.z); v[5] = bfhi(w.z); v[6] = bflo(w.w); v[7] = bfhi(w.w);
#pragma unroll
              for (int e = 0; e < 8; ++e) ss += v[e] * v[e]; }
          const float rs = rsqrtf(wave_sum(ss) * (1.f / 384.f) + EPS);
          if (lane < 48) {
#pragma unroll
              for (int e = 0; e < 8; ++e) v[e] = v[e] * rs * a.in[I_QNG][8 * lane + e];
              *(u32x4*)(cq + (size_t)r * 384 + 8 * lane) = pack8(v); } }
        { float v[8]; float ss = 0.f;
          if (lane < 32) { const u32x4 w = *(const u32x4*)(ckvraw + (size_t)r * 256 + 8 * lane);
              v[0] = bflo(w.x); v[1] = bfhi(w.x); v[2] = bflo(w.y); v[3] = bfhi(w.y); v[4] = bflo(w.z); v[5] = bfhi(w.z); v[6] = bflo(w.w); v[7] = bfhi(w.w);
#pragma unroll
              for (int e = 0; e < 8; ++e) ss += v[e] * v[e]; }
          const float rs = rsqrtf(wave_sum(ss) * (1.f / 256.f) + EPS);
          if (lane < 32) {
#pragma unroll
              for (int e = 0; e < 8; ++e) v[e] = v[e] * rs * a.in[I_KVNG][8 * lane + e];
              float* o = r < MP ? out + O_CKVP + (size_t)r * 256 : out + O_CKVS + (size_t)(r - MP) * 256;
              *(f32x4*)(o + 8 * lane) = (f32x4){v[0], v[1], v[2], v[3]}; *(f32x4*)(o + 8 * lane + 4) = (f32x4){v[4], v[5], v[6], v[7]};
              const size_t R = r < MP ? (size_t)r : (size_t)MP + (size_t)((r - MP) >> 4) * SKV + PAST + ((r - MP) & 15);
              *(u32x4*)(ckvrows + R * 256 + 8 * lane) = pack8(v); } }
        if (lane < 16) { const int pos = r < MP ? (r & 2047) : PAST + ((r - MP) & 15);
            const float x1 = krraw[(size_t)r * 32 + lane], x2 = krraw[(size_t)r * 32 + 16 + lane]; const f32x2 cs = rope[pos * 16 + lane];
            float* o = r < MP ? out + O_KRP + (size_t)r * 32 : out + O_KRS + (size_t)(r - MP) * 32;
            o[lane] = x1 * cs.x - x2 * cs.y; o[16 + lane] = x2 * cs.x + x1 * cs.y; }
    }
}

template <int I> struct SolveRow {
    static __device__ __forceinline__ void run(float (&x)[64], const LAS float* A, const LAS bf16_t* src, const LAS float* scp) {
        float s = scp[I] * bf2f(src[I * 72]);
#pragma unroll
        for (int j4 = 0; j4 < (I + 3) / 4; ++j4) { const f32x4 av = *(const LAS f32x4*)(A + I * 64 + 4 * j4);
#pragma unroll
            for (int e = 0; e < 4; ++e) if (4 * j4 + e < I) s -= av[e] * x[4 * j4 + e]; }
        x[I] = s;
        SolveRow<I + 1>::run(x, A, src, scp);
    }
};
template <> struct SolveRow<64> { static __device__ __forceinline__ void run(float (&)[64], const LAS float*, const LAS bf16_t*, const LAS float*) {} };

__device__ __forceinline__ void gdn_prep(const Args& a, LAS unsigned char* lds, int tid) {
    const int slot = tid >> 7, w2 = __builtin_amdgcn_readfirstlane((tid >> 6) & 1), lane = tid & 63;
    LAS unsigned char* sl = lds + slot * 35584;
    LAS bf16_t* q_lds = (LAS bf16_t*)sl; LAS float* A_lds = (LAS float*)sl;
    LAS bf16_t* k_lds = (LAS bf16_t*)(sl + 16384); LAS bf16_t* v_lds = (LAS bf16_t*)(sl + 25600);
    LAS float* gcs = (LAS float*)(sl + 34816); LAS float* bts = (LAS float*)(sl + 35072); LAS float* scw = (LAS float*)(sl + 35328);
    const bf16_t* gqkv = (const bf16_t*)(a.ws + WS_GQKV); const float* ab = (const float*)(a.ws + WS_AB); const float* cw = a.in[I_CONVW];
#pragma unroll 1
    for (int qi = blockIdx.x; qi < 512 * REPK(3); qi += gridDim.x) {
        const int item = (qi & 511) * 4 + slot, bh = item >> 5, n = item & 31, b = bh >> 3, h = bh & 7;
        const int r0 = b * SP + 64 * n, t = lane;
        unsigned char* rec = a.ws + WS_PREP + (size_t)item * REC_BYTES;
        LAS float* cwl = (LAS float*)(sl + 9216);
        for (int i = tid & 127; i < 768; i += 128) { const int tap = i / 192, cc = i - tap * 192; cwl[i] = cw[tap * 1536 + (cc >> 6) * 512 + h * 64 + (cc & 63)]; }
        __syncthreads();
        {
            const int colbase = w2 * 512 + h * 64;
            float o[64];
#pragma unroll
            for (int c = 0; c < 64; ++c) o[c] = 0.f;
#pragma unroll 1
            for (int tap = 0; tap < 4; ++tap) { const int rr = t - 3 + tap; const bool valid = (n > 0) || (rr >= 0);
                const bf16_t* src = gqkv + (size_t)(r0 + (valid ? rr : 0)) * 1536 + colbase;
#pragma unroll
                for (int c8 = 0; c8 < 8; ++c8) { u32x4 w = *(const u32x4*)(src + 8 * c8); if (!valid) w = (u32x4){0u, 0u, 0u, 0u};
                    const f32x4 wa = *(const LAS f32x4*)(cwl + tap * 192 + w2 * 64 + 8 * c8), wb = *(const LAS f32x4*)(cwl + tap * 192 + w2 * 64 + 8 * c8 + 4);
                    o[8 * c8 + 0] += wa[0] * bflo(w.x); o[8 * c8 + 1] += wa[1] * bfhi(w.x); o[8 * c8 + 2] += wa[2] * bflo(w.y); o[8 * c8 + 3] += wa[3] * bfhi(w.y);
                    o[8 * c8 + 4] += wb[0] * bflo(w.z); o[8 * c8 + 5] += wb[1] * bfhi(w.z); o[8 * c8 + 6] += wb[2] * bflo(w.w); o[8 * c8 + 7] += wb[3] * bfhi(w.w); } }
            float ss = 0.f;
#pragma unroll
            for (int c = 0; c < 64; ++c) { o[c] = siluf_(o[c]); ss += o[c] * o[c]; }
            const float sc = rsqrtf(ss + EPS) * (w2 ? 1.f : 0.125f);
            LAS bf16_t* dst = (w2 ? k_lds : q_lds) + t * 72;
#pragma unroll
            for (int c8 = 0; c8 < 8; ++c8) { float v[8];
#pragma unroll
                for (int e = 0; e < 8; ++e) v[e] = o[8 * c8 + e] * sc;
                *(LAS u32x4*)(dst + 8 * c8) = pack8(v); }
        }
        {
            const int colbase = 1024 + h * 64 + 32 * w2;
            float o[32];
#pragma unroll
            for (int c = 0; c < 32; ++c) o[c] = 0.f;
#pragma unroll 1
            for (int tap = 0; tap < 4; ++tap) { const int rr = t - 3 + tap; const bool valid = (n > 0) || (rr >= 0);
                const bf16_t* src = gqkv + (size_t)(r0 + (valid ? rr : 0)) * 1536 + colbase;
#pragma unroll
                for (int c8 = 0; c8 < 4; ++c8) { u32x4 w = *(const u32x4*)(src + 8 * c8); if (!valid) w = (u32x4){0u, 0u, 0u, 0u};
                    const f32x4 wa = *(const LAS f32x4*)(cwl + tap * 192 + 128 + 32 * w2 + 8 * c8), wb = *(const LAS f32x4*)(cwl + tap * 192 + 128 + 32 * w2 + 8 * c8 + 4);
                    o[8 * c8 + 0] += wa[0] * bflo(w.x); o[8 * c8 + 1] += wa[1] * bfhi(w.x); o[8 * c8 + 2] += wa[2] * bflo(w.y); o[8 * c8 + 3] += wa[3] * bfhi(w.y);
                    o[8 * c8 + 4] += wb[0] * bflo(w.z); o[8 * c8 + 5] += wb[1] * bfhi(w.z); o[8 * c8 + 6] += wb[2] * bflo(w.w); o[8 * c8 + 7] += wb[3] * bfhi(w.w); } }
#pragma unroll
            for (int c8 = 0; c8 < 4; ++c8) { float v[8];
#pragma unroll
                for (int e = 0; e < 8; ++e) v[e] = siluf_(o[8 * c8 + e]);
                *(LAS u32x4*)(v_lds + t * 72 + 32 * w2 + 8 * c8) = pack8(v); }
        }
        float gc, gcl;
        {
            const float av = ab[(size_t)(r0 + t) * 16 + h], bv = ab[(size_t)(r0 + t) * 16 + 8 + h];
            const float xg = av + a.in[I_DTB][h];
            const float sp = fmaxf(xg, 0.f) + __logf(1.f + __expf(-fabsf(xg)));
            gc = -__expf(a.in[I_ALOG][h]) * sp;
#pragma unroll
            for (int o = 1; o < 64; o <<= 1) { const float u = __shfl_up(gc, o); if (lane >= o) gc += u; }
            gcl = __shfl(gc, 63);
            if (w2 == 0) { const float be = sigmoidf_(bv); gcs[t] = gc; bts[t] = be; scw[t] = be * __expf(gc); if (lane == 0) *(float*)(rec + 40960) = __expf(gcl); }
        }
        __syncthreads();
#pragma unroll
        for (int it = 0; it < 8; ++it) { const int ri = (lane >> 3) + 8 * it, pg = lane & 7, d0 = 32 * (pg >> 2) + 4 * (pg & 3);
            float v[8];
            if (w2 == 0) { const u32x2 w0 = *(const LAS u32x2*)(q_lds + ri * 72 + d0), w1 = *(const LAS u32x2*)(q_lds + ri * 72 + d0 + 16); const float e = __expf(gcs[ri]);
                v[0] = bflo(w0.x) * e; v[1] = bfhi(w0.x) * e; v[2] = bflo(w0.y) * e; v[3] = bfhi(w0.y) * e; v[4] = bflo(w1.x) * e; v[5] = bfhi(w1.x) * e; v[6] = bflo(w1.y) * e; v[7] = bfhi(w1.y) * e;
                *(u32x4*)(rec + 8192 + (ri * 64 + 8 * pg) * 2) = pack8(v); }
            else {
#pragma unroll
                for (int j = 0; j < 8; ++j) { const int c = d0 + 16 * (j >> 2) + (j & 3); v[j] = bf2f(k_lds[c * 72 + ri]) * __expf(gcl - gcs[c]); }
                *(u32x4*)(rec + 24576 + (ri * 64 + 8 * pg) * 2) = pack8(v); } }
        const int m_ = lane & 15, g4 = lane >> 4;
        f32x4 acc[4][4];
        {
            bf16x8 ka[4][2], bb[4][2];
            const LAS bf16_t* bsrc = w2 ? k_lds : q_lds;
#pragma unroll
            for (int jt = 0; jt < 4; ++jt)
#pragma unroll
                for (int ks = 0; ks < 2; ++ks) { ka[jt][ks] = *(const LAS bf16x8*)(k_lds + (16 * jt + m_) * 72 + 32 * ks + 8 * g4); bb[jt][ks] = *(const LAS bf16x8*)(bsrc + (16 * jt + m_) * 72 + 32 * ks + 8 * g4); }
#pragma unroll
            for (int jt = 0; jt < 4; ++jt)
#pragma unroll
                for (int it = 0; it < 4; ++it) { f32x4 c = (f32x4){0.f, 0.f, 0.f, 0.f};
                    if (it >= jt) {
#pragma unroll
                        for (int ks = 0; ks < 2; ++ks) c = __builtin_amdgcn_mfma_f32_16x16x32_bf16(ka[jt][ks], bb[it][ks], c, 0, 0, 0); }
                    acc[jt][it] = c; }
        }
        __syncthreads();
#pragma unroll
        for (int jt = 0; jt < 4; ++jt)
#pragma unroll
            for (int it = 0; it < 4; ++it) { const int i = 16 * it + m_, j0 = 16 * jt + 4 * g4; const float gi = gcs[i]; const f32x4 gj = *(const LAS f32x4*)(gcs + j0);
                float v[4];
                if (w2 == 0) {
#pragma unroll
                    for (int e = 0; e < 4; ++e) { const bool keep = it > jt ? true : (it < jt ? false : m_ >= 4 * g4 + e); v[e] = keep ? acc[jt][it][e] * __expf(keep ? gi - gj[e] : 0.f) : 0.f; }
                    u32x2 w; w.x = cvt_pk_bf16(v[0], v[1]); w.y = cvt_pk_bf16(v[2], v[3]);
                    *(u32x2*)(rec + 16384 + (i * 64 + 32 * (jt >> 1) + 8 * g4 + 4 * (jt & 1)) * 2) = w; }
                else { const float bi = bts[i];
#pragma unroll
                    for (int e = 0; e < 4; ++e) { const bool keep = it > jt ? true : (it < jt ? false : m_ > 4 * g4 + e); v[e] = keep ? bi * acc[jt][it][e] * __expf(keep ? gi - gj[e] : 0.f) : 0.f; }
                    *(LAS f32x4*)(A_lds + i * 64 + j0) = (f32x4){v[0], v[1], v[2], v[3]}; } }
        __syncthreads();
        {
            const LAS bf16_t* src = w2 ? k_lds : v_lds; const LAS float* scp = w2 ? scw : bts;
            float x[64];
            SolveRow<0>::run(x, A_lds, src + lane, scp);
            if (w2 == 0) {
#pragma unroll
                for (int q = 0; q < 8; ++q) *(u32x4*)(rec + 32768 + (lane * 64 + 8 * q) * 2) = pack8(&x[8 * q]);
            } else { const int pinv = (lane & 32) | (((lane >> 2) & 3) << 3) | (((lane >> 4) & 1) << 2) | (lane & 3);
#pragma unroll
                for (int i = 0; i < 64; ++i) *(bf16_t*)(rec + (i * 64 + pinv) * 2) = f2bf(-x[i]); }
        }
        __syncthreads();
    }
}

__device__ __forceinline__ void misc_p3(const Args& a, int tid) {
    bf16_t* ckvrows = (bf16_t*)(a.ws + WS_CKVROWS); const float* cache = a.in[I_CKV];
    const int gt = blockIdx.x * 512 + tid, GT = gridDim.x * 512;
    for (int i = gt; i < BS * PAST * 32; i += GT) { const int row = i >> 5, c8 = i & 31, s = row >> 11, j = row & 2047;
        const f32x4 v0 = *(const f32x4*)(cache + (size_t)row * 256 + 8 * c8), v1 = *(const f32x4*)(cache + (size_t)row * 256 + 8 * c8 + 4);
        *(u32x4*)(ckvrows + ((size_t)MP + (size_t)s * SKV + j) * 256 + 8 * c8) = pack_v(v0, v1); }
    const bf16_t* gqkv = (const bf16_t*)(a.ws + WS_GQKV);
    for (int i = gt; i < BP * 3 * 1536; i += GT) { const int b = i / 4608, rem = i - b * 4608, r = rem / 1536, c = rem - r * 1536;
        a.out[O_CVP + i] = bf2f(gqkv[(size_t)(b * SP + SP - 3 + r) * 1536 + c]); }
    for (int i = gt; i < BS * 3 * 1536; i += GT) { const int s = i / 4608, rem = i - s * 4608, r = rem / 1536, c = rem - r * 1536;
        a.out[O_CVS + i] = bf2f(gqkv[(size_t)(MP + s * SS + SS - 3 + r) * 1536 + c]); }
}

__device__ __forceinline__ bf16x8 pack_frag(const f32x4 lo, const f32x4 hi) { u32x4 w = pack_v(lo, hi); return __builtin_bit_cast(bf16x8, w); }

__device__ __forceinline__ void scan_prompt(const Args& a, LAS unsigned char* lds, int bh, int tid, int lane, int wave, bool st) {
    const int b = bh >> 3, h = bh & 7;
    const unsigned char* recs = a.ws + WS_PREP + (size_t)bh * 32 * REC_BYTES;
    bf16_t* zo = (bf16_t*)(a.ws + WS_Z);
    LAS float* red = (LAS float*)(lds + 92160);
    const int prow = (tid & 511) >> 3, pc16 = tid & 7;
    const int n_ = lane & 15, g4 = lane >> 4, dv = 16 * wave + n_;
    f32x4 S[4];
#pragma unroll
    for (int kt = 0; kt < 4; ++kt) S[kt] = (f32x4){0.f, 0.f, 0.f, 0.f};
    const float gn = wave < 4 ? a.in[I_GNG][dv] : 0.f;
    { u32x4 p[5];
#pragma unroll
      for (int i = 0; i < 5; ++i) p[i] = *(const u32x4*)(recs + i * 8192 + tid * 16);
#pragma unroll
      for (int i = 0; i < 5; ++i) *(LAS u32x4*)(lds + i * 9216 + prow * 144 + pc16 * 16) = p[i]; }
    __syncthreads();
    for (int n = 0; n < 32; ++n) {
        LAS unsigned char* cur = lds + (n & 1) * 46080; LAS unsigned char* nxt = lds + ((n + 1) & 1) * 46080;
        u32x4 p[5];
        if (n + 1 < 32) {
#pragma unroll
            for (int i = 0; i < 5; ++i) p[i] = *(const u32x4*)(recs + (size_t)(n + 1) * REC_BYTES + i * 8192 + tid * 16); }
        f32x4 O[4];
        float zv[4][4];
        const size_t rowbase = (size_t)b * SP + 64 * n;
        if (wave < 4) {
#pragma unroll
            for (int mt = 0; mt < 4; ++mt)
#pragma unroll
                for (int e = 0; e < 4; ++e) zv[mt][e] = bf2f(zo[(rowbase + 16 * mt + 4 * g4 + e) * 512 + h * 64 + dv]);
            const float gl = *(const float*)(recs + (size_t)n * REC_BYTES + 40960);
            bf16x8 Bs[2];
            Bs[0] = pack_frag(S[0], S[1]); Bs[1] = pack_frag(S[2], S[3]);
            f32x4 VN[4];
#pragma unroll
            for (int mt = 0; mt < 4; ++mt) { const u32x2 w = *(const LAS u32x2*)(cur + 4 * 9216 + dv * 144 + (16 * mt + 4 * g4) * 2);
                f32x4 c = (f32x4){bflo(w.x), bfhi(w.x), bflo(w.y), bfhi(w.y)};
#pragma unroll
                for (int ks = 0; ks < 2; ++ks) c = __builtin_amdgcn_mfma_f32_16x16x32_bf16(*(const LAS bf16x8*)(cur + (16 * mt + n_) * 144 + (32 * ks + 8 * g4) * 2), Bs[ks], c, 0, 0, 0);
                VN[mt] = c;
                f32x4 o = (f32x4){0.f, 0.f, 0.f, 0.f};
#pragma unroll
                for (int ks = 0; ks < 2; ++ks) o = __builtin_amdgcn_mfma_f32_16x16x32_bf16(*(const LAS bf16x8*)(cur + 9216 + (16 * mt + n_) * 144 + (32 * ks + 8 * g4) * 2), Bs[ks], o, 0, 0, 0);
                O[mt] = o; }
            bf16x8 Bv[2];
            Bv[0] = pack_frag(VN[0], VN[1]); Bv[1] = pack_frag(VN[2], VN[3]);
#pragma unroll
            for (int mt = 0; mt < 4; ++mt) {
#pragma unroll
                for (int ks = 0; ks < 2; ++ks) O[mt] = __builtin_amdgcn_mfma_f32_16x16x32_bf16(*(const LAS bf16x8*)(cur + 2 * 9216 + (16 * mt + n_) * 144 + (32 * ks + 8 * g4) * 2), Bv[ks], O[mt], 0, 0, 0);
                f32x4 s = S[mt] * gl;
#pragma unroll
                for (int ks = 0; ks < 2; ++ks) s = __builtin_amdgcn_mfma_f32_16x16x32_bf16(*(const LAS bf16x8*)(cur + 3 * 9216 + (16 * mt + n_) * 144 + (32 * ks + 8 * g4) * 2), Bv[ks], s, 0, 0, 0);
                S[mt] = s; }
#pragma unroll
            for (int mt = 0; mt < 4; ++mt)
#pragma unroll
                for (int e = 0; e < 4; ++e) { float q = O[mt][e] * O[mt][e]; q += __shfl_xor(q, 1); q += __shfl_xor(q, 2); q += __shfl_xor(q, 4); q += __shfl_xor(q, 8);
                    if (n_ == 0) red[((n & 1) * 4 + wave) * 64 + 16 * mt + 4 * g4 + e] = q; }
        }
        if (n + 1 < 32) {
#pragma unroll
            for (int i = 0; i < 5; ++i) *(LAS u32x4*)(nxt + i * 9216 + prow * 144 + pc16 * 16) = p[i]; }
        __syncthreads();
        if (wave < 4) {
#pragma unroll
            for (int mt = 0; mt < 4; ++mt)
#pragma unroll
                for (int e = 0; e < 4; ++e) { const int c = 16 * mt + 4 * g4 + e; const LAS float* rp = red + (n & 1) * 256 + c;
                    const float ss = rp[0] + rp[64] + rp[128] + rp[192];
                    const float val = O[mt][e] * rsqrtf(ss * (1.f / 64.f) + EPS) * gn * siluf_(zv[mt][e]);
                    if (st) zo[(rowbase + c) * 512 + h * 64 + dv] = f2bf(val); }
        }
    }
    if (wave < 4 && st) { float* so = a.out + O_STP + (size_t)bh * 4096;
#pragma unroll
        for (int kt = 0; kt < 4; ++kt)
#pragma unroll
            for (int e = 0; e < 4; ++e) so[(16 * kt + 4 * g4 + e) * 64 + dv] = S[kt][e]; }
}

__device__ __forceinline__ void gdn_sample(const Args& a, LAS unsigned char* lds, int u, int tid, int lane, int wave, bool st) {
    const int s = u >> 3, h = u & 7;
    LAS float* raw = (LAS float*)lds;
    LAS float* qkv = raw + 19 * 192;
    LAS float* gs = qkv + 16 * 192;
    LAS float* pa = gs + 32;
    LAS float* pb = pa + 512;
    LAS float* ol = pb + 512;
    const bf16_t* gqkv = (const bf16_t*)(a.ws + WS_GQKV); const float* ab = (const float*)(a.ws + WS_AB);
    for (int i = tid; i < 19 * 192; i += 512) { const int r = i / 192, cc = i - r * 192, seg = cc >> 6, c = cc & 63, col = seg * 512 + h * 64 + c;
        raw[i] = r < 3 ? a.in[I_CONV][((size_t)s * 3 + r) * 1536 + col] : bf2f(gqkv[(size_t)(MP + s * SS + (r - 3)) * 1536 + col]); }
    if (tid < 16) { const size_t row = (size_t)MP + s * SS + tid; const float av = ab[row * 16 + h], bv = ab[row * 16 + 8 + h];
        const float xg = av + a.in[I_DTB][h]; const float sp = fmaxf(xg, 0.f) + __logf(1.f + __expf(-fabsf(xg)));
        gs[tid] = __expf(-__expf(a.in[I_ALOG][h]) * sp); gs[16 + tid] = sigmoidf_(bv); }
    __syncthreads();
    for (int i = tid; i < 16 * 192; i += 512) { const int t = i / 192, cc = i - t * 192, seg = cc >> 6, c = cc & 63, col = seg * 512 + h * 64 + c;
        float y = 0.f;
#pragma unroll
        for (int tap = 0; tap < 4; ++tap) y += a.in[I_CONVW][tap * 1536 + col] * raw[(t + tap) * 192 + cc];
        qkv[i] = siluf_(y); }
    __syncthreads();
    for (int v = wave; v < 32; v += 8) { const int t = v >> 1, seg = v & 1; const float x = qkv[t * 192 + seg * 64 + lane];
        const float ss = wave_sum(x * x); qkv[t * 192 + seg * 64 + lane] = x * rsqrtf(ss + EPS) * (seg ? 1.f : 0.125f); }
    __syncthreads();
    const int dv = tid & 63, dkg = tid >> 6;
    float S[8];
    const float* s0 = a.in[I_ST] + (size_t)u * 4096;
#pragma unroll
    for (int i = 0; i < 8; ++i) S[i] = s0[(8 * dkg + i) * 64 + dv];
    for (int t = 0; t < 16; ++t) {
        const float eg = gs[t], bt = gs[16 + t];
        const LAS float* qr = qkv + t * 192; const LAS float* kr = qr + 64; const float vv = qr[128 + dv];
        float part = 0.f;
#pragma unroll
        for (int i = 0; i < 8; ++i) { S[i] *= eg; part += kr[8 * dkg + i] * S[i]; }
        pa[dkg * 64 + dv] = part;
        __syncthreads();
        float ks = 0.f;
#pragma unroll
        for (int w = 0; w < 8; ++w) ks += pa[w * 64 + dv];
        const float dl = bt * (vv - ks);
        float po = 0.f;
#pragma unroll
        for (int i = 0; i < 8; ++i) { S[i] += kr[8 * dkg + i] * dl; po += qr[8 * dkg + i] * S[i]; }
        pb[dkg * 64 + dv] = po;
        __syncthreads();
        if (dkg == 0) { float o = 0.f;
#pragma unroll
            for (int w = 0; w < 8; ++w) o += pb[w * 64 + dv];
            ol[t * 64 + dv] = o; }
    }
    __syncthreads();
    float* so = a.out + O_STS + (size_t)u * 4096;
#pragma unroll
    for (int i = 0; i < 8; ++i) if (st) so[(8 * dkg + i) * 64 + dv] = S[i];
    bf16_t* zo = (bf16_t*)(a.ws + WS_Z);
    for (int t = wave; t < 16; t += 8) { const float o = ol[t * 64 + lane]; const float ss = wave_sum(o * o);
        const size_t idx = ((size_t)MP + s * SS + t) * 512 + h * 64 + lane;
        const bf16_t res = f2bf(o * rsqrtf(ss * (1.f / 64.f) + EPS) * a.in[I_GNG][lane] * siluf_(bf2f(zo[idx]))); if (st) zo[idx] = res; }
}

struct AttnWave { int qrow, pos, mylast; bool qvalid; };
__device__ __forceinline__ void attn_unit(const Args& a, LAS unsigned char* lds, const bf16_t* Kb, const bf16_t* VTb, int pitch, int head, int ntiles, int nkeys,
                                          const AttnWave w, float boff, int tid, int lane) {
    const int r = lane & 31, hh = lane >> 5;
    const bf16_t* qraw = (const bf16_t*)(a.ws + WS_QRAW); const f32x2* rope = (const f32x2*)(a.ws + WS_ROPE);
    bf16x8 Qf[6];
    {
        const bf16_t* qp = qraw + (size_t)w.qrow * 768 + head * 96 + 8 * hh;
        float v[6][8]; float ss = 0.f;
#pragma unroll
        for (int s = 0; s < 6; ++s) { const u32x4 u = *(const u32x4*)(qp + 16 * s);
            v[s][0] = bflo(u.x); v[s][1] = bfhi(u.x); v[s][2] = bflo(u.y); v[s][3] = bfhi(u.y); v[s][4] = bflo(u.z); v[s][5] = bfhi(u.z); v[s][6] = bflo(u.w); v[s][7] = bfhi(u.w); }
#pragma unroll
        for (int e = 0; e < 8; ++e) { const f32x2 cs = rope[w.pos * 16 + 8 * hh + e]; const float x1 = v[4][e], x2 = v[5][e]; v[4][e] = x1 * cs.x - x2 * cs.y; v[5][e] = x2 * cs.x + x1 * cs.y; }
#pragma unroll
        for (int s = 0; s < 6; ++s)
#pragma unroll
            for (int e = 0; e < 8; ++e) ss += v[s][e] * v[s][e];
        ss += __shfl_xor(ss, 32);
        const float rs = rsqrtf(ss * (1.f / 96.f) + EPS) * (1.4426950408889634f * 0.10206207261596575f);
#pragma unroll
        for (int s = 0; s < 6; ++s) { float o[8];
#pragma unroll
            for (int e = 0; e < 8; ++e) o[e] = v[s][e] * rs * a.in[I_QHG][16 * s + 8 * hh + e];
            Qf[s] = __builtin_bit_cast(bf16x8, pack8(o)); }
    }
    const int kp0row = tid / 12, kp0c = tid - kp0row * 12, kp1row = (tid + 512) / 12, kp1c = (tid + 512) - kp1row * 12, vrow = tid >> 3, vc = tid & 7;
    const int pr = (r & 19) | ((r & 4) << 1) | ((r & 8) >> 1);
    f32x16 oa[2];
#pragma unroll
    for (int i = 0; i < 16; ++i) { oa[0][i] = 0.f; oa[1][i] = 0.f; }
    float lsum = 0.f;
    u32x4 k0, k1, vv;
    k0 = *(const u32x4*)(Kb + (size_t)kp0row * 768 + kp0c * 8); if (tid < 256) k1 = *(const u32x4*)(Kb + (size_t)kp1row * 768 + kp1c * 8);
    vv = *(const u32x4*)(VTb + (size_t)vrow * pitch + vc * 8);
    *(LAS u32x4*)(lds + kp0row * 208 + kp0c * 16) = k0; if (tid < 256) *(LAS u32x4*)(lds + kp1row * 208 + kp1c * 16) = k1;
    *(LAS u32x4*)(lds + 13312 + vrow * 144 + vc * 16) = vv;
    __syncthreads();
    for (int kt = 0; kt < ntiles; ++kt) {
        LAS unsigned char* cur = lds + (kt & 1) * 22528; LAS unsigned char* nxt = lds + ((kt + 1) & 1) * 22528;
        const int key0 = kt * 64;
        if (kt + 1 < ntiles) { const bf16_t* kn = Kb + (size_t)(key0 + 64) * 768;
            k0 = *(const u32x4*)(kn + (size_t)kp0row * 768 + kp0c * 8); if (tid < 256) k1 = *(const u32x4*)(kn + (size_t)kp1row * 768 + kp1c * 8);
            vv = *(const u32x4*)(VTb + (size_t)vrow * pitch + key0 + 64 + vc * 8); }
        if (kt <= w.mylast) {
            f32x16 sa[2];
#pragma unroll
            for (int t2 = 0; t2 < 2; ++t2) {
#pragma unroll
                for (int i = 0; i < 16; ++i) sa[t2][i] = 0.f;
#pragma unroll
                for (int s = 0; s < 6; ++s) sa[t2] = __builtin_amdgcn_mfma_f32_32x32x16_bf16(*(const LAS bf16x8*)(cur + (32 * t2 + pr) * 208 + (16 * s + 8 * hh) * 2), Qf[s], sa[t2], 0, 0, 0);
            }
            const bool tail = key0 + 64 > nkeys;
            bf16x8 Pf[2][2];
#pragma unroll
            for (int t2 = 0; t2 < 2; ++t2) { float p[16];
#pragma unroll
                for (int jj = 0; jj < 16; ++jj) { float e = __builtin_amdgcn_exp2f(sa[t2][jj] - boff);
                    if (tail) { const int key = key0 + 32 * t2 + (jj & 3) + 4 * ((jj >> 2) & 1) + 8 * hh + 16 * (jj >> 3); if (key >= nkeys) e = 0.f; }
                    p[jj] = e; lsum += e; }
                Pf[t2][0] = __builtin_bit_cast(bf16x8, pack8(&p[0])); Pf[t2][1] = __builtin_bit_cast(bf16x8, pack8(&p[8])); }
#pragma unroll
            for (int mt = 0; mt < 2; ++mt)
#pragma unroll
                for (int t2 = 0; t2 < 2; ++t2)
#pragma unroll
                    for (int s2 = 0; s2 < 2; ++s2)
                        oa[mt] = __builtin_amdgcn_mfma_f32_32x32x16_bf16(*(const LAS bf16x8*)(cur + 13312 + (32 * mt + r) * 144 + (32 * t2 + 16 * s2 + 8 * hh) * 2), Pf[t2][s2], oa[mt], 0, 0, 0);
        }
        if (kt + 1 < ntiles) { *(LAS u32x4*)(nxt + kp0row * 208 + kp0c * 16) = k0; if (tid < 256) *(LAS u32x4*)(nxt + kp1row * 208 + kp1c * 16) = k1;
            *(LAS u32x4*)(nxt + 13312 + vrow * 144 + vc * 16) = vv; }
        __syncthreads();
    }
    lsum += __shfl_xor(lsum, 32);
    if (w.qvalid && w.mylast >= 0) { const float inv = 1.f / lsum; bf16_t* op = (bf16_t*)(a.ws + WS_OMLA) + (size_t)w.qrow * 512 + head * 64 + 4 * hh;
#pragma unroll
        for (int mt = 0; mt < 2; ++mt)
#pragma unroll
            for (int q4 = 0; q4 < 4; ++q4) { u32x2 o; o.x = cvt_pk_bf16(oa[mt][4 * q4] * inv, oa[mt][4 * q4 + 1] * inv); o.y = cvt_pk_bf16(oa[mt][4 * q4 + 2] * inv, oa[mt][4 * q4 + 3] * inv);
                *(u32x2*)(op + 32 * mt + 8 * q4) = o; } }
}
__device__ __forceinline__ void attn_phase(const Args& a, LAS unsigned char* lds, int tid, int lane, int wave) {
    const int c = blockIdx.x, G = gridDim.x;
    float mq = fabsf(a.in[I_QHG][lane]), mk = fabsf(a.in[I_KHG][lane]);
    if (lane < 32) { mq = fmaxf(mq, fabsf(a.in[I_QHG][64 + lane])); mk = fmaxf(mk, fabsf(a.in[I_KHG][64 + lane])); }
    const float boff = 9.797958971132712f * wave_max(mq) * wave_max(mk) * 1.4426950408889634f;
    const bf16_t* Kbuf = (const bf16_t*)(a.ws + WS_KBUF); const bf16_t* VT = (const bf16_t*)(a.ws + WS_VT);
#pragma unroll 1
    for (int rep = 0; rep < REPK(6); ++rep) {
    for (int p = c; p < 256; p += G) { const int bh = p >> 2, b = bh >> 3, h = bh & 7;
#pragma unroll 1
        for (int half = 0; half < 2; ++half) { const int qb = half ? 7 - (p & 3) : (p & 3);
            AttnWave w; w.pos = 256 * qb + 32 * wave + (lane & 31); w.qrow = b * SP + w.pos; w.mylast = 4 * qb + (wave >> 1); w.qvalid = true;
            attn_unit(a, lds, Kbuf + (size_t)b * SP * 768 + h * 96, VT + (size_t)bh * 64 * SP, SP, h, 4 * qb + 4, SP, w, boff, tid, lane); } }
    for (int u = (c + G / 2) % G; u < BS * 8; u += G) { const int s = u >> 3, h = u & 7;
        AttnWave w; w.pos = PAST + (lane & 15); w.qrow = MP + s * SS + (lane & 15); w.mylast = wave == 0 ? 32 : -1; w.qvalid = (lane & 31) < 16;
        attn_unit(a, lds, Kbuf + ((size_t)MP + (size_t)s * SKV) * 768 + h * 96, VT + VT_SAMPLE_OFF + (size_t)u * 64 * SKV, SKV, h, 33, SKV, w, boff, tid, lane); }
    }
}

#define XB_TMO      128
#define XB_XCNT(j)  (256  + 64 * (j))
#define XB_XSUB(j)  (1280 + 64 * (j))
#define XB_XGEN(j)  (2304 + 64 * (j))
#define XB_TOP      3328
#define XB_TOPGEN   3392
#define XCD_BAR_WORDS 3456
#define XB_SPIN_CAP (1u << 18)

__device__ __forceinline__ unsigned xb_ld(unsigned* p)              { return __hip_atomic_load(p, __ATOMIC_RELAXED, __HIP_MEMORY_SCOPE_AGENT); }
__device__ __forceinline__ unsigned xb_add(unsigned* p, unsigned v) { return __hip_atomic_fetch_add(p, v, __ATOMIC_RELAXED, __HIP_MEMORY_SCOPE_AGENT); }
__device__ __forceinline__ unsigned xb_xcc_id() { return (unsigned)__builtin_amdgcn_s_getreg((3 << 11) | 20) & 0xFu; }
#define XB_SPIN(cond, bar) do { unsigned _sp = 0; while (cond) { __builtin_amdgcn_s_sleep(1); \
    if ((++_sp & 255u) == 0u) { if (xb_ld(&(bar)[XB_TMO])) break; if (_sp > XB_SPIN_CAP) { atomicAdd(&(bar)[XB_TMO], 1u); break; } } } } while (0)

struct XcdBarrier {
    unsigned* bar; unsigned x;
    volatile LAS unsigned* st;
};

__device__ __forceinline__ XcdBarrier xcd_barrier_post(unsigned* bar, volatile LAS unsigned* st) {
    XcdBarrier b; b.bar = bar; b.x = xb_xcc_id(); b.st = st;
    if (threadIdx.x == 0) (void)xb_add(&bar[XB_XCNT(b.x)], 1u);
    return b;
}
__device__ __forceinline__ void xcd_barrier_complete(unsigned* bar, unsigned x, unsigned& nloc, unsigned& nx) {
    const unsigned G = gridDim.x * gridDim.y * gridDim.z;
    unsigned sum, cnt, mine, sp = 0u;
    for (;;) {
        sum = 0u; cnt = 0u; mine = 0u;
#pragma unroll
        for (unsigned j = 0; j < 16; ++j) { const unsigned c = xb_ld(&bar[XB_XCNT(j)]); sum += c; cnt += (c > 0u) ? 1u : 0u; mine = (j == x) ? c : mine; }
        if (sum == G) break;
        __builtin_amdgcn_s_sleep(1);
        if ((++sp & 255u) == 0u) { if (xb_ld(&bar[XB_TMO])) break; if (sp > XB_SPIN_CAP) { atomicAdd(&bar[XB_TMO], 1u); break; } }
    }
    nloc = mine > 0u ? mine : 1u; nx = cnt > 0u ? cnt : 1u;
}

__device__ __forceinline__ void xcd_barrier(const XcdBarrier& b) {
    asm volatile("s_waitcnt vmcnt(0)" ::: "memory");
    __syncthreads();
    if (threadIdx.x == 0) {
        unsigned* bar = b.bar;
        __builtin_amdgcn_s_waitcnt(0);
        unsigned nloc = b.st[0], nx = b.st[1];
        if (nloc == 0u) { xcd_barrier_complete(bar, b.x, nloc, nx); b.st[0] = nloc; b.st[1] = nx; }
        const unsigned old = xb_add(&bar[XB_XSUB(b.x)], 1u);
        const unsigned gen = old / nloc;
        if (old + 1u == (gen + 1u) * nloc) {
            __builtin_amdgcn_fence(__ATOMIC_RELEASE, "agent");
            asm volatile("s_waitcnt vmcnt(0)" ::: "memory");
            const unsigned og = xb_add(&bar[XB_TOP], 1u);
            const unsigned tg = og / nx;
            if (og + 1u == (tg + 1u) * nx) xb_add(&bar[XB_TOPGEN], 1u);
            else XB_SPIN(xb_ld(&bar[XB_TOPGEN]) == tg, bar);
            __builtin_amdgcn_fence(__ATOMIC_ACQUIRE, "agent");
            xb_add(&bar[XB_XGEN(b.x)], 1u);
            asm volatile("s_waitcnt vmcnt(0)" ::: "memory");
        } else {
            XB_SPIN(xb_ld(&bar[XB_XGEN(b.x)]) == gen, bar);
            __builtin_amdgcn_fence(__ATOMIC_ACQUIRE, "agent");
            asm volatile("s_waitcnt vmcnt(0)" ::: "memory");
        }
    }
    __syncthreads();
}


__global__ void __launch_bounds__(512, 2) mk_fwd(Args a) {
    extern __shared__ __attribute__((aligned(16))) unsigned char lds_raw[];
    LAS unsigned char* lds = (LAS unsigned char*)lds_raw;
    const int tid = threadIdx.x, lane = tid & 63, wave = __builtin_amdgcn_readfirstlane(tid >> 6);
    const int c = blockIdx.x, G = gridDim.x, gw = c * 8 + wave;
    unsigned char* ws = a.ws;
    volatile LAS unsigned* bst = (volatile LAS unsigned*)(lds + 147456);
    if (tid < 16) bst[tid] = 0u;
    __syncthreads();
    XcdBarrier xbar = xcd_barrier_post((unsigned*)(ws + WS_CTL) + CW_BAR, bst);
    const int lo = a.ph_lo, hi = a.ph_hi;
    if (hi > 4096) cg::this_grid().sync();
#define IN(k) (((MK_PHMASK >> (k)) & 1) && lo <= (k) && (k) < hi)
#if MK_SPLIT
#define SEAM(k) do { } while (0)
#else
#define SEAM(k) do { if (IN(k) && IN((k) + 1)) xcd_barrier(xbar); } while (0)
#endif
    const bf16_t* H = (const bf16_t*)(ws + WS_H);
    float* mod = (float*)(ws + WS_MOD);
    if (IN(0)) phase0(a, lds, tid, lane, wave);
    SEAM(0);
#if MK_XSYNC && !MK_SPLIT
#pragma unroll 1
    for (int x = 0; x < MK_XSYNC; ++x) cg::this_grid().sync();
#endif
    if (IN(1)) norm_rows(a.in[I_XP], a.in[I_XS], a.in[I_N1G], mod, 0, 1024, (bf16_t*)(ws + WS_H), gw, lane, nullptr, nullptr);
    SEAM(1);
    if (IN(2)) { pg8::Gemm g{{H, H}, {(const bf16_t*)(ws + WS_WIN), nullptr}, 1024, 1024, 1024}; pg8::StaticOrder S; S.init(MR / 256, NINP / 256, G, c, REPK(2));
        EpiProj E{(bf16_t*)(ws + WS_GQKV), (bf16_t*)(ws + WS_Z), (bf16_t*)a.out, (bf16_t*)(ws + WS_GLS), (bf16_t*)(ws + WS_CKVRAW), (bf16_t*)(ws + WS_CQ), (float*)(ws + WS_KRRAW), (float*)(ws + WS_AB)};
        pg8::gemm_phase(lds, g, S, E); }
    SEAM(2);
    if (IN(3)) { gdn_prep(a, lds, tid); mla_rows(a, gw, lane); misc_p3(a, tid); }
    SEAM(3);
    if (IN(4)) {
#pragma unroll 1
        for (int rep = REPK(4) - 1; rep >= 0; --rep) for (int u = c; u < 192; u += G) { if (u < 64) scan_prompt(a, lds, u, tid, lane, wave, rep == 0); else gdn_sample(a, lds, u - 64, tid, lane, wave, rep == 0); __syncthreads(); } }
    SEAM(4);
    if (IN(5)) {
        { pg8::Gemm g{{(const bf16_t*)(ws + WS_CQ), nullptr}, {(const bf16_t*)(ws + WS_WUQ), nullptr}, 384, 384, 384}; pg8::StaticOrder S; S.init(MR / 256, 3, G, c, REPK(5));
          EpiBf16<0> E{(bf16_t*)(ws + WS_QRAW), 768}; pg8::gemm_phase(lds, g, S, E); }
        { pg8::Gemm g{{(const bf16_t*)(ws + WS_CKVROWS), nullptr}, {(const bf16_t*)(ws + WS_WUK), nullptr}, 256, 256, 256}; pg8::StaticOrder S; S.init(KR / 256, 2, G, (c + G - 195 % G) % G, REPK(5));
          EpiK E{(bf16_t*)(ws + WS_KBUF), a.in[I_KHG], a.out + O_KRP, a.out + O_KRS, a.in[I_CKR]}; pg8::gemm_phase(lds, g, S, E); }
        { pg8::Gemm g{{(const bf16_t*)(ws + WS_WUV), nullptr}, {(const bf16_t*)(ws + WS_CKVROWS), nullptr}, 256, 256, 256}; pg8::StaticOrder S; S.init(2, KR / 256, G, (c + G - 69 % G) % G, REPK(5));
          EpiVT E{(bf16_t*)(ws + WS_VT)}; pg8::gemm_phase(lds, g, S, E); }
    }
    SEAM(5);
    if (IN(6)) attn_phase(a, lds, tid, lane, wave);
    SEAM(6);
    if (IN(7)) { pg8::Gemm g{{(const bf16_t*)(ws + WS_Z), (const bf16_t*)(ws + WS_OMLA)}, {(const bf16_t*)(ws + WS_WGO), (const bf16_t*)(ws + WS_WMO)}, 512, 512, 512};
        pg8::DualOrder S; S.S.init(MR / 256, 4, G, c, REPK(7)); EpiGate E{(bf16_t*)(ws + WS_MERGED), (const bf16_t*)a.out, (const bf16_t*)(ws + WS_GLS)}; pg8::gemm_phase(lds, g, S, E); }
    SEAM(7);
    if (IN(8)) { pg8::Gemm g{{(const bf16_t*)(ws + WS_MERGED), nullptr}, {(const bf16_t*)(ws + WS_WO), nullptr}, 1024, 1024, 1024}; pg8::StaticOrder S; S.init(MP / 256, 4, G, c, REPK(8));
        EpiRes E{a.in[I_XP], a.in[I_XS], a.out, mod, 2048}; pg8::gemm_phase(lds, g, S, E);
        pg8::PieceOrder P{4, 4, G, c, 16, 16, 256};
        pg8::Gemm gs{{(const bf16_t*)(ws + WS_MERGED), nullptr}, {(const bf16_t*)(ws + WS_WO), nullptr}, 1024, 1024, 256}; EpiAtom Es{(float*)(ws + WS_PART8), 1024, mod, 2048, 256}; pg8::gemm_phase(lds, gs, P, Es); }
    SEAM(8);
    if (IN(9)) norm_rows(a.out, a.in[I_XS], a.in[I_N2G], mod, 3072, 4096, (bf16_t*)(ws + WS_H), gw, lane, (const float*)(ws + WS_PART8), a.out + (size_t)MP * 1024);
    SEAM(9);
    if (IN(10)) { pg8::Gemm g{{H, nullptr}, {(const bf16_t*)(ws + WS_WF1), nullptr}, 1024, 1024, 1024}; pg8::StaticOrder S; S.init(MR / 256, 16, G, c, REPK(10));
        EpiBf16<1> E{(bf16_t*)(ws + WS_HID), DFF}; pg8::gemm_phase(lds, g, S, E); }
    SEAM(10);
    if (IN(11)) { pg8::Gemm g{{(const bf16_t*)(ws + WS_HID), nullptr}, {(const bf16_t*)(ws + WS_WF2), nullptr}, DFF, DFF, DFF}; pg8::StaticOrder S; S.init(MP / 256, 4, G, c);
        EpiRes E{a.out, a.out + (size_t)MP * 1024, a.out, mod, 5120}; pg8::gemm_phase(lds, g, S, E);
        pg8::PieceOrder P{4, 8, G, c, 8, 32, 512};
        pg8::Gemm gs{{(const bf16_t*)(ws + WS_HID), nullptr}, {(const bf16_t*)(ws + WS_WF2), nullptr}, DFF, DFF, 512}; EpiAtom Es{(float*)(ws + WS_PART11), 1024, mod, 5120, 512}; pg8::gemm_phase(lds, gs, P, Es); }
    SEAM(11);
    if (IN(12)) {
        for (int i = c * 512 + tid; i < MS * 256; i += G * 512) { f32x4 v = ((const f32x4*)(a.out + (size_t)MP * 1024))[i];
#pragma unroll
            for (int k = 0; k < 8; ++k) v += ((const f32x4*)(ws + WS_PART11))[(size_t)k * (MS * 256) + i];
            ((f32x4*)(a.out + (size_t)MP * 1024))[i] = v; } }
#undef IN
#undef SEAM
}

extern "C" void kernel_launch(void* const* d_in, const int* in_sizes, int n_in, void* d_out, int out_size, void* d_ws, size_t ws_size, hipStream_t stream) {
    static int grid = 0;
    if (grid == 0) {
        int dev = 0, cus = 0, per_cu = 0;
        hipGetDevice(&dev); hipDeviceGetAttribute(&cus, hipDeviceAttributeMultiprocessorCount, dev);
        hipFuncSetAttribute((const void*)mk_fwd, hipFuncAttributeMaxDynamicSharedMemorySize, LDS_BYTES);
        hipOccupancyMaxActiveBlocksPerMultiprocessor(&per_cu, (const void*)mk_fwd, 512, LDS_BYTES);
        if (per_cu < 1) per_cu = 1;
        grid = cus * per_cu; if (grid > 256) grid = 256;
        (void)hipGetLastError();
    }
    hipMemsetAsync((char*)d_ws + WS_CTL, 0, 64 * KiB, stream);
    Args a{};
    for (int i = 0; i < 28; ++i) a.in[i] = (const float*)d_in[i];
    a.out = (float*)d_out; a.ws = (unsigned char*)d_ws;
#if MK_SPLIT
    for (int p = 0; p < NPHASE; ++p) { a.ph_lo = p; a.ph_hi = p + 1; hipLaunchKernelGGL(mk_fwd, dim3(grid), dim3(512), LDS_BYTES, stream, a); }
#else
    a.ph_lo = 0; a.ph_hi = NPHASE;
    void* args[] = {&a};
    hipError_t e = hipLaunchCooperativeKernel((const void*)mk_fwd, dim3(grid), dim3(512), args, LDS_BYTES, stream);
    if (e != hipSuccess) fprintf(stderr, "cooperative launch failed: %s (grid %d)\n", hipGetErrorString(e), grid);
#endif
}
```

```cpp
#include <hip/hip_runtime.h>
#include <hip/hip_cooperative_groups.h>
#include <cstdio>
#include <cstdint>
namespace cg = cooperative_groups;

#ifndef REP_GEMM
#define REP_GEMM 0x111111111111ull
#endif
#define REPK(k) ((int)((REP_GEMM >> (4 * (k))) & 15))
#ifndef PROBE_A
#define PROBE_A -1
#endif
#ifndef PROBE_B
#define PROBE_B -1
#endif
#ifndef PROBE_LP
#define PROBE_LP 0
#endif
#ifndef MK_XSYNC
#define MK_XSYNC 0
#endif
#ifndef MK_PHMASK
#define MK_PHMASK 0x1FFF
#endif
#ifndef MK_SPLIT
#define MK_SPLIT 0
#endif

#define LAS __attribute__((address_space(3)))
typedef unsigned short bf16_t;
typedef short bf16x8 __attribute__((ext_vector_type(8)));
typedef float f32x4 __attribute__((ext_vector_type(4)));
typedef float f32x2 __attribute__((ext_vector_type(2)));
typedef float f32x16 __attribute__((ext_vector_type(16)));
typedef unsigned u32x4 __attribute__((ext_vector_type(4)));
typedef unsigned u32x2 __attribute__((ext_vector_type(2)));

constexpr int DM = 1024, BP = 8, SP = 2048, BS = 16, SS = 16, PAST = 2048;
constexpr int MP = BP * SP, MS = BS * SS, MR = MP + MS;
constexpr int SKV = PAST + SS;
constexpr int KR = MP + BS * SKV;
constexpr int NIN = 4784, NINP = 4864;
constexpr int DFF = 4096;
constexpr float EPS = 1e-6f;

constexpr size_t O_Y = 0, O_CKVP = 17039360, O_KRP = 21233664, O_STP = 21757952, O_CVP = 22020096,
                 O_CKVS = 22056960, O_KRS = 22122496, O_STS = 22130688, O_CVS = 22654976;

constexpr size_t KiB = 1024, MiB = 1024 * 1024;
constexpr size_t WS_CTL = 0;
constexpr size_t WS_MOD = 64 * KiB;
constexpr size_t WS_ROPE = 640 * KiB;
constexpr size_t WS_WIN = 960 * KiB;
constexpr size_t WS_WUQ = WS_WIN + (size_t)NINP * 1024 * 2;
constexpr size_t WS_WUK = WS_WUQ + 768 * 384 * 2;
constexpr size_t WS_WUV = WS_WUK + 512 * 256 * 2;
constexpr size_t WS_WGO = WS_WUV + 512 * 256 * 2;
constexpr size_t WS_WMO = WS_WGO + 1024 * 512 * 2;
constexpr size_t WS_WO = WS_WMO + 1024 * 512 * 2;
constexpr size_t WS_WF1 = WS_WO + 1024 * 1024 * 2;
constexpr size_t WS_WF2 = WS_WF1 + (size_t)4096 * 1024 * 2;
constexpr size_t WS_WEND = WS_WF2 + (size_t)4096 * 1024 * 2;
static_assert(WS_WEND <= 32 * MiB, "weights region");
constexpr size_t WS_H = 32 * MiB;
constexpr size_t WS_CKVROWS = 32 * MiB;
constexpr size_t WS_OMLA = 32 * MiB;
constexpr size_t WS_GQKV = 64 * MiB + 512 * KiB;
constexpr size_t WS_VT = WS_GQKV;
constexpr size_t WS_Z = 113 * MiB + 256 * KiB;
constexpr size_t WS_CQ = 129 * MiB + 512 * KiB;
constexpr size_t WS_CKVRAW = WS_CQ + (size_t)MR * 384 * 2;
constexpr size_t WS_KRRAW = WS_CKVRAW + (size_t)MR * 256 * 2;
constexpr size_t WS_AB = WS_KRRAW + (size_t)MR * 32 * 4;
static_assert(WS_AB + (size_t)MR * 16 * 4 <= 153 * MiB, "small proj outputs");
constexpr size_t WS_PREP = 153 * MiB;
constexpr size_t REC_BYTES = 41024;
static_assert(WS_PREP + (size_t)2048 * REC_BYTES <= 256 * MiB, "prep region");
constexpr size_t WS_KBUF = 153 * MiB;
constexpr size_t WS_QRAW = WS_KBUF + (size_t)KR * 768 * 2;
static_assert(WS_QRAW + (size_t)MR * 768 * 2 <= 256 * MiB, "qraw");
constexpr size_t WS_MERGED = 153 * MiB;
constexpr size_t WS_HID = 64 * MiB + 512 * KiB;
static_assert(WS_HID + (size_t)MR * DFF * 2 <= 256 * MiB, "hid");
constexpr size_t WS_GLS = 250 * MiB;
constexpr size_t WS_PART8 = 186 * MiB;
constexpr size_t WS_PART7 = 196 * MiB;
constexpr size_t WS_PART11 = 196 * MiB;
constexpr size_t WS_HACC = 251 * MiB;
constexpr size_t WS_MACC = 255 * MiB;
constexpr size_t WS_X1B = 212 * MiB;
static_assert(WS_X1B + (size_t)MP * 1024 * 2 <= 250 * MiB, "x1b");
constexpr size_t VT_SAMPLE_OFF = (size_t)BP * 8 * 64 * SP;

constexpr int LDS_BYTES = 147456 + 64;
constexpr int CW_BAR = 4096;
constexpr int NPHASE = 13;

__device__ __forceinline__ unsigned cvt_pk_bf16(float lo, float hi) { unsigned r; asm volatile("v_cvt_pk_bf16_f32 %0, %1, %2" : "=v"(r) : "v"(lo), "v"(hi)); return r; }
__device__ __forceinline__ float bflo(unsigned u) { return __uint_as_float(u << 16); }
__device__ __forceinline__ float bfhi(unsigned u) { return __uint_as_float(u & 0xffff0000u); }
__device__ __forceinline__ float bf2f(bf16_t b) { return __uint_as_float((unsigned)b << 16); }
__device__ __forceinline__ bf16_t f2bf(float f) { return (bf16_t)(cvt_pk_bf16(f, 0.f) & 0xffffu); }
__device__ __forceinline__ float wave_max(float v) {
#pragma unroll
    for (int o = 1; o < 64; o <<= 1) v = fmaxf(v, __shfl_xor(v, o));
    return v;
}
__device__ __forceinline__ void lds_barrier() { asm volatile("s_waitcnt lgkmcnt(0)\n\ts_barrier" ::: "memory"); }
__device__ __forceinline__ float dpp_add(float v, const int ctrl) { return v; }
#define DPP_ADD(v, ctrl) ((v) + __builtin_bit_cast(float, __builtin_amdgcn_update_dpp(0, __builtin_bit_cast(int, (v)), (ctrl), 0xF, 0xF, true)))
__device__ __forceinline__ float row16_sum(float v) { v = DPP_ADD(v, 0xB1); v = DPP_ADD(v, 0x4E); v = DPP_ADD(v, 0x141); v = DPP_ADD(v, 0x140); return v; }
__device__ __forceinline__ float wave_sum(float v) { v = row16_sum(v); v += __shfl_xor(v, 16); v += __shfl_xor(v, 32); return v; }
__device__ __forceinline__ float sigmoidf_(float x) { return 1.f / (1.f + __expf(-x)); }
__device__ __forceinline__ float siluf_(float x) { return x / (1.f + __expf(-x)); }
__device__ __forceinline__ u32x4 pack8(const float* v) { u32x4 w; w.x = cvt_pk_bf16(v[0], v[1]); w.y = cvt_pk_bf16(v[2], v[3]); w.z = cvt_pk_bf16(v[4], v[5]); w.w = cvt_pk_bf16(v[6], v[7]); return w; }
__device__ __forceinline__ int mod_row(int r) { return r < MP ? (r >> 11) : 8 + ((r - MP) >> 4); }

namespace pg8 {
constexpr int BM = 256, BK = 64, HALF = 128, HTB = HALF * BK * 2, STAGE_BYTES = 8 * HTB, NXCD = 8, WGM = 8;
__host__ __device__ __forceinline__ int lds_byte(int r, int c) { const int st = (r >> 4) * 2 + (c >> 5), rr = r & 15, cc = c & 31, ob = rr * 64 + cc * 2; return st * 1024 + (ob ^ (((ob >> 9) & 1) << 5)); }
__host__ __device__ __forceinline__ void stage_rc(int b, int& R, int& C) { const int st = b / 1024, sb = b % 1024, swz = sb ^ (((sb >> 9) & 1) << 5); R = (st >> 1) * 16 + swz / 64; C = (st & 1) * 32 + (swz % 64) / 2; }
__host__ __device__ __forceinline__ int perm32(int rho) { const int n = rho >> 4, i = rho & 15; return 8 * (i >> 2) + 4 * n + (i & 3); }

struct Unit { int pm, pn, sel, pk; };
struct Gemm { const bf16_t* A[2]; const bf16_t* Bt[2]; int lda, ldb, K; };

struct StaticOrder {
    int nM, nN, nwg, G, c, rep;
    __device__ void init(int nM_, int nN_, int G_, int c_, int rep_ = 1) { nM = nM_; nN = nN_; nwg = nM * nN; G = G_; c = c_; rep = rep_; }
    __device__ __forceinline__ bool next(int i, Unit& u) const {
        const long L = (long)(i / rep) * G + c; if (L >= nwg) return false;
        int wgid = (int)L; { const int q = nwg / NXCD, r = nwg % NXCD, xcd = wgid % NXCD, off = wgid / NXCD; wgid = (xcd < r ? xcd * (q + 1) : r * (q + 1) + (xcd - r) * q) + off; }
        const int nig = WGM * nN, gid = wgid / nig, fm = gid * WGM, gsz = (nM - fm) < WGM ? (nM - fm) : WGM;
        u.pm = fm + ((wgid % nig) % gsz); u.pn = (wgid % nig) / gsz; u.sel = 0; u.pk = 0; return true;
    }
};
struct PieceOrder {
    int npn, nks, G, c, stride, npieces, klen, off;
    __device__ __forceinline__ bool next(int i, Unit& u) const {
        const int q_ = (c >> 3) - off; if (i != 0 || q_ < 0 || (q_ % stride) != 0) return false; const int L = (c & 7) + 8 * (q_ / stride); if (L >= npieces) return false;
        u.pm = 64; u.pn = L % npn; const int r = L / npn; u.pk = (r % nks) * klen; u.sel = r / nks; return true;
    }
};
struct DualOrder {
    StaticOrder S;
    __device__ __forceinline__ bool next(int i, Unit& u) const { const bool ok = S.next(i >> 1, u); u.sel = i & 1; return ok; }
};

template <class Epi, class Sched>
__device__ __forceinline__ void gemm_phase(LAS unsigned char* lds, const Gemm g, const Sched& S, const Epi& E) {
    const int tid = threadIdx.x, wid = __builtin_amdgcn_readfirstlane(tid >> 6), lane = tid & 63, wr = wid >> 2, wc = wid & 3, fr = lane & 15, fq = lane >> 4;
    const int K = g.K, nt = K / BK;
    unsigned voffA[2], voffB[2];
#pragma unroll
    for (int i = 0; i < 2; ++i) { int R, C; stage_rc(tid * 16 + i * 8192, R, C); const int Rb = Epi::PERM ? ((R & ~31) + perm32(R & 31)) : R;
        voffA[i] = (unsigned)(R * g.lda + C) * 2u; voffB[i] = (unsigned)(Rb * g.ldb + C) * 2u; }
    const size_t kstep = (size_t)(BK * 2);
    const size_t hstepA = (size_t)HALF * g.lda * 2, hstepB = (size_t)HALF * g.ldb * 2;
    const size_t tstepA = 2 * hstepA, tstepB = 2 * hstepB;
    const unsigned ldsw = (unsigned)wid * 1024u;
    const int aoff = lds_byte(wr * 64 + fr, fq * 8), boff = lds_byte(wc * 32 + fr, fq * 8);
#define PG8_SA(b, h) (((b) * 2 + (h)) * HTB)
#define PG8_SB(b, h) ((4 + (b) * 2 + (h)) * HTB)
#define PG8_STAGE(bufoff, gbase, voff) do { _Pragma("unroll") for (int _i = 0; _i < 2; ++_i) \
        __builtin_amdgcn_global_load_lds((const unsigned*)((const char*)(gbase) + (voff)[_i]), (LAS unsigned*)(lds + (bufoff) + ldsw + _i * 8192), 16, 0, 0); } while (0)
#define PG8_LDA(dst, b, h) do { _Pragma("unroll") for (int m = 0; m < 4; ++m) _Pragma("unroll") for (int k = 0; k < 2; ++k) dst[m][k] = *(const LAS bf16x8*)(lds + PG8_SA(b, h) + aoff + m * 2048 + k * 1024); } while (0)
#define PG8_LDB(dst, b, h) do { _Pragma("unroll") for (int n = 0; n < 2; ++n) _Pragma("unroll") for (int k = 0; k < 2; ++k) dst[n][k] = *(const LAS bf16x8*)(lds + PG8_SB(b, h) + boff + n * 2048 + k * 1024); } while (0)
#define PG8_MMA(ai, bj, At, Bt) do { __builtin_amdgcn_s_setprio(1); _Pragma("unroll") for (int m = 0; m < 4; ++m) _Pragma("unroll") for (int n = 0; n < 2; ++n) _Pragma("unroll") for (int k = 0; k < 2; ++k) \
        acc[ai][bj][m][n] = __builtin_amdgcn_mfma_f32_16x16x32_bf16(Bt[n][k], At[m][k], acc[ai][bj][m][n], 0, 0, 0); __builtin_amdgcn_s_setprio(0); } while (0)
#define PG8_WAIT_V(n) asm volatile("s_waitcnt vmcnt(" #n ")" ::: "memory")
#define PG8_WAIT_L(n) asm volatile("s_waitcnt lgkmcnt(" #n ")" ::: "memory")
#define PG8_BAR __builtin_amdgcn_s_barrier()
#define PG8_SCHED __builtin_amdgcn_sched_barrier(0)
    Unit cur, nxt; int ui = 0;
    if (!S.next(0, cur)) return;
    f32x4 acc[2][2][4][2];
#pragma unroll
    for (int a = 0; a < 2; ++a)
#pragma unroll
        for (int b = 0; b < 2; ++b)
#pragma unroll
            for (int m = 0; m < 4; ++m)
#pragma unroll
                for (int n = 0; n < 2; ++n) acc[a][b][m][n] = (f32x4){0.f, 0.f, 0.f, 0.f};
    bf16x8 At[4][2], B0[2][2], B1[2][2];
    const char* cA = (const char*)(cur.sel ? g.A[1] : g.A[0]) + (size_t)cur.pm * tstepA + (size_t)cur.pk * 2; const char* cB = (const char*)(cur.sel ? g.Bt[1] : g.Bt[0]) + (size_t)cur.pn * tstepB + (size_t)cur.pk * 2;
    PG8_STAGE(PG8_SB(0, 0), cB, voffB); PG8_STAGE(PG8_SB(0, 1), cB + hstepB, voffB); PG8_STAGE(PG8_SA(0, 0), cA, voffA); PG8_STAGE(PG8_SA(0, 1), cA + hstepA, voffA);
    if (wr == 1) PG8_BAR;
    PG8_WAIT_V(2); PG8_BAR;
    PG8_STAGE(PG8_SB(1, 0), cB + kstep, voffB); PG8_STAGE(PG8_SA(1, 0), cA + kstep, voffA); PG8_STAGE(PG8_SB(1, 1), cB + hstepB + kstep, voffB);
    PG8_WAIT_V(6); PG8_BAR;
    for (;;) {
        const bool has_next = S.next(ui + 1, nxt);
        const char* nA = has_next ? (const char*)(nxt.sel ? g.A[1] : g.A[0]) + (size_t)nxt.pm * tstepA + (size_t)nxt.pk * 2 : cA; const char* nB = has_next ? (const char*)(nxt.sel ? g.Bt[1] : g.Bt[0]) + (size_t)nxt.pn * tstepB + (size_t)nxt.pk * 2 : cB;
#pragma unroll 1
        for (int t = 0; t < nt; t += 2) {
            const bool last = (t == nt - 2);
            const char* a1 = cA + (size_t)(t + 1) * kstep;
            const char* a2 = last ? nA : cA + (size_t)(t + 2) * kstep; const char* b2 = last ? nB : cB + (size_t)(t + 2) * kstep;
            const char* a3 = a2 + kstep; const char* b3 = b2 + kstep;
            PG8_LDB(B0, 0, 0); PG8_LDB(B1, 0, 1); PG8_SCHED; PG8_LDA(At, 0, 0); PG8_STAGE(PG8_SA(1, 1), a1 + hstepA, voffA);
            PG8_WAIT_V(8); PG8_WAIT_L(0); PG8_BAR; PG8_MMA(0, 0, At, B0); PG8_MMA(0, 1, At, B1); PG8_BAR; PG8_SCHED;
            PG8_LDA(At, 0, 1); PG8_STAGE(PG8_SB(0, 0), b2, voffB); PG8_STAGE(PG8_SB(0, 1), b2 + hstepB, voffB); PG8_STAGE(PG8_SA(0, 0), a2, voffA);
            PG8_WAIT_V(8); PG8_WAIT_L(0); PG8_BAR; PG8_MMA(1, 0, At, B0); PG8_MMA(1, 1, At, B1); PG8_BAR; PG8_SCHED;
            PG8_LDB(B0, 1, 0); PG8_LDB(B1, 1, 1); PG8_SCHED; PG8_LDA(At, 1, 0); PG8_STAGE(PG8_SA(0, 1), a2 + hstepA, voffA);
            PG8_WAIT_V(8); PG8_WAIT_L(0); PG8_BAR; PG8_MMA(0, 0, At, B0); PG8_MMA(0, 1, At, B1); PG8_BAR; PG8_SCHED;
            PG8_LDA(At, 1, 1); PG8_STAGE(PG8_SB(1, 0), b3, voffB); PG8_STAGE(PG8_SB(1, 1), b3 + hstepB, voffB); PG8_STAGE(PG8_SA(1, 0), a3, voffA);
            PG8_WAIT_V(8); PG8_WAIT_L(0); PG8_BAR; PG8_MMA(1, 0, At, B0); PG8_MMA(1, 1, At, B1); PG8_BAR; PG8_SCHED;
        }
        if (wr == 0) PG8_BAR;
        E(acc, cur, wr, wc, fr, fq);
        if (!has_next) break;
#pragma unroll
        for (int a = 0; a < 2; ++a)
#pragma unroll
            for (int b = 0; b < 2; ++b)
#pragma unroll
                for (int m = 0; m < 4; ++m)
#pragma unroll
                    for (int n = 0; n < 2; ++n) acc[a][b][m][n] = (f32x4){0.f, 0.f, 0.f, 0.f};
        cur = nxt; cA = nA; cB = nB; ++ui;
        if (wr == 1) PG8_BAR;
    }
    PG8_WAIT_V(0);
    PG8_BAR;
#undef PG8_SA
#undef PG8_SB
#undef PG8_STAGE
#undef PG8_LDA
#undef PG8_LDB
#undef PG8_MMA
#undef PG8_WAIT_V
#undef PG8_WAIT_L
#undef PG8_BAR
#undef PG8_SCHED
}
}
using pg8::Unit;

#define EPI_ARGS const f32x4 (&acc)[2][2][4][2], const Unit& u, int wr, int wc, int fr, int fq
__device__ __forceinline__ u32x4 pack_v(const f32x4 v0, const f32x4 v1) { u32x4 w; w.x = cvt_pk_bf16(v0[0], v0[1]); w.y = cvt_pk_bf16(v0[2], v0[3]); w.z = cvt_pk_bf16(v1[0], v1[1]); w.w = cvt_pk_bf16(v1[2], v1[3]); return w; }

struct EpiProj {
    static constexpr bool PERM = true;
    bf16_t *gqkv, *z, *gl, *gls, *ckvraw, *cq; float *krraw, *ab;
    __device__ __forceinline__ void operator()(EPI_ARGS) const {
        const int pn = u.pn; bf16_t* base; int pitch;
        if (pn < 6) { base = gqkv + pn * 256; pitch = 1536; } else if (pn < 8) { base = z + (pn - 6) * 256; pitch = 512; }
        else if (pn < 16) { base = (u.pm == 64 ? gls - (size_t)MP * 2048 : gl) + (pn - 8) * 256; pitch = 2048; } else if (pn == 16) { base = ckvraw; pitch = 256; }
        else if (pn == 17) { base = cq; pitch = 384; } else { base = cq + 256; pitch = 384; }
#pragma unroll
        for (int ai = 0; ai < 2; ++ai)
#pragma unroll
            for (int m = 0; m < 4; ++m) { const size_t row = (size_t)u.pm * 256 + ai * 128 + wr * 64 + m * 16 + fr;
#pragma unroll
                for (int bj = 0; bj < 2; ++bj) { const int ct = bj * 128 + wc * 32 + 8 * fq; const f32x4 v0 = acc[ai][bj][m][0], v1 = acc[ai][bj][m][1];
                    if (pn < 18 || bj == 0) { *(u32x4*)(base + row * pitch + ct) = pack_v(v0, v1); }
                    else if (wc == 0) { float* d = krraw + row * 32 + 8 * fq; *(f32x4*)d = v0; *(f32x4*)(d + 4) = v1; }
                    else if (wc == 1 && fq < 2) { float* d = ab + row * 16 + 8 * fq; *(f32x4*)d = v0; *(f32x4*)(d + 4) = v1; }
                } }
    }
};
template <int ACT> struct EpiBf16 {
    static constexpr bool PERM = true;
    bf16_t* O; int ldc;
    __device__ __forceinline__ void operator()(EPI_ARGS) const {
#pragma unroll
        for (int ai = 0; ai < 2; ++ai)
#pragma unroll
            for (int m = 0; m < 4; ++m) { const size_t row = (size_t)u.pm * 256 + ai * 128 + wr * 64 + m * 16 + fr;
#pragma unroll
                for (int bj = 0; bj < 2; ++bj) { const int col = u.pn * 256 + bj * 128 + wc * 32 + 8 * fq; f32x4 v0 = acc[ai][bj][m][0], v1 = acc[ai][bj][m][1];
                    if (ACT == 1) {
#pragma unroll
                        for (int e = 0; e < 4; ++e) { const float a = fmaxf(v0[e], 0.f), b = fmaxf(v1[e], 0.f); v0[e] = a * a; v1[e] = b * b; } }
                    *(u32x4*)(O + row * ldc + col) = pack_v(v0, v1); } }
    }
};
struct EpiK {
    static constexpr bool PERM = true;
    bf16_t* K; const float *gk, *krp, *krs, *krcache;
    __device__ __forceinline__ void operator()(EPI_ARGS) const {
        const int head = u.pn * 4 + wc;
        float g0[8], g1[8], g2[8];
#pragma unroll
        for (int e = 0; e < 8; ++e) { g0[e] = gk[8 * fq + e]; g1[e] = gk[32 + 8 * fq + e]; g2[e] = gk[64 + 8 * fq + e]; }
#pragma unroll
        for (int ai = 0; ai < 2; ++ai) {
            f32x4 r0[4], r1[4];
#pragma unroll
            for (int m = 0; m < 4; ++m) { const int R = u.pm * 256 + ai * 128 + wr * 64 + m * 16 + fr;
                const float* kr;
                if (R < MP) kr = krp + (size_t)R * 32;
                else { const int q = R - MP, s = q / SKV, j = q - s * SKV; kr = j < PAST ? krcache + ((size_t)s * PAST + j) * 32 : krs + ((size_t)s * SS + (j - PAST)) * 32; }
                r0[m] = *(const f32x4*)(kr + 8 * fq); r1[m] = *(const f32x4*)(kr + 8 * fq + 4); }
            asm volatile("" ::: "memory");
#pragma unroll
            for (int m = 0; m < 4; ++m) { const int R = u.pm * 256 + ai * 128 + wr * 64 + m * 16 + fr;
                const f32x4 a0 = acc[ai][0][m][0], a1 = acc[ai][0][m][1], b0 = acc[ai][1][m][0], b1 = acc[ai][1][m][1];
                float ss = 0.f;
#pragma unroll
                for (int e = 0; e < 4; ++e) ss += a0[e] * a0[e] + a1[e] * a1[e] + b0[e] * b0[e] + b1[e] * b1[e] + r0[m][e] * r0[m][e] + r1[m][e] * r1[m][e];
                ss += __shfl_xor(ss, 16); ss += __shfl_xor(ss, 32);
                const float rs = rsqrtf(ss * (1.f / 96.f) + EPS);
                float o0[8], o1[8], o2[8];
#pragma unroll
                for (int e = 0; e < 4; ++e) { o0[e] = a0[e] * rs * g0[e]; o0[4 + e] = a1[e] * rs * g0[4 + e]; o1[e] = b0[e] * rs * g1[e]; o1[4 + e] = b1[e] * rs * g1[4 + e];
                    o2[e] = r0[m][e] * rs * g2[e]; o2[4 + e] = r1[m][e] * rs * g2[4 + e]; }
                size_t krow;
                if (R < MP) krow = ((size_t)(R >> 11) * 8 + head) * SP + (R & 2047);
                else { const int q = R - MP, s = q / SKV, j = q - s * SKV; krow = (size_t)MP * 8 + ((size_t)s * 8 + head) * SKV + j; }
                bf16_t* d = K + krow * 96 + 8 * fq;
                *(u32x4*)d = pack8(o0); *(u32x4*)(d + 32) = pack8(o1); *(u32x4*)(d + 64) = pack8(o2); }
            asm volatile("" ::: "memory");
        }
    }
};
struct EpiVT {
    static constexpr bool PERM = true;
    bf16_t* VT;
    __device__ __forceinline__ void operator()(EPI_ARGS) const {
        size_t coff[2]; int pitch[2];
#pragma unroll
        for (int bj = 0; bj < 2; ++bj) { const int R0 = u.pn * 256 + bj * 128 + wc * 32 + 8 * fq;
            if (R0 < MP) { coff[bj] = (size_t)(R0 >> 11) * 8 * 64 * SP + (R0 & 2047); pitch[bj] = SP; }
            else { const int q = R0 - MP, s = q / SKV, j = q - s * SKV; coff[bj] = VT_SAMPLE_OFF + (size_t)s * 8 * 64 * SKV + j; pitch[bj] = SKV; } }
#pragma unroll
        for (int ai = 0; ai < 2; ++ai)
#pragma unroll
            for (int m = 0; m < 4; ++m) { const int f = u.pm * 256 + ai * 128 + wr * 64 + m * 16 + fr;
#pragma unroll
                for (int bj = 0; bj < 2; ++bj) *(u32x4*)(VT + coff[bj] + (size_t)f * pitch[bj]) = pack_v(acc[ai][bj][m][0], acc[ai][bj][m][1]); }
    }
};
struct EpiGate {
    static constexpr bool PERM = true;
    bf16_t* merged; const bf16_t* gl; const bf16_t* gls;
    __device__ __forceinline__ void operator()(EPI_ARGS) const {
#pragma unroll
        for (int ai = 0; ai < 2; ++ai) {
            u32x4 gw[4][2], tw[4][2];
#pragma unroll
            for (int m = 0; m < 4; ++m) { const size_t row = (size_t)u.pm * 256 + ai * 128 + wr * 64 + m * 16 + fr;
#pragma unroll
                for (int bj = 0; bj < 2; ++bj) { const int col = u.pn * 256 + bj * 128 + wc * 32 + 8 * fq;
                    gw[m][bj] = *(const u32x4*)(gl + row * 2048 + u.sel * 1024 + col);
                    tw[m][bj] = u.sel ? *(const u32x4*)(merged + row * 1024 + col) : (u32x4){0u, 0u, 0u, 0u}; } }
            asm volatile("" ::: "memory");
#pragma unroll
            for (int m = 0; m < 4; ++m) { const size_t row = (size_t)u.pm * 256 + ai * 128 + wr * 64 + m * 16 + fr;
#pragma unroll
                for (int bj = 0; bj < 2; ++bj) { const int col = u.pn * 256 + bj * 128 + wc * 32 + 8 * fq; const f32x4 v0 = acc[ai][bj][m][0], v1 = acc[ai][bj][m][1];
                    const u32x4 g = gw[m][bj], t = tw[m][bj];
                    float o[8];
                    o[0] = sigmoidf_(bflo(g.x)) * v0[0] + bflo(t.x); o[1] = sigmoidf_(bfhi(g.x)) * v0[1] + bfhi(t.x); o[2] = sigmoidf_(bflo(g.y)) * v0[2] + bflo(t.y); o[3] = sigmoidf_(bfhi(g.y)) * v0[3] + bfhi(t.y);
                    o[4] = sigmoidf_(bflo(g.z)) * v1[0] + bflo(t.z); o[5] = sigmoidf_(bfhi(g.z)) * v1[1] + bfhi(t.z); o[6] = sigmoidf_(bflo(g.w)) * v1[2] + bflo(t.w); o[7] = sigmoidf_(bfhi(g.w)) * v1[3] + bfhi(t.w);
                    *(u32x4*)(merged + row * 1024 + col) = pack8(o); } }
            asm volatile("" ::: "memory");
        }
    }
};
struct EpiGateS {
    static constexpr bool PERM = true;
    float* macc; const bf16_t* gls;
    __device__ __forceinline__ void operator()(EPI_ARGS) const {
#pragma unroll
        for (int ai = 0; ai < 2; ++ai) {
            u32x4 gw[4][2];
#pragma unroll
            for (int m = 0; m < 4; ++m) { const size_t r = ai * 128 + wr * 64 + m * 16 + fr;
#pragma unroll
                for (int bj = 0; bj < 2; ++bj) gw[m][bj] = *(const u32x4*)(gls + r * 2048 + u.sel * 1024 + u.pn * 256 + bj * 128 + wc * 32 + 8 * fq); }
            asm volatile("" ::: "memory");
#pragma unroll
            for (int m = 0; m < 4; ++m) { const size_t r = ai * 128 + wr * 64 + m * 16 + fr;
#pragma unroll
                for (int bj = 0; bj < 2; ++bj) { const int col = u.pn * 256 + bj * 128 + wc * 32 + 8 * fq; const f32x4 v0 = acc[ai][bj][m][0], v1 = acc[ai][bj][m][1]; const u32x4 g = gw[m][bj];
                    float* d = macc + (size_t)(u.sel * 2 + (u.pk >> 8)) * (MS * 1024) + r * 1024 + col;
                    *(f32x4*)d = (f32x4){sigmoidf_(bflo(g.x)) * v0[0], sigmoidf_(bfhi(g.x)) * v0[1], sigmoidf_(bflo(g.y)) * v0[2], sigmoidf_(bfhi(g.y)) * v0[3]};
                    *(f32x4*)(d + 4) = (f32x4){sigmoidf_(bflo(g.z)) * v1[0], sigmoidf_(bfhi(g.z)) * v1[1], sigmoidf_(bflo(g.w)) * v1[2], sigmoidf_(bfhi(g.w)) * v1[3]}; } }
            asm volatile("" ::: "memory");
        }
    }
};
struct EpiAtom {
    static constexpr bool PERM = false;
    float* dst; int ld; const float* mod; int goff, klen;
    __device__ __forceinline__ void operator()(EPI_ARGS) const {
#pragma unroll
        for (int ai = 0; ai < 2; ++ai) {
            f32x4 gt[4][2][2];
#pragma unroll
            for (int m = 0; m < 4; ++m) { const int r = ai * 128 + wr * 64 + m * 16 + fr;
#pragma unroll
                for (int bj = 0; bj < 2; ++bj)
#pragma unroll
                    for (int n = 0; n < 2; ++n) gt[m][bj][n] = mod ? *(const f32x4*)(mod + (8 + (r >> 4)) * 6144 + goff + u.pn * 256 + bj * 128 + wc * 32 + 16 * n + 4 * fq) : (f32x4){1.f, 1.f, 1.f, 1.f}; }
            asm volatile("" ::: "memory");
#pragma unroll
            for (int m = 0; m < 4; ++m) { const int r = ai * 128 + wr * 64 + m * 16 + fr;
#pragma unroll
                for (int bj = 0; bj < 2; ++bj)
#pragma unroll
                    for (int n = 0; n < 2; ++n) { const int col = u.pn * 256 + bj * 128 + wc * 32 + 16 * n + 4 * fq;
                        *(f32x4*)(dst + (size_t)(u.pk / klen) * (MS * 1024) + (size_t)r * ld + col) = acc[ai][bj][m][n] * gt[m][bj][n]; } }
            asm volatile("" ::: "memory");
        }
    }
};
template <int NP, int W8  > __device__ __forceinline__ void convert_slice(const float* part, int ld, bf16_t* dst, int k0, int tid) {
#pragma unroll 1
    for (int i0 = tid; i0 < 256 * W8; i0 += 4 * 512) {
        f32x4 v0[4], v1[4];
#pragma unroll
        for (int q = 0; q < 4; ++q) { const int i = i0 + q * 512, r = i / W8, c8 = i % W8; const float* pp = part + (size_t)r * ld + k0 + 8 * c8;
            v0[q] = *(const f32x4*)pp; v1[q] = *(const f32x4*)(pp + 4);
#pragma unroll
            for (int k = 1; k < NP; ++k) { v0[q] += *(const f32x4*)(pp + (size_t)k * 256 * ld); v1[q] += *(const f32x4*)(pp + (size_t)k * 256 * ld + 4); } }
#pragma unroll
        for (int q = 0; q < 4; ++q) { const int i = i0 + q * 512, r = i / W8, c8 = i % W8; *(u32x4*)(dst + (size_t)r * ld + k0 + 8 * c8) = pack_v(v0[q], v1[q]); }
    }
    asm volatile("s_waitcnt vmcnt(0)" ::: "memory");
    __syncthreads();
}
struct EpiRes {
    static constexpr bool PERM = false;
    const float *bp, *bs; float* out; const float* mod; int goff;
    __device__ __forceinline__ void operator()(EPI_ARGS) const {
        const float* gr = mod + (u.pm >> 3) * 6144 + goff + u.pn * 256 + wc * 32 + 4 * fq;
        f32x4 gt[2][2];
#pragma unroll
        for (int bj = 0; bj < 2; ++bj)
#pragma unroll
            for (int n = 0; n < 2; ++n) gt[bj][n] = *(const f32x4*)(gr + bj * 128 + 16 * n);
#pragma unroll
        for (int ai = 0; ai < 2; ++ai) {
            f32x4 b[4][2][2];
#pragma unroll
            for (int m = 0; m < 4; ++m) { const size_t off = (size_t)(u.pm * 256 + ai * 128 + wr * 64 + m * 16 + fr) * 1024 + u.pn * 256 + wc * 32 + 4 * fq;
#pragma unroll
                for (int bj = 0; bj < 2; ++bj)
#pragma unroll
                    for (int n = 0; n < 2; ++n) b[m][bj][n] = *(const f32x4*)(bp + off + bj * 128 + 16 * n); }
            asm volatile("" ::: "memory");
#pragma unroll
            for (int m = 0; m < 4; ++m) { const size_t off = (size_t)(u.pm * 256 + ai * 128 + wr * 64 + m * 16 + fr) * 1024 + u.pn * 256 + wc * 32 + 4 * fq;
#pragma unroll
                for (int bj = 0; bj < 2; ++bj)
#pragma unroll
                    for (int n = 0; n < 2; ++n) *(f32x4*)(out + off + bj * 128 + 16 * n) = b[m][bj][n] + gt[bj][n] * acc[ai][bj][m][n]; }
            asm volatile("" ::: "memory");
        }
    }
};

struct EpiRes1 {
    static constexpr bool PERM = true;
    const float* x; bf16_t* x1b; const float* mod;
    __device__ __forceinline__ void operator()(EPI_ARGS) const {
        const float* gr = mod + (u.pm >> 3) * 6144 + 2048 + u.pn * 256 + wc * 32 + 8 * fq;
        f32x4 gt[2][2];
#pragma unroll
        for (int bj = 0; bj < 2; ++bj) { gt[bj][0] = *(const f32x4*)(gr + bj * 128); gt[bj][1] = *(const f32x4*)(gr + bj * 128 + 4); }
#pragma unroll
        for (int ai = 0; ai < 2; ++ai) {
            f32x4 b[4][2][2];
#pragma unroll
            for (int m = 0; m < 4; ++m) { const size_t off = (size_t)(u.pm * 256 + ai * 128 + wr * 64 + m * 16 + fr) * 1024 + u.pn * 256 + wc * 32 + 8 * fq;
#pragma unroll
                for (int bj = 0; bj < 2; ++bj) { b[m][bj][0] = *(const f32x4*)(x + off + bj * 128); b[m][bj][1] = *(const f32x4*)(x + off + bj * 128 + 4); } }
            asm volatile("" ::: "memory");
#pragma unroll
            for (int m = 0; m < 4; ++m) { const size_t off = (size_t)(u.pm * 256 + ai * 128 + wr * 64 + m * 16 + fr) * 1024 + u.pn * 256 + wc * 32 + 8 * fq;
#pragma unroll
                for (int bj = 0; bj < 2; ++bj) *(u32x4*)(x1b + off + bj * 128) = pack_v(b[m][bj][0] + gt[bj][0] * acc[ai][bj][m][0], b[m][bj][1] + gt[bj][1] * acc[ai][bj][m][1]); }
            asm volatile("" ::: "memory");
        }
    }
};
struct EpiRes2 {
    static constexpr bool PERM = true;
    const bf16_t* x1b; float* out; const float* mod;
    __device__ __forceinline__ void operator()(EPI_ARGS) const {
        const float* gr = mod + (u.pm >> 3) * 6144 + 5120 + u.pn * 256 + wc * 32 + 8 * fq;
        f32x4 gt[2][2];
#pragma unroll
        for (int bj = 0; bj < 2; ++bj) { gt[bj][0] = *(const f32x4*)(gr + bj * 128); gt[bj][1] = *(const f32x4*)(gr + bj * 128 + 4); }
#pragma unroll
        for (int ai = 0; ai < 2; ++ai) {
            u32x4 b[4][2];
#pragma unroll
            for (int m = 0; m < 4; ++m) { const size_t off = (size_t)(u.pm * 256 + ai * 128 + wr * 64 + m * 16 + fr) * 1024 + u.pn * 256 + wc * 32 + 8 * fq;
#pragma unroll
                for (int bj = 0; bj < 2; ++bj) b[m][bj] = *(const u32x4*)(x1b + off + bj * 128); }
#pragma unroll
            for (int m = 0; m < 4; ++m) { const size_t off = (size_t)(u.pm * 256 + ai * 128 + wr * 64 + m * 16 + fr) * 1024 + u.pn * 256 + wc * 32 + 8 * fq;
#pragma unroll
                for (int bj = 0; bj < 2; ++bj) { const u32x4 w = b[m][bj];
                    *(f32x4*)(out + off + bj * 128) = (f32x4){bflo(w.x), bfhi(w.x), bflo(w.y), bfhi(w.y)} + gt[bj][0] * acc[ai][bj][m][0];
                    *(f32x4*)(out + off + bj * 128 + 4) = (f32x4){bflo(w.z), bfhi(w.z), bflo(w.w), bfhi(w.w)} + gt[bj][1] * acc[ai][bj][m][1]; } }
        }
    }
};

struct Args { const float* in[28]; float* out; unsigned char* ws; int ph_lo, ph_hi; };
enum { I_XP = 0, I_XS, I_CP, I_CS, I_CKV, I_CKR, I_ST, I_CONV, I_ADAW, I_ADAB, I_N1G, I_WIN, I_CONVW, I_ALOG, I_DTB, I_GNG, I_WGO, I_QNG, I_WUQ, I_KVNG, I_WUKV,
       I_QHG, I_KHG, I_WMO, I_WO, I_N2G, I_WF1, I_WF2 };

__device__ __forceinline__ int colmap(int which, int n) {
    switch (which) {
    case 0:
        if (n < 2048) return n; if (n < 4096) return 2736 + (n - 2048); if (n < 4352) return 2448 + (n - 4096); if (n < 4736) return 2064 + (n - 4352);
        if (n < 4768) return 2704 + (n - 4736); if (n < 4776) return 2048 + (n - 4768); if (n < 4784) return 2056 + (n - 4776); return -1;
    case 2: { const int pn = n >> 8, bj = (n >> 7) & 1, wc = (n >> 5) & 3, j = n & 31; return (4 * pn + wc) * 128 + bj * 32 + j; }
    case 3: return (n >> 6) * 128 + 64 + (n & 63);
    default: return n;
    }
}
__device__ __forceinline__ void transpose_item(const float* W, int K, int N, bf16_t* WT, LAS float* scr, int nblk, int which, int item, int lane) {
    const int kb = item / nblk, nb = item - kb * nblk, k0 = 64 * kb, n0 = 64 * nb;
    const int cq = lane & 15, rq = lane >> 4;
    const int sc = colmap(which, n0 + 4 * cq);
    f32x4 v[16];
#pragma unroll
    for (int i = 0; i < 16; ++i) v[i] = sc >= 0 ? *(const f32x4*)(W + (size_t)(k0 + rq + 4 * i) * N + sc) : (f32x4){0.f, 0.f, 0.f, 0.f};
#pragma unroll
    for (int i = 0; i < 16; ++i) { LAS float* d = scr + (rq + 4 * i) * 65 + 4 * cq; d[0] = v[i][0]; d[1] = v[i][1]; d[2] = v[i][2]; d[3] = v[i][3]; }
    asm volatile("s_waitcnt lgkmcnt(0)" ::: "memory");
#pragma unroll
    for (int j = 0; j < 8; ++j) { const int q = lane + 64 * j, n = q >> 3, ch = q & 7; const LAS float* sp = scr + (8 * ch) * 65 + n;
        u32x4 o; o.x = cvt_pk_bf16(sp[0 * 65], sp[1 * 65]); o.y = cvt_pk_bf16(sp[2 * 65], sp[3 * 65]); o.z = cvt_pk_bf16(sp[4 * 65], sp[5 * 65]); o.w = cvt_pk_bf16(sp[6 * 65], sp[7 * 65]);
        *(u32x4*)(WT + (size_t)(n0 + n) * K + k0 + 8 * ch) = o; }
    asm volatile("s_waitcnt lgkmcnt(0)" ::: "memory");
}
__device__ __forceinline__ void phase0(const Args& a, LAS unsigned char* lds, int tid, int lane, int wave, unsigned long long& tmid) {
    unsigned char* ws = a.ws;
    for (int idx = blockIdx.x * 512 + tid; idx < SKV * 16; idx += gridDim.x * 512) {
        const int pos = idx >> 4, i = idx & 15;
        const float inv = exp2f(-(float)i * (13.287712379549449f / 16.f));
        const float ang = (float)pos * inv;
        double t = (double)ang * 0.15915494309189535; t -= floor(t);
        const float rev = (float)t;
        ((f32x2*)(ws + WS_ROPE))[idx] = (f32x2){__builtin_amdgcn_cosf(rev), __builtin_amdgcn_sinf(rev)};
    }
    {
        LAS float* sc = (LAS float*)lds;
        LAS float* red = (LAS float*)(lds + 98304);
        { f32x4 cv[12];
#pragma unroll
            for (int q = 0; q < 12; ++q) { const int f = 4 * (tid + 512 * q), r = f >> 10, k = f & 1023; cv[q] = *(const f32x4*)(r < 8 ? a.in[I_CP] + r * 1024 + k : a.in[I_CS] + (r - 8) * 1024 + k); }
#pragma unroll
            for (int q = 0; q < 12; ++q) { const int f = 4 * (tid + 512 * q); *(LAS f32x4*)(sc + f) = (f32x4){siluf_(cv[q][0]), siluf_(cv[q][1]), siluf_(cv[q][2]), siluf_(cv[q][3])}; } }
        __syncthreads();
        for (int cb = blockIdx.x; cb < 256; cb += gridDim.x) {
            const int cl = lane % 24, kh = lane / 24, col = cb * 24 + cl;
            float acc[24];
#pragma unroll
            for (int r = 0; r < 24; ++r) acc[r] = 0.f;
            if (lane < 48) {
                const int kbase = wave * 128 + kh * 64; const float* wp = a.in[I_ADAW] + (size_t)kbase * 6144 + col;
#pragma unroll 1
                for (int kb = 0; kb < 4; ++kb) {
                    float w[16];
#pragma unroll
                    for (int i = 0; i < 16; ++i) w[i] = wp[(size_t)(16 * kb + i) * 6144];
#pragma unroll
                    for (int i4 = 0; i4 < 4; ++i4)
#pragma unroll
                        for (int r = 0; r < 24; ++r) { const f32x4 sv = *(const LAS f32x4*)(sc + r * 1024 + kbase + 16 * kb + 4 * i4);
                            acc[r] += sv[0] * w[4 * i4] + sv[1] * w[4 * i4 + 1] + sv[2] * w[4 * i4 + 2] + sv[3] * w[4 * i4 + 3]; }
                }
            }
#pragma unroll
            for (int r = 0; r < 24; ++r) { float v = acc[r]; const float o = __shfl(v, (lane + 24) & 63); if (lane < 24) red[(wave * 24 + r) * 24 + lane] = v + o; }
            __syncthreads();
            for (int i = tid; i < 24 * 24; i += 512) { const int r = i / 24, cc = i - r * 24; float sum = a.in[I_ADAB][cb * 24 + cc];
#pragma unroll
                for (int w = 0; w < 8; ++w) sum += red[(w * 24 + r) * 24 + cc];
                ((float*)(ws + WS_MOD))[r * 6144 + cb * 24 + cc] = sum; }
            __syncthreads();
        }
    }
    if (PROBE_LP == 3) tmid = __builtin_amdgcn_s_memrealtime();
    LAS float* scr = (LAS float*)(lds + wave * 16640);
    constexpr int N0 = 16 * 76, N1 = 6 * 12, N2 = 4 * 8, N3 = 4 * 8;
    constexpr int NT = N0 + N1 + N2 + N3;
    const int NW = (int)gridDim.x * 8, vw = (int)blockIdx.x * 8 + wave;
#pragma unroll 1
    for (int it0 = vw; it0 < NT * REPK(0); it0 += NW) {
        int it = it0 % NT;
        if (it < N0) { transpose_item(a.in[I_WIN], 1024, NIN, (bf16_t*)(ws + WS_WIN), scr, 76, 0, it, lane); continue; } it -= N0;
        if (it < N1) { transpose_item(a.in[I_WUQ], 384, 768, (bf16_t*)(ws + WS_WUQ), scr, 12, 1, it, lane); continue; } it -= N1;
        if (it < N2) { transpose_item(a.in[I_WUKV], 256, 1024, (bf16_t*)(ws + WS_WUK), scr, 8, 2, it, lane); continue; } it -= N2;
        transpose_item(a.in[I_WUKV], 256, 1024, (bf16_t*)(ws + WS_WUV), scr, 8, 3, it, lane);
    }
}
__device__ __forceinline__ void ffn_weight_transposes(const Args& a, LAS unsigned char* lds, int vw, int NW, int lane, int wave) {
    LAS float* scr = (LAS float*)(lds + wave * 16640);
    constexpr int N4 = 8 * 16, N5 = 8 * 16, N6 = 16 * 16, N7 = 16 * 64, N8 = 64 * 16;
#pragma unroll 1
    for (int it0 = vw; it0 < N4 + N5 + N6 + N7 + N8; it0 += NW) { int it = it0;
        if (it < N4) { transpose_item(a.in[I_WGO], 512, 1024, (bf16_t*)(a.ws + WS_WGO), scr, 16, 1, it, lane); continue; } it -= N4;
        if (it < N5) { transpose_item(a.in[I_WMO], 512, 1024, (bf16_t*)(a.ws + WS_WMO), scr, 16, 1, it, lane); continue; } it -= N5;
        if (it < N6) { transpose_item(a.in[I_WO], 1024, 1024, (bf16_t*)(a.ws + WS_WO), scr, 16, 1, it, lane); continue; } it -= N6;
        if (it < N7) { transpose_item(a.in[I_WF1], 1024, 4096, (bf16_t*)(a.ws + WS_WF1), scr, 64, 1, it, lane); continue; } it -= N7;
        transpose_item(a.in[I_WF2], 4096, 1024, (bf16_t*)(a.ws + WS_WF2), scr, 16, 1, it, lane);
    }
}

__device__ __forceinline__ void norm_load(int r, const float* xp, const float* xs, const float* part, float* ys, int lane, f32x4 (&v)[4]) {
    const float* xr = r < MP ? xp + (size_t)r * 1024 : xs + (size_t)(r - MP) * 1024;
#pragma unroll
    for (int j = 0; j < 4; ++j) {
        if (part && r < MP) { const u32x2 w = *(const u32x2*)((const bf16_t*)xp + (size_t)r * 1024 + 4 * (lane + 64 * j)); v[j] = (f32x4){bflo(w.x), bfhi(w.x), bflo(w.y), bfhi(w.y)}; }
        else v[j] = *(const f32x4*)(xr + 4 * (lane + 64 * j));
        if (part && r >= MP) {
#pragma unroll
            for (int k = 0; k < 8; ++k) v[j] += *(const f32x4*)(part + (size_t)k * (MS * 1024) + (size_t)(r - MP) * 1024 + 4 * (lane + 64 * j));
            *(f32x4*)(ys + (size_t)(r - MP) * 1024 + 4 * (lane + 64 * j)) = v[j]; } }
}
struct NormAux { f32x4 gg[4], sc[4], sh[4]; };
__device__ __forceinline__ void norm_aux(int r, const float* g, const float* mod, int shift_off, int scale_off, int lane, NormAux& x) {
    const float* mr = mod + mod_row(r) * 6144;
#pragma unroll
    for (int j = 0; j < 4; ++j) { const int col = 4 * (lane + 64 * j); x.gg[j] = *(const f32x4*)(g + col); x.sc[j] = *(const f32x4*)(mr + scale_off + col); x.sh[j] = *(const f32x4*)(mr + shift_off + col); }
}
__device__ __forceinline__ void norm_finish(int r, const f32x4 (&v)[4], const NormAux& x, bf16_t* out, int lane) {
    float ss = 0.f;
#pragma unroll
    for (int j = 0; j < 4; ++j) ss += v[j][0] * v[j][0] + v[j][1] * v[j][1] + v[j][2] * v[j][2] + v[j][3] * v[j][3];
    const float rs = rsqrtf(wave_sum(ss) * (1.f / 1024.f) + EPS);
#pragma unroll
    for (int j = 0; j < 4; ++j) { const int col = 4 * (lane + 64 * j);
        const f32x4 y = v[j] * rs * x.gg[j] * (x.sc[j] + 1.f) + x.sh[j];
        u32x2 w; w.x = cvt_pk_bf16(y[0], y[1]); w.y = cvt_pk_bf16(y[2], y[3]);
        *(u32x2*)(out + (size_t)r * 1024 + col) = w; }
}
__device__ __forceinline__ void norm_rows(const float* xp, const float* xs, const float* g, const float* mod, int shift_off, int scale_off, bf16_t* out, int gw, int lane, const float* part, float* ys) {
    for (int r = gw; r < MR; r += 4096) {
        const int r2 = r + 2048; const bool two = r2 < MR;
        f32x4 va[4], vb[4]; NormAux xa, xb;
        norm_load(r, xp, xs, part, ys, lane, va);
        if (two) norm_load(r2, xp, xs, part, ys, lane, vb);
        norm_aux(r, g, mod, shift_off, scale_off, lane, xa);
        if (two) norm_aux(r2, g, mod, shift_off, scale_off, lane, xb);
        norm_finish(r, va, xa, out, lane);
        if (two) norm_finish(r2, vb, xb, out, lane);
    }
}

__device__ __forceinline__ void unpack8(const u32x4 w, float* v) { v[0] = bflo(w.x); v[1] = bfhi(w.x); v[2] = bflo(w.y); v[3] = bfhi(w.y); v[4] = bflo(w.z); v[5] = bfhi(w.z); v[6] = bflo(w.w); v[7] = bfhi(w.w); }
__device__ __forceinline__ void mla_rows(const Args& a, int gw, int ngw, int lane) {
    unsigned char* ws = a.ws; float* out = a.out;
    bf16_t* cq = (bf16_t*)(ws + WS_CQ); const bf16_t* ckvraw = (const bf16_t*)(ws + WS_CKVRAW); const float* krraw = (const float*)(ws + WS_KRRAW);
    bf16_t* ckvrows = (bf16_t*)(ws + WS_CKVROWS); const f32x2* rope = (const f32x2*)(ws + WS_ROPE);
    float gq[8], gk[8];
#pragma unroll
    for (int e = 0; e < 8; ++e) { gq[e] = lane < 48 ? a.in[I_QNG][8 * lane + e] : 0.f; gk[e] = lane < 32 ? a.in[I_KVNG][8 * lane + e] : 0.f; }
    for (int r0 = gw * 4; r0 < MR; r0 += ngw * 4) {
        u32x4 wq[4], wk[4]; float x1[4], x2[4]; f32x2 cs[4];
#pragma unroll
        for (int j = 0; j < 4; ++j) { const int r = r0 + j; const int pos = r < MP ? (r & 2047) : PAST + ((r - MP) & 15);
            wq[j] = lane < 48 ? *(const u32x4*)(cq + (size_t)r * 384 + 8 * lane) : (u32x4){0u, 0u, 0u, 0u};
            wk[j] = lane < 32 ? *(const u32x4*)(ckvraw + (size_t)r * 256 + 8 * lane) : (u32x4){0u, 0u, 0u, 0u};
            x1[j] = krraw[(size_t)r * 32 + (lane & 15)]; x2[j] = krraw[(size_t)r * 32 + 16 + (lane & 15)]; cs[j] = rope[pos * 16 + (lane & 15)]; }
#pragma unroll
        for (int j = 0; j < 4; ++j) { const int r = r0 + j;
            float vq[8], vk[8]; unpack8(wq[j], vq); unpack8(wk[j], vk);
            float sq = 0.f, sk = 0.f;
#pragma unroll
            for (int e = 0; e < 8; ++e) { sq += vq[e] * vq[e]; sk += vk[e] * vk[e]; }
            const float rq = rsqrtf(wave_sum(sq) * (1.f / 384.f) + EPS), rk = rsqrtf(wave_sum(sk) * (1.f / 256.f) + EPS);
            if (lane < 48) {
#pragma unroll
                for (int e = 0; e < 8; ++e) vq[e] = vq[e] * rq * gq[e];
                *(u32x4*)(cq + (size_t)r * 384 + 8 * lane) = pack8(vq); }
            if (lane < 32) {
#pragma unroll
                for (int e = 0; e < 8; ++e) vk[e] = vk[e] * rk * gk[e];
                float* o = r < MP ? out + O_CKVP + (size_t)r * 256 : out + O_CKVS + (size_t)(r - MP) * 256;
                *(f32x4*)(o + 8 * lane) = (f32x4){vk[0], vk[1], vk[2], vk[3]}; *(f32x4*)(o + 8 * lane + 4) = (f32x4){vk[4], vk[5], vk[6], vk[7]};
                const size_t R = r < MP ? (size_t)r : (size_t)MP + (size_t)((r - MP) >> 4) * SKV + PAST + ((r - MP) & 15);
                *(u32x4*)(ckvrows + R * 256 + 8 * lane) = pack8(vk); }
            if (lane < 16) { float* o = r < MP ? out + O_KRP + (size_t)r * 32 : out + O_KRS + (size_t)(r - MP) * 32;
                o[lane] = x1[j] * cs[j].x - x2[j] * cs[j].y; o[16 + lane] = x2[j] * cs[j].x + x1[j] * cs[j].y; }
        }
    }
}

template <int I> struct SolveRow {
    static __device__ __forceinline__ void run(float (&x)[64], const LAS float* A, const LAS bf16_t* src, const LAS float* scp) {
        float s0 = scp[I] * bf2f(src[I * 72]), s1 = 0.f, s2 = 0.f, s3 = 0.f;
#pragma unroll
        for (int j4 = 0; j4 < (I + 3) / 4; ++j4) { const f32x4 av = *(const LAS f32x4*)(A + I * 64 + 4 * j4);
            if (4 * j4 + 0 < I) s0 -= av[0] * x[4 * j4 + 0]; if (4 * j4 + 1 < I) s1 -= av[1] * x[4 * j4 + 1]; if (4 * j4 + 2 < I) s2 -= av[2] * x[4 * j4 + 2]; if (4 * j4 + 3 < I) s3 -= av[3] * x[4 * j4 + 3]; }
        const float s = (s0 + s1) + (s2 + s3);
        x[I] = s;
        SolveRow<I + 1>::run(x, A, src, scp);
    }
};
template <> struct SolveRow<64> { static __device__ __forceinline__ void run(float (&)[64], const LAS float*, const LAS bf16_t*, const LAS float*) {} };

__device__ __forceinline__ void gdn_prep(const Args& a, LAS unsigned char* lds, int tid) {
    const int slot = tid >> 7, w2 = __builtin_amdgcn_readfirstlane((tid >> 6) & 1), lane = tid & 63;
    LAS unsigned char* sl = lds + slot * 35584;
    LAS bf16_t* q_lds = (LAS bf16_t*)sl; LAS float* A_lds = (LAS float*)sl;
    LAS bf16_t* k_lds = (LAS bf16_t*)(sl + 16384); LAS bf16_t* v_lds = (LAS bf16_t*)(sl + 25600);
    LAS float* gcs = (LAS float*)(sl + 34816); LAS float* bts = (LAS float*)(sl + 35072); LAS float* scw = (LAS float*)(sl + 35328);
    const bf16_t* gqkv = (const bf16_t*)(a.ws + WS_GQKV); const float* ab = (const float*)(a.ws + WS_AB); const float* cw = a.in[I_CONVW];
#pragma unroll 1
    for (int qi = blockIdx.x; qi < 512 * REPK(3); qi += gridDim.x) {
        const int item = (qi & 511) * 4 + slot, bh = item >> 5, n = item & 31, b = bh >> 3, h = bh & 7;
        const int r0 = b * SP + 64 * n, t = lane;
        unsigned char* rec = a.ws + WS_PREP + (size_t)item * REC_BYTES;
        LAS float* cwl = (LAS float*)(sl + 9216);
        for (int i = tid & 127; i < 768; i += 128) { const int tap = i / 192, cc = i - tap * 192; cwl[i] = cw[tap * 1536 + (cc >> 6) * 512 + h * 64 + (cc & 63)]; }
        __syncthreads();
        {
            const int cb0 = w2 * 512 + h * 64;
            float o[64];
#pragma unroll
            for (int c = 0; c < 64; ++c) o[c] = 0.f;
#pragma unroll 1
            for (int tap = 0; tap < 4; ++tap) { const int rr = t - 3 + tap; const bool valid = (n > 0) || (rr >= 0);
                const bf16_t* src = gqkv + (size_t)(r0 + (valid ? rr : 0)) * 1536 + cb0;
                u32x4 w[8];
#pragma unroll
                for (int c8 = 0; c8 < 8; ++c8) w[c8] = *(const u32x4*)(src + 8 * c8);
#pragma unroll
                for (int c8 = 0; c8 < 8; ++c8) { if (!valid) w[c8] = (u32x4){0u, 0u, 0u, 0u};
                    const LAS float* wl = cwl + tap * 192 + w2 * 64 + 8 * c8;
                    const f32x4 wa = *(const LAS f32x4*)wl, wb = *(const LAS f32x4*)(wl + 4);
                    o[8 * c8 + 0] += wa[0] * bflo(w[c8].x); o[8 * c8 + 1] += wa[1] * bfhi(w[c8].x); o[8 * c8 + 2] += wa[2] * bflo(w[c8].y); o[8 * c8 + 3] += wa[3] * bfhi(w[c8].y);
                    o[8 * c8 + 4] += wb[0] * bflo(w[c8].z); o[8 * c8 + 5] += wb[1] * bfhi(w[c8].z); o[8 * c8 + 6] += wb[2] * bflo(w[c8].w); o[8 * c8 + 7] += wb[3] * bfhi(w[c8].w); } }
            float ss = 0.f;
#pragma unroll
            for (int c = 0; c < 64; ++c) { o[c] = siluf_(o[c]); ss += o[c] * o[c]; }
            const float sc = rsqrtf(ss + EPS) * (w2 ? 1.f : 0.125f);
            LAS bf16_t* dst = (w2 ? k_lds : q_lds) + t * 72;
#pragma unroll
            for (int c8 = 0; c8 < 8; ++c8) { float v[8];
#pragma unroll
                for (int e = 0; e < 8; ++e) v[e] = o[8 * c8 + e] * sc;
                *(LAS u32x4*)(dst + 8 * c8) = pack8(v); }
        }
        {
            const int cb1 = 1024 + h * 64 + 32 * w2;
            u32x4 w[4][4];
#pragma unroll
            for (int tap = 0; tap < 4; ++tap) { const int rr = t - 3 + tap; const bool valid = (n > 0) || (rr >= 0);
                const bf16_t* src = gqkv + (size_t)(r0 + (valid ? rr : 0)) * 1536 + cb1;
#pragma unroll
                for (int c8 = 0; c8 < 4; ++c8) { w[tap][c8] = *(const u32x4*)(src + 8 * c8); if (!valid) w[tap][c8] = (u32x4){0u, 0u, 0u, 0u}; } }
#pragma unroll
            for (int c8 = 0; c8 < 4; ++c8) { float o[8];
#pragma unroll
                for (int e = 0; e < 8; ++e) o[e] = 0.f;
#pragma unroll
                for (int tap = 0; tap < 4; ++tap) { const LAS float* wl = cwl + tap * 192 + 128 + 32 * w2 + 8 * c8;
                    const f32x4 wa = *(const LAS f32x4*)wl, wb = *(const LAS f32x4*)(wl + 4); const u32x4 x = w[tap][c8];
                    o[0] += wa[0] * bflo(x.x); o[1] += wa[1] * bfhi(x.x); o[2] += wa[2] * bflo(x.y); o[3] += wa[3] * bfhi(x.y);
                    o[4] += wb[0] * bflo(x.z); o[5] += wb[1] * bfhi(x.z); o[6] += wb[2] * bflo(x.w); o[7] += wb[3] * bfhi(x.w); }
#pragma unroll
                for (int e = 0; e < 8; ++e) o[e] = siluf_(o[e]);
                *(LAS u32x4*)(v_lds + t * 72 + 32 * w2 + 8 * c8) = pack8(o); }
        }
        float gc, gcl;
        {
            const float av = ab[(size_t)(r0 + t) * 16 + h], bv = ab[(size_t)(r0 + t) * 16 + 8 + h];
            const float xg = av + a.in[I_DTB][h];
            const float sp = fmaxf(xg, 0.f) + __logf(1.f + __expf(-fabsf(xg)));
            gc = -__expf(a.in[I_ALOG][h]) * sp;
#pragma unroll
            for (int o = 1; o < 64; o <<= 1) { const float u = __shfl_up(gc, o); if (lane >= o) gc += u; }
            gcl = __shfl(gc, 63);
            if (w2 == 0) { const float be = sigmoidf_(bv); gcs[t] = gc; bts[t] = be; scw[t] = be * __expf(gc); if (lane == 0) *(float*)(rec + 40960) = __expf(gcl); }
        }
        __syncthreads();
#pragma unroll
        for (int it = 0; it < 8; ++it) { const int ri = (lane >> 3) + 8 * it, pg = lane & 7, d0 = 32 * (pg >> 2) + 4 * (pg & 3);
            float v[8];
            if (w2 == 0) { const u32x2 w0 = *(const LAS u32x2*)(q_lds + ri * 72 + d0), w1 = *(const LAS u32x2*)(q_lds + ri * 72 + d0 + 16); const float e = __expf(gcs[ri]);
                v[0] = bflo(w0.x) * e; v[1] = bfhi(w0.x) * e; v[2] = bflo(w0.y) * e; v[3] = bfhi(w0.y) * e; v[4] = bflo(w1.x) * e; v[5] = bfhi(w1.x) * e; v[6] = bflo(w1.y) * e; v[7] = bfhi(w1.y) * e;
                *(u32x4*)(rec + 8192 + (ri * 64 + 8 * pg) * 2) = pack8(v); }
            else {
#pragma unroll
                for (int j = 0; j < 8; ++j) { const int c = d0 + 16 * (j >> 2) + (j & 3); v[j] = bf2f(k_lds[c * 72 + ri]) * __expf(gcl - gcs[c]); }
                *(u32x4*)(rec + 24576 + (ri * 64 + 8 * pg) * 2) = pack8(v); } }
        const int m_ = lane & 15, g4 = lane >> 4;
        f32x4 acc[4][4];
        {
            bf16x8 ka[4][2], bb[4][2];
            const LAS bf16_t* bsrc = w2 ? k_lds : q_lds;
#pragma unroll
            for (int jt = 0; jt < 4; ++jt)
#pragma unroll
                for (int ks = 0; ks < 2; ++ks) { ka[jt][ks] = *(const LAS bf16x8*)(k_lds + (16 * jt + m_) * 72 + 32 * ks + 8 * g4); bb[jt][ks] = *(const LAS bf16x8*)(bsrc + (16 * jt + m_) * 72 + 32 * ks + 8 * g4); }
#pragma unroll
            for (int jt = 0; jt < 4; ++jt)
#pragma unroll
                for (int it = 0; it < 4; ++it) { f32x4 c = (f32x4){0.f, 0.f, 0.f, 0.f};
                    if (it >= jt) {
#pragma unroll
                        for (int ks = 0; ks < 2; ++ks) c = __builtin_amdgcn_mfma_f32_16x16x32_bf16(ka[jt][ks], bb[it][ks], c, 0, 0, 0); }
                    acc[jt][it] = c; }
        }
        __syncthreads();
#pragma unroll
        for (int jt = 0; jt < 4; ++jt)
#pragma unroll
            for (int it = 0; it < 4; ++it) { const int i = 16 * it + m_, j0 = 16 * jt + 4 * g4; const float gi = gcs[i]; const f32x4 gj = *(const LAS f32x4*)(gcs + j0);
                float v[4];
                if (w2 == 0) {
#pragma unroll
                    for (int e = 0; e < 4; ++e) { const bool keep = it > jt ? true : (it < jt ? false : m_ >= 4 * g4 + e); v[e] = keep ? acc[jt][it][e] * __expf(keep ? gi - gj[e] : 0.f) : 0.f; }
                    u32x2 w; w.x = cvt_pk_bf16(v[0], v[1]); w.y = cvt_pk_bf16(v[2], v[3]);
                    *(u32x2*)(rec + 16384 + (i * 64 + 32 * (jt >> 1) + 8 * g4 + 4 * (jt & 1)) * 2) = w; }
                else { const float bi = bts[i];
#pragma unroll
                    for (int e = 0; e < 4; ++e) { const bool keep = it > jt ? true : (it < jt ? false : m_ > 4 * g4 + e); v[e] = keep ? bi * acc[jt][it][e] * __expf(keep ? gi - gj[e] : 0.f) : 0.f; }
                    *(LAS f32x4*)(A_lds + i * 64 + j0) = (f32x4){v[0], v[1], v[2], v[3]}; } }
        __syncthreads();
        {
            const LAS bf16_t* src = w2 ? k_lds : v_lds; const LAS float* scp = w2 ? scw : bts;
            float x[64];
            SolveRow<0>::run(x, A_lds, src + lane, scp);
            if (w2 == 0) {
#pragma unroll
                for (int q = 0; q < 8; ++q) *(u32x4*)(rec + 32768 + (lane * 64 + 8 * q) * 2) = pack8(&x[8 * q]);
            } else { const int pinv = (lane & 32) | (((lane >> 2) & 3) << 3) | (((lane >> 4) & 1) << 2) | (lane & 3);
#pragma unroll
                for (int i = 0; i < 64; ++i) *(bf16_t*)(rec + (i * 64 + pinv) * 2) = f2bf(-x[i]); }
        }
        __syncthreads();
    }
}

__device__ __forceinline__ void misc_p3(const Args& a, int gt, int GT) {
    bf16_t* ckvrows = (bf16_t*)(a.ws + WS_CKVROWS); const float* cache = a.in[I_CKV];
    for (int i0 = gt; i0 < BS * PAST * 32; i0 += 4 * GT) {
        f32x4 v0[4], v1[4];
#pragma unroll
        for (int q = 0; q < 4; ++q) { const int i = i0 + q * GT; if (i < BS * PAST * 32) { const int row = i >> 5, c8 = i & 31;
            v0[q] = *(const f32x4*)(cache + (size_t)row * 256 + 8 * c8); v1[q] = *(const f32x4*)(cache + (size_t)row * 256 + 8 * c8 + 4); } }
#pragma unroll
        for (int q = 0; q < 4; ++q) { const int i = i0 + q * GT; if (i < BS * PAST * 32) { const int row = i >> 5, c8 = i & 31, s = row >> 11, j = row & 2047;
            *(u32x4*)(ckvrows + ((size_t)MP + (size_t)s * SKV + j) * 256 + 8 * c8) = pack_v(v0[q], v1[q]); } }
    }
    const bf16_t* gqkv = (const bf16_t*)(a.ws + WS_GQKV);
    for (int i = gt; i < BP * 3 * 1536; i += GT) { const int b = i / 4608, rem = i - b * 4608, r = rem / 1536, c = rem - r * 1536;
        a.out[O_CVP + i] = bf2f(gqkv[(size_t)(b * SP + SP - 3 + r) * 1536 + c]); }
    for (int i = gt; i < BS * 3 * 1536; i += GT) { const int s = i / 4608, rem = i - s * 4608, r = rem / 1536, c = rem - r * 1536;
        a.out[O_CVS + i] = bf2f(gqkv[(size_t)(MP + s * SS + SS - 3 + r) * 1536 + c]); }
}

__device__ __forceinline__ bf16x8 pack_frag(const f32x4 lo, const f32x4 hi) { u32x4 w = pack_v(lo, hi); return __builtin_bit_cast(bf16x8, w); }

__device__ __forceinline__ void scan_prompt(const Args& a, LAS unsigned char* lds, int bh, int tid, int lane, int wave, bool st) {
    const int b = bh >> 3, h = bh & 7;
    const unsigned char* recs = a.ws + WS_PREP + (size_t)bh * 32 * REC_BYTES;
    bf16_t* zo = (bf16_t*)(a.ws + WS_Z) + (size_t)b * SP * 512 + h * 64;
    constexpr int BUF = 46080, OT = 2 * BUF, OTB = 64 * 272, GLO = OT + 2 * OTB;
    LAS float* gls = (LAS float*)(lds + GLO);
    const int n_ = lane & 15, g4 = lane >> 4, dv = 16 * wave + n_;
    const int lt = tid - 256, prow = (lt & 255) >> 3, pc16 = lt & 7;
    f32x4 S[4];
#pragma unroll
    for (int kt = 0; kt < 4; ++kt) S[kt] = (f32x4){0.f, 0.f, 0.f, 0.f};
    u32x4 p[10], pz[2]; float pg = 0.f, gn8[8];
    if (wave >= 4) {
#pragma unroll
        for (int e = 0; e < 8; ++e) gn8[e] = a.in[I_GNG][8 * pc16 + e];
#pragma unroll
        for (int i = 0; i < 10; ++i) p[i] = *(const u32x4*)(recs + (i >> 1) * 8192 + ((i & 1) * 256 + lt) * 16);
        pg = *(const float*)(recs + 40960);
#pragma unroll
        for (int i = 0; i < 10; ++i) *(LAS u32x4*)(lds + (i >> 1) * 9216 + (prow + 32 * (i & 1)) * 144 + pc16 * 16) = p[i];
        if (lt == 0) gls[0] = pg;
#pragma unroll
        for (int i = 0; i < 10; ++i) p[i] = *(const u32x4*)(recs + (size_t)REC_BYTES + (i >> 1) * 8192 + ((i & 1) * 256 + lt) * 16);
        pg = *(const float*)(recs + (size_t)REC_BYTES + 40960);
#pragma unroll
        for (int i = 0; i < 2; ++i) pz[i] = *(const u32x4*)(zo + (size_t)(prow + 32 * i) * 512 + pc16 * 8);
    }
    lds_barrier();
    for (int n = 0; n <= 32; ++n) {
        LAS unsigned char* cur = lds + (n & 1) * BUF;
        if (wave >= 4) {
            if (n + 1 < 32) {
                LAS unsigned char* nxt = lds + ((n + 1) & 1) * BUF;
#pragma unroll
                for (int i = 0; i < 10; ++i) *(LAS u32x4*)(nxt + (i >> 1) * 9216 + (prow + 32 * (i & 1)) * 144 + pc16 * 16) = p[i];
                if (lt == 0) gls[(n + 1) & 1] = pg;
            }
            u32x4 zc[2] = {pz[0], pz[1]};
            if (n + 2 < 32) { const unsigned char* rp = recs + (size_t)(n + 2) * REC_BYTES;
#pragma unroll
                for (int i = 0; i < 10; ++i) p[i] = *(const u32x4*)(rp + (i >> 1) * 8192 + ((i & 1) * 256 + lt) * 16);
                pg = *(const float*)(rp + 40960); }
            if (n < 32) {
#pragma unroll
                for (int i = 0; i < 2; ++i) pz[i] = *(const u32x4*)(zo + (size_t)(64 * n + prow + 32 * i) * 512 + pc16 * 8); }
            if (n >= 1) {
#pragma unroll
                for (int i = 0; i < 2; ++i) { const int r = prow + 32 * i; const LAS float* op = (const LAS float*)(lds + OT + ((n - 1) & 1) * OTB + r * 272) + 8 * pc16;
                    const f32x4 o0 = *(const LAS f32x4*)op, o1 = *(const LAS f32x4*)(op + 4);
                    float ss = o0[0] * o0[0] + o0[1] * o0[1] + o0[2] * o0[2] + o0[3] * o0[3] + o1[0] * o1[0] + o1[1] * o1[1] + o1[2] * o1[2] + o1[3] * o1[3];
                    ss = DPP_ADD(ss, 0xB1); ss = DPP_ADD(ss, 0x4E); ss = DPP_ADD(ss, 0x141);
                    const float rs = rsqrtf(ss * (1.f / 64.f) + EPS);
                    float zf[8], v[8]; unpack8(zc[i], zf);
#pragma unroll
                    for (int e = 0; e < 4; ++e) { v[e] = o0[e] * rs * gn8[e] * siluf_(zf[e]); v[4 + e] = o1[e] * rs * gn8[4 + e] * siluf_(zf[4 + e]); }
                    if (st) *(u32x4*)(zo + (size_t)(64 * (n - 1) + r) * 512 + pc16 * 8) = pack8(v); }
            }
        } else if (n < 32) {
            const float gl = gls[n & 1];
            bf16x8 Bs[2];
            Bs[0] = pack_frag(S[0], S[1]); Bs[1] = pack_frag(S[2], S[3]);
            f32x4 VN[4], O[4];
#pragma unroll
            for (int mt = 0; mt < 4; ++mt) { const u32x2 w = *(const LAS u32x2*)(cur + 4 * 9216 + dv * 144 + (16 * mt + 4 * g4) * 2);
                f32x4 c = (f32x4){bflo(w.x), bfhi(w.x), bflo(w.y), bfhi(w.y)};
#pragma unroll
                for (int ks = 0; ks < 2; ++ks) c = __builtin_amdgcn_mfma_f32_16x16x32_bf16(*(const LAS bf16x8*)(cur + (16 * mt + n_) * 144 + (32 * ks + 8 * g4) * 2), Bs[ks], c, 0, 0, 0);
                VN[mt] = c;
                f32x4 o = (f32x4){0.f, 0.f, 0.f, 0.f};
#pragma unroll
                for (int ks = 0; ks < 2; ++ks) o = __builtin_amdgcn_mfma_f32_16x16x32_bf16(*(const LAS bf16x8*)(cur + 9216 + (16 * mt + n_) * 144 + (32 * ks + 8 * g4) * 2), Bs[ks], o, 0, 0, 0);
                O[mt] = o; }
            bf16x8 Bv[2];
            Bv[0] = pack_frag(VN[0], VN[1]); Bv[1] = pack_frag(VN[2], VN[3]);
#pragma unroll
            for (int mt = 0; mt < 4; ++mt) {
#pragma unroll
                for (int ks = 0; ks < 2; ++ks) O[mt] = __builtin_amdgcn_mfma_f32_16x16x32_bf16(*(const LAS bf16x8*)(cur + 2 * 9216 + (16 * mt + n_) * 144 + (32 * ks + 8 * g4) * 2), Bv[ks], O[mt], 0, 0, 0);
                f32x4 sN = S[mt] * gl;
#pragma unroll
                for (int ks = 0; ks < 2; ++ks) sN = __builtin_amdgcn_mfma_f32_16x16x32_bf16(*(const LAS bf16x8*)(cur + 3 * 9216 + (16 * mt + n_) * 144 + (32 * ks + 8 * g4) * 2), Bv[ks], sN, 0, 0, 0);
                S[mt] = sN; }
#pragma unroll
            for (int mt = 0; mt < 4; ++mt)
#pragma unroll
                for (int e = 0; e < 4; ++e) *((LAS float*)(lds + OT + (n & 1) * OTB + (16 * mt + 4 * g4 + e) * 272) + dv) = O[mt][e];
        }
        lds_barrier();
    }
    if (wave < 4 && st) { float* so = a.out + O_STP + (size_t)bh * 4096;
#pragma unroll
        for (int kt = 0; kt < 4; ++kt)
#pragma unroll
            for (int e = 0; e < 4; ++e) so[(16 * kt + 4 * g4 + e) * 64 + dv] = S[kt][e]; }
}

__device__ __forceinline__ void gdn_sample(const Args& a, LAS unsigned char* lds, int u, int tid, int lane, int wave, bool st) {
    const int s = u >> 3, h = u & 7;
    LAS float* raw = (LAS float*)lds;
    LAS float* qkv = raw + 19 * 192;
    LAS float* gs = qkv + 16 * 192;
    LAS float* pa = gs + 32;
    LAS float* pb = pa + 512;
    LAS float* ol = pb + 512;
    const bf16_t* gqkv = (const bf16_t*)(a.ws + WS_GQKV); const float* ab = (const float*)(a.ws + WS_AB);
    for (int i = tid; i < 19 * 192; i += 512) { const int r = i / 192, cc = i - r * 192, seg = cc >> 6, c = cc & 63, col = seg * 512 + h * 64 + c;
        raw[i] = r < 3 ? a.in[I_CONV][((size_t)s * 3 + r) * 1536 + col] : bf2f(gqkv[(size_t)(MP + s * SS + (r - 3)) * 1536 + col]); }
    if (tid < 16) { const size_t row = (size_t)MP + s * SS + tid; const float av = ab[row * 16 + h], bv = ab[row * 16 + 8 + h];
        const float xg = av + a.in[I_DTB][h]; const float sp = fmaxf(xg, 0.f) + __logf(1.f + __expf(-fabsf(xg)));
        gs[tid] = __expf(-__expf(a.in[I_ALOG][h]) * sp); gs[16 + tid] = sigmoidf_(bv); }
    __syncthreads();
    for (int i = tid; i < 16 * 192; i += 512) { const int t = i / 192, cc = i - t * 192, seg = cc >> 6, c = cc & 63, col = seg * 512 + h * 64 + c;
        float y = 0.f;
#pragma unroll
        for (int tap = 0; tap < 4; ++tap) y += a.in[I_CONVW][tap * 1536 + col] * raw[(t + tap) * 192 + cc];
        qkv[i] = siluf_(y); }
    __syncthreads();
    for (int v = wave; v < 32; v += 8) { const int t = v >> 1, seg = v & 1; const float x = qkv[t * 192 + seg * 64 + lane];
        const float ss = wave_sum(x * x); qkv[t * 192 + seg * 64 + lane] = x * rsqrtf(ss + EPS) * (seg ? 1.f : 0.125f); }
    __syncthreads();
    const int dv = tid & 63, dkg = tid >> 6;
    float S[8];
    const float* s0 = a.in[I_ST] + (size_t)u * 4096;
#pragma unroll
    for (int i = 0; i < 8; ++i) S[i] = s0[(8 * dkg + i) * 64 + dv];
    for (int t = 0; t < 16; ++t) {
        const float eg = gs[t], bt = gs[16 + t];
        const LAS float* qr = qkv + t * 192; const LAS float* kr = qr + 64; const float vv = qr[128 + dv];
        float part = 0.f;
#pragma unroll
        for (int i = 0; i < 8; ++i) { S[i] *= eg; part += kr[8 * dkg + i] * S[i]; }
        pa[dkg * 64 + dv] = part;
        __syncthreads();
        float ks = 0.f;
#pragma unroll
        for (int w = 0; w < 8; ++w) ks += pa[w * 64 + dv];
        const float dl = bt * (vv - ks);
        float po = 0.f;
#pragma unroll
        for (int i = 0; i < 8; ++i) { S[i] += kr[8 * dkg + i] * dl; po += qr[8 * dkg + i] * S[i]; }
        pb[dkg * 64 + dv] = po;
        __syncthreads();
        if (dkg == 0) { float o = 0.f;
#pragma unroll
            for (int w = 0; w < 8; ++w) o += pb[w * 64 + dv];
            ol[t * 64 + dv] = o; }
    }
    __syncthreads();
    float* so = a.out + O_STS + (size_t)u * 4096;
#pragma unroll
    for (int i = 0; i < 8; ++i) if (st) so[(8 * dkg + i) * 64 + dv] = S[i];
    bf16_t* zo = (bf16_t*)(a.ws + WS_Z);
    for (int t = wave; t < 16; t += 8) { const float o = ol[t * 64 + lane]; const float ss = wave_sum(o * o);
        const size_t idx = ((size_t)MP + s * SS + t) * 512 + h * 64 + lane;
        const bf16_t res = f2bf(o * rsqrtf(ss * (1.f / 64.f) + EPS) * a.in[I_GNG][lane] * siluf_(bf2f(zo[idx]))); if (st) zo[idx] = res; }
}

struct AttnWave { int qrow, pos, mylast; bool qvalid; };
__device__ __forceinline__ void attn_unit(const Args& a, LAS unsigned char* lds, const bf16_t* Kb, const bf16_t* VTb, int pitch, int head, int ntiles, int nkeys,
                                          const AttnWave w, float boff, int tid, int lane) {
    const int r = lane & 31, hh = lane >> 5;
    const bf16_t* qraw = (const bf16_t*)(a.ws + WS_QRAW); const f32x2* rope = (const f32x2*)(a.ws + WS_ROPE);
    bf16x8 Qf[6];
    {
        const bf16_t* qp = qraw + (size_t)w.qrow * 768 + head * 96 + 8 * hh;
        float v[6][8]; float ss = 0.f;
#pragma unroll
        for (int s = 0; s < 6; ++s) { const u32x4 u = *(const u32x4*)(qp + 16 * s);
            v[s][0] = bflo(u.x); v[s][1] = bfhi(u.x); v[s][2] = bflo(u.y); v[s][3] = bfhi(u.y); v[s][4] = bflo(u.z); v[s][5] = bfhi(u.z); v[s][6] = bflo(u.w); v[s][7] = bfhi(u.w); }
#pragma unroll
        for (int e = 0; e < 8; ++e) { const f32x2 cs = rope[w.pos * 16 + 8 * hh + e]; const float x1 = v[4][e], x2 = v[5][e]; v[4][e] = x1 * cs.x - x2 * cs.y; v[5][e] = x2 * cs.x + x1 * cs.y; }
#pragma unroll
        for (int s = 0; s < 6; ++s)
#pragma unroll
            for (int e = 0; e < 8; ++e) ss += v[s][e] * v[s][e];
        ss += __shfl_xor(ss, 32);
        const float rs = rsqrtf(ss * (1.f / 96.f) + EPS) * (1.4426950408889634f * 0.10206207261596575f);
#pragma unroll
        for (int s = 0; s < 6; ++s) { float o[8];
#pragma unroll
            for (int e = 0; e < 8; ++e) o[e] = v[s][e] * rs * a.in[I_QHG][16 * s + 8 * hh + e];
            Qf[s] = __builtin_bit_cast(bf16x8, pack8(o)); }
    }
    const int kp0row = tid / 12, kp0c = tid - kp0row * 12, kp1row = (tid + 512) / 12, kp1c = (tid + 512) - kp1row * 12, vrow = tid >> 3, vc = tid & 7;
    const int pr = (r & 19) | ((r & 4) << 1) | ((r & 8) >> 1);
    constexpr int TB = 22528;
    f32x16 oa[2], sa[2];
#pragma unroll
    for (int i = 0; i < 16; ++i) { oa[0][i] = 0.f; oa[1][i] = 0.f; sa[0][i] = 0.f; sa[1][i] = 0.f; }
    float lsum = 0.f;
    u32x4 k0, k1, vv;
#define ATT_LOAD(T) do { const bf16_t* kn_ = Kb + (size_t)(T) * 64 * 96; k0 = *(const u32x4*)(kn_ + (size_t)kp0row * 96 + kp0c * 8); if (tid < 256) k1 = *(const u32x4*)(kn_ + (size_t)kp1row * 96 + kp1c * 8); \
        vv = *(const u32x4*)(VTb + (size_t)vrow * pitch + (T) * 64 + vc * 8); } while (0)
#define ATT_PARK(B) do { LAS unsigned char* b_ = lds + (B) * TB; *(LAS u32x4*)(b_ + kp0row * 208 + kp0c * 16) = k0; if (tid < 256) *(LAS u32x4*)(b_ + kp1row * 208 + kp1c * 16) = k1; \
        *(LAS u32x4*)(b_ + 13312 + vrow * 144 + vc * 16) = vv; } while (0)
#define ATT_QK(B, ACC) do { LAS unsigned char* b_ = lds + (B) * TB; _Pragma("unroll") for (int t2 = 0; t2 < 2; ++t2) { _Pragma("unroll") for (int i = 0; i < 16; ++i) ACC[t2][i] = -boff; \
        _Pragma("unroll") for (int s_ = 0; s_ < 6; ++s_) ACC[t2] = __builtin_amdgcn_mfma_f32_32x32x16_bf16(*(const LAS bf16x8*)(b_ + (32 * t2 + pr) * 208 + (16 * s_ + 8 * hh) * 2), Qf[s_], ACC[t2], 0, 0, 0); } } while (0)
    ATT_LOAD(0); ATT_PARK(0);
    if (ntiles > 1) { ATT_LOAD(1); ATT_PARK(1); }
    if (ntiles > 2) ATT_LOAD(2);
    __syncthreads();
    if (w.mylast >= 0) ATT_QK(0, sa);
    for (int kt = 0; kt < ntiles; ++kt) {
        const int bcur = kt % 3, bnx = (kt + 1) % 3, bwr = (kt + 2) % 3;
        const int key0 = kt * 64;
        if (kt + 2 < ntiles) ATT_PARK(bwr);
        if (kt + 3 < ntiles) ATT_LOAD(kt + 3);
        if (kt <= w.mylast) {
            f32x16 sn[2];
            const bool more = kt + 1 <= w.mylast;
            if (more) ATT_QK(bnx, sn);
            const bool tail = key0 + 64 > nkeys;
            bf16x8 Pf[2][2];
#pragma unroll
            for (int t2 = 0; t2 < 2; ++t2) { float p[16];
#pragma unroll
                for (int jj = 0; jj < 16; ++jj) { float e = __builtin_amdgcn_exp2f(sa[t2][jj]);
                    if (tail) { const int key = key0 + 32 * t2 + (jj & 3) + 4 * ((jj >> 2) & 1) + 8 * hh + 16 * (jj >> 3); if (key >= nkeys) e = 0.f; }
                    p[jj] = e; lsum += e; }
                Pf[t2][0] = __builtin_bit_cast(bf16x8, pack8(&p[0])); Pf[t2][1] = __builtin_bit_cast(bf16x8, pack8(&p[8])); }
            LAS unsigned char* cur = lds + bcur * TB;
#pragma unroll
            for (int mt = 0; mt < 2; ++mt)
#pragma unroll
                for (int t2 = 0; t2 < 2; ++t2)
#pragma unroll
                    for (int s2 = 0; s2 < 2; ++s2)
                        oa[mt] = __builtin_amdgcn_mfma_f32_32x32x16_bf16(*(const LAS bf16x8*)(cur + 13312 + (32 * mt + r) * 144 + (32 * t2 + 16 * s2 + 8 * hh) * 2), Pf[t2][s2], oa[mt], 0, 0, 0);
            if (more) { sa[0] = sn[0]; sa[1] = sn[1]; }
        }
        lds_barrier();
    }
#undef ATT_LOAD
#undef ATT_PARK
#undef ATT_QK
    lsum += __shfl_xor(lsum, 32);
    if (w.qvalid && w.mylast >= 0) { const float inv = 1.f / lsum; bf16_t* op = (bf16_t*)(a.ws + WS_OMLA) + (size_t)w.qrow * 512 + head * 64 + 4 * hh;
#pragma unroll
        for (int mt = 0; mt < 2; ++mt)
#pragma unroll
            for (int q4 = 0; q4 < 4; ++q4) { u32x2 o; o.x = cvt_pk_bf16(oa[mt][4 * q4] * inv, oa[mt][4 * q4 + 1] * inv); o.y = cvt_pk_bf16(oa[mt][4 * q4 + 2] * inv, oa[mt][4 * q4 + 3] * inv);
                *(u32x2*)(op + 32 * mt + 8 * q4) = o; } }
}
__device__ __forceinline__ void attn_phase(const Args& a, LAS unsigned char* lds, int tid, int lane, int wave) {
    const int c = blockIdx.x, G = gridDim.x;
    float mq = fabsf(a.in[I_QHG][lane]), mk = fabsf(a.in[I_KHG][lane]);
    if (lane < 32) { mq = fmaxf(mq, fabsf(a.in[I_QHG][64 + lane])); mk = fmaxf(mk, fabsf(a.in[I_KHG][64 + lane])); }
    const float boff = 9.797958971132712f * wave_max(mq) * wave_max(mk) * 1.4426950408889634f;
    const bf16_t* Kbuf = (const bf16_t*)(a.ws + WS_KBUF); const bf16_t* VT = (const bf16_t*)(a.ws + WS_VT);
#pragma unroll 1
    for (int rep = 0; rep < REPK(6); ++rep) {
    const int vc = (G % 8 == 0) ? (c % 8) * (G / 8) + c / 8 : c;
    for (int p = vc; p < 256; p += G) { const int bh = p >> 2, b = bh >> 3, h = bh & 7;
#pragma unroll 1
        for (int half = 0; half < 2; ++half) { const int qb = half ? 7 - (p & 3) : ((p & 3) ^ 2);
            AttnWave w; w.pos = 256 * qb + 32 * wave + (lane & 31); w.qrow = b * SP + w.pos; w.mylast = 4 * qb + (wave >> 1); w.qvalid = true;
            attn_unit(a, lds, Kbuf + (size_t)bh * SP * 96, VT + (size_t)bh * 64 * SP, SP, h, 4 * qb + 4, SP, w, boff, tid, lane); } }
    for (int p = vc; p < 256; p += G) if (p & 2) { const int u = (p >> 2) * 2 + (p & 1), s = u >> 3, h = u & 7;
        AttnWave w; w.pos = PAST + (lane & 15); w.qrow = MP + s * SS + (lane & 15); w.mylast = wave == 0 ? 32 : -1; w.qvalid = (lane & 31) < 16;
        attn_unit(a, lds, Kbuf + ((size_t)MP * 8 + (size_t)u * SKV) * 96, VT + VT_SAMPLE_OFF + (size_t)u * 64 * SKV, SKV, h, 33, SKV, w, boff, tid, lane); }
    }
}

#define XB_TMO      128
#define XB_XCNT(j)  (256  + 64 * (j))
#define XB_XSUB(j)  (1280 + 64 * (j))
#define XB_XGEN(j)  (2304 + 64 * (j))
#define XB_TOP      3328
#define XB_TOPGEN   3392
#define XCD_BAR_WORDS 3456
#define XB_SPIN_CAP (1u << 18)

__device__ __forceinline__ unsigned xb_ld(unsigned* p)              { return __hip_atomic_load(p, __ATOMIC_RELAXED, __HIP_MEMORY_SCOPE_AGENT); }
__device__ __forceinline__ unsigned xb_add(unsigned* p, unsigned v) { return __hip_atomic_fetch_add(p, v, __ATOMIC_RELAXED, __HIP_MEMORY_SCOPE_AGENT); }
__device__ __forceinline__ unsigned xb_xcc_id() { return (unsigned)__builtin_amdgcn_s_getreg((3 << 11) | 20) & 0xFu; }
#define XB_SPIN(cond, bar) do { unsigned _sp = 0; while (cond) { __builtin_amdgcn_s_sleep(1); \
    if ((++_sp & 255u) == 0u) { if (xb_ld(&(bar)[XB_TMO])) break; if (_sp > XB_SPIN_CAP) { atomicAdd(&(bar)[XB_TMO], 1u); break; } } } } while (0)

struct XcdBarrier {
    unsigned* bar; unsigned x;
    volatile LAS unsigned* st;
};

__device__ __forceinline__ XcdBarrier xcd_barrier_post(unsigned* bar, volatile LAS unsigned* st) {
    XcdBarrier b; b.bar = bar; b.x = xb_xcc_id(); b.st = st;
    if (threadIdx.x == 0) (void)xb_add(&bar[XB_XCNT(b.x)], 1u);
    return b;
}
__device__ __forceinline__ void xcd_barrier_complete(unsigned* bar, unsigned x, unsigned& nloc, unsigned& nx) {
    const unsigned G = gridDim.x * gridDim.y * gridDim.z;
    unsigned sum, cnt, mine, sp = 0u;
    for (;;) {
        sum = 0u; cnt = 0u; mine = 0u;
#pragma unroll
        for (unsigned j = 0; j < 16; ++j) { const unsigned c = xb_ld(&bar[XB_XCNT(j)]); sum += c; cnt += (c > 0u) ? 1u : 0u; mine = (j == x) ? c : mine; }
        if (sum == G) break;
        __builtin_amdgcn_s_sleep(1);
        if ((++sp & 255u) == 0u) { if (xb_ld(&bar[XB_TMO])) break; if (sp > XB_SPIN_CAP) { atomicAdd(&bar[XB_TMO], 1u); break; } }
    }
    nloc = mine > 0u ? mine : 1u; nx = cnt > 0u ? cnt : 1u;
}

__device__ __forceinline__ void xcd_barrier(const XcdBarrier& b) {
    asm volatile("s_waitcnt vmcnt(0)" ::: "memory");
    __syncthreads();
    if (threadIdx.x == 0) {
        unsigned* bar = b.bar;
        __builtin_amdgcn_s_waitcnt(0);
        unsigned nloc = b.st[0], nx = b.st[1];
        if (nloc == 0u) { xcd_barrier_complete(bar, b.x, nloc, nx); b.st[0] = nloc; b.st[1] = nx; }
        const unsigned old = xb_add(&bar[XB_XSUB(b.x)], 1u);
        const unsigned gen = old / nloc;
        if (old + 1u == (gen + 1u) * nloc) {
            __builtin_amdgcn_fence(__ATOMIC_RELEASE, "agent");
            asm volatile("s_waitcnt vmcnt(0)" ::: "memory");
            const unsigned og = xb_add(&bar[XB_TOP], 1u);
            const unsigned tg = og / nx;
            if (og + 1u == (tg + 1u) * nx) xb_add(&bar[XB_TOPGEN], 1u);
            else XB_SPIN(xb_ld(&bar[XB_TOPGEN]) == tg, bar);
            __builtin_amdgcn_fence(__ATOMIC_ACQUIRE, "agent");
            xb_add(&bar[XB_XGEN(b.x)], 1u);
            asm volatile("s_waitcnt vmcnt(0)" ::: "memory");
        } else {
            XB_SPIN(xb_ld(&bar[XB_XGEN(b.x)]) == gen, bar);
            __builtin_amdgcn_fence(__ATOMIC_ACQUIRE, "agent");
            asm volatile("s_waitcnt vmcnt(0)" ::: "memory");
        }
    }
    __syncthreads();
}


__global__ void __launch_bounds__(512, 2) mk_fwd(Args a) {
    extern __shared__ __attribute__((aligned(16))) unsigned char lds_raw[];
    LAS unsigned char* lds = (LAS unsigned char*)lds_raw;
    const int tid = threadIdx.x, lane = tid & 63, wave = __builtin_amdgcn_readfirstlane(tid >> 6);
    const int c = blockIdx.x, G = gridDim.x, gw = c * 8 + wave;
    unsigned char* ws = a.ws;
    volatile LAS unsigned* bst = (volatile LAS unsigned*)(lds + 147456);
    if (tid < 16) bst[tid] = 0u;
    __syncthreads();
    XcdBarrier xbar = xcd_barrier_post((unsigned*)(ws + WS_CTL) + CW_BAR, bst);
    const int lo = a.ph_lo, hi = a.ph_hi;
    if (hi > 4096) cg::this_grid().sync();
#define IN(k) (((MK_PHMASK >> (k)) & 1) && lo <= (k) && (k) < hi)
#if MK_SPLIT
#define SEAM(k) do { } while (0)
#else
#define SEAM(k) do { if (IN(k) && IN((k) + 1)) xcd_barrier(xbar); if (PROBE_A >= 0) { const unsigned long long now_ = __builtin_amdgcn_s_memrealtime(); \
        if ((k) == PROBE_A - 1) tA0 = now_; if ((k) == PROBE_A) tA1 = now_; if ((k) == PROBE_B - 1) tB0 = now_; if ((k) == PROBE_B) tB1 = now_; } } while (0)
#endif
    const bf16_t* H = (const bf16_t*)(ws + WS_H);
    float* mod = (float*)(ws + WS_MOD);
    unsigned long long tA0 = 0, tA1 = 0, tB0 = 0, tB1 = 0;
    if (PROBE_A >= 0) { tA0 = tB0 = __builtin_amdgcn_s_memrealtime(); }
    unsigned long long lp0 = 0, lp1 = 0, lp2 = 0;
    if (PROBE_LP == 3) lp0 = __builtin_amdgcn_s_memrealtime();
    if (IN(0)) phase0(a, lds, tid, lane, wave, lp1);
    if (PROBE_LP == 3) { asm volatile("s_waitcnt vmcnt(0)" ::: "memory"); lp2 = __builtin_amdgcn_s_memrealtime(); }
    SEAM(0);
#if MK_XSYNC && !MK_SPLIT
#pragma unroll 1
    for (int x = 0; x < MK_XSYNC; ++x) cg::this_grid().sync();
#endif
    if (IN(1)) norm_rows(a.in[I_XP], a.in[I_XS], a.in[I_N1G], mod, 0, 1024, (bf16_t*)(ws + WS_H), gw, lane, nullptr, nullptr);
    SEAM(1);
    if (IN(2)) { pg8::Gemm g{{H, H}, {(const bf16_t*)(ws + WS_WIN), nullptr}, 1024, 1024, 1024}; pg8::StaticOrder S; S.init(MR / 256, NINP / 256, G, c, REPK(2));
        EpiProj E{(bf16_t*)(ws + WS_GQKV), (bf16_t*)(ws + WS_Z), (bf16_t*)a.out, (bf16_t*)(ws + WS_GLS), (bf16_t*)(ws + WS_CKVRAW), (bf16_t*)(ws + WS_CQ), (float*)(ws + WS_KRRAW), (float*)(ws + WS_AB)};
        pg8::gemm_phase(lds, g, S, E); }
    SEAM(2);
    if (IN(3)) { gdn_prep(a, lds, tid); if (G <= 64) { mla_rows(a, gw, G * 8, lane); misc_p3(a, c * 512 + tid, G * 512); } }
    SEAM(3);
    if (IN(4)) {
        if (PROBE_LP == 1 || PROBE_LP == 2) lp0 = __builtin_amdgcn_s_memrealtime();
#pragma unroll 1
        for (int rep = REPK(4) - 1; rep >= 0; --rep) for (int u = c; u < 192; u += G) { if (u < 64) scan_prompt(a, lds, u, tid, lane, wave, rep == 0); else gdn_sample(a, lds, u - 64, tid, lane, wave, rep == 0); __syncthreads(); }
        if (PROBE_LP == 1 && c == 64) { lp1 = __builtin_amdgcn_s_memrealtime(); }
        if (PROBE_LP == 2 && c == 0) { lp1 = __builtin_amdgcn_s_memrealtime(); }
        if (G > 64 && c >= 64) { mla_rows(a, (c - 64) * 8 + wave, (G - 64) * 8, lane); misc_p3(a, (c - 64) * 512 + tid, (G - 64) * 512); __syncthreads(); ffn_weight_transposes(a, lds, (c - 64) * 8 + wave, (G - 64) * 8, lane, wave); }
        else if (G <= 64) ffn_weight_transposes(a, lds, c * 8 + wave, G * 8, lane, wave);
        if (PROBE_LP == 1 && c == 64) { asm volatile("s_waitcnt vmcnt(0)" ::: "memory"); lp2 = __builtin_amdgcn_s_memrealtime(); } }
    SEAM(4);
    if (PROBE_LP == 2 && c == 0) lp2 = __builtin_amdgcn_s_memrealtime();
    if (IN(5)) {
        { pg8::Gemm g{{(const bf16_t*)(ws + WS_CQ), nullptr}, {(const bf16_t*)(ws + WS_WUQ), nullptr}, 384, 384, 384}; pg8::StaticOrder S; S.init(MR / 256, 3, G, c, REPK(5));
          EpiBf16<0> E{(bf16_t*)(ws + WS_QRAW), 768}; pg8::gemm_phase(lds, g, S, E); }
        { pg8::Gemm g{{(const bf16_t*)(ws + WS_CKVROWS), nullptr}, {(const bf16_t*)(ws + WS_WUK), nullptr}, 256, 256, 256}; pg8::StaticOrder S; S.init(KR / 256, 2, G, (c + G - 195 % G) % G, REPK(5));
          EpiK E{(bf16_t*)(ws + WS_KBUF), a.in[I_KHG], a.out + O_KRP, a.out + O_KRS, a.in[I_CKR]}; pg8::gemm_phase(lds, g, S, E); }
        { pg8::Gemm g{{(const bf16_t*)(ws + WS_WUV), nullptr}, {(const bf16_t*)(ws + WS_CKVROWS), nullptr}, 256, 256, 256}; pg8::StaticOrder S; S.init(2, KR / 256, G, (c + G - 69 % G) % G, REPK(5));
          EpiVT E{(bf16_t*)(ws + WS_VT)}; pg8::gemm_phase(lds, g, S, E); }
    }
    SEAM(5);
    if (IN(6)) attn_phase(a, lds, tid, lane, wave);
    SEAM(6);
    if (IN(7)) { pg8::Gemm g{{(const bf16_t*)(ws + WS_Z), (const bf16_t*)(ws + WS_OMLA)}, {(const bf16_t*)(ws + WS_WGO), (const bf16_t*)(ws + WS_WMO)}, 512, 512, 512};
        pg8::DualOrder S; S.S.init(MP / 256, 4, G, c, REPK(7)); EpiGate E{(bf16_t*)(ws + WS_MERGED), (const bf16_t*)a.out, (const bf16_t*)(ws + WS_GLS)};
        if (PROBE_LP == 5) lp0 = __builtin_amdgcn_s_memrealtime();
        pg8::gemm_phase(lds, g, S, E);
        if (PROBE_LP == 5) { asm volatile("s_waitcnt vmcnt(0)" ::: "memory"); lp1 = __builtin_amdgcn_s_memrealtime(); }
    }
    SEAM(7);
    if (PROBE_LP == 5) lp2 = __builtin_amdgcn_s_memrealtime();
    if (IN(8)) {
        unsigned* hcnt = (unsigned*)(ws + WS_CTL) + 8192;
        {
            pg8::Gemm gs{{(const bf16_t*)(ws + WS_Z), (const bf16_t*)(ws + WS_OMLA)}, {(const bf16_t*)(ws + WS_WGO), (const bf16_t*)(ws + WS_WMO)}, 512, 512, 256};
            pg8::PieceOrder P{4, 2, G, c, 16, 16, 256, 4}; EpiGateS Es{(float*)(ws + WS_PART7), (const bf16_t*)(ws + WS_GLS)}; Unit pu;
            if (P.next(0, pu)) { pg8::gemm_phase(lds, gs, P, Es);
                if (tid == 0) { __builtin_amdgcn_fence(__ATOMIC_RELEASE, "agent"); asm volatile("s_waitcnt vmcnt(0)" ::: "memory");
                    __hip_atomic_fetch_add(hcnt, 1u, __ATOMIC_RELAXED, __HIP_MEMORY_SCOPE_AGENT); } }
        }
        pg8::Gemm g{{(const bf16_t*)(ws + WS_MERGED), nullptr}, {(const bf16_t*)(ws + WS_WO), nullptr}, 1024, 1024, 1024}; pg8::StaticOrder S; S.init(MP / 256, 4, G, c, REPK(8));
        if (PROBE_LP == 4) lp0 = __builtin_amdgcn_s_memrealtime();
        EpiRes1 E{a.in[I_XP], (bf16_t*)(ws + WS_X1B), mod}; pg8::gemm_phase(lds, g, S, E);
        if (PROBE_LP == 4) { asm volatile("s_waitcnt vmcnt(0)" ::: "memory"); lp1 = __builtin_amdgcn_s_memrealtime(); }
        pg8::PieceOrder P{4, 8, G, c, 8, 32, 128, 0}; Unit pu;
        if (P.next(0, pu)) {
            if (tid == 0) { unsigned spins = 0; while (__hip_atomic_load(hcnt, __ATOMIC_RELAXED, __HIP_MEMORY_SCOPE_AGENT) < 16u && ++spins < (1u << 22)) __builtin_amdgcn_s_sleep(2);
                __builtin_amdgcn_fence(__ATOMIC_ACQUIRE, "agent"); asm volatile("s_waitcnt vmcnt(0)" ::: "memory"); }
            __syncthreads(); }
        if (P.next(0, pu)) convert_slice<4, 16>((const float*)(ws + WS_PART7), 1024, (bf16_t*)(ws + WS_MERGED) + (size_t)MP * 1024, pu.pk, tid);
        pg8::Gemm gs{{(const bf16_t*)(ws + WS_MERGED), nullptr}, {(const bf16_t*)(ws + WS_WO), nullptr}, 1024, 1024, 128}; EpiAtom Es{(float*)(ws + WS_PART8), 1024, mod, 2048, 128}; pg8::gemm_phase(lds, gs, P, Es); }
    SEAM(8);
    if (PROBE_LP == 4) lp2 = __builtin_amdgcn_s_memrealtime();
    if (IN(9)) norm_rows((const float*)(ws + WS_X1B), a.in[I_XS], a.in[I_N2G], mod, 3072, 4096, (bf16_t*)(ws + WS_H), gw, lane, (const float*)(ws + WS_PART8), a.out + (size_t)MP * 1024);
    SEAM(9);
    if (IN(10)) { pg8::Gemm g{{H, nullptr}, {(const bf16_t*)(ws + WS_WF1), nullptr}, 1024, 1024, 1024}; pg8::StaticOrder S; S.init(MR / 256, 16, G, c, REPK(10));
        EpiBf16<1> E{(bf16_t*)(ws + WS_HID), DFF}; pg8::gemm_phase(lds, g, S, E); }
    SEAM(10);
    if (IN(11)) { pg8::Gemm g{{(const bf16_t*)(ws + WS_HID), nullptr}, {(const bf16_t*)(ws + WS_WF2), nullptr}, DFF, DFF, DFF}; pg8::StaticOrder S; S.init(MP / 256, 4, G, c);
        EpiRes2 E{(const bf16_t*)(ws + WS_X1B), a.out, mod}; pg8::gemm_phase(lds, g, S, E);
        pg8::PieceOrder P{4, 16, G, c, 4, 64, 256, 0};
        pg8::Gemm gs{{(const bf16_t*)(ws + WS_HID), nullptr}, {(const bf16_t*)(ws + WS_WF2), nullptr}, DFF, DFF, 256}; EpiAtom Es{(float*)(ws + WS_PART11), 1024, mod, 5120, 256}; pg8::gemm_phase(lds, gs, P, Es);
        { Unit pu; if (P.next(0, pu)) {
            unsigned* hcnt4 = (unsigned*)(ws + WS_CTL) + 8192 + 192;
            if (tid == 0) { __builtin_amdgcn_fence(__ATOMIC_RELEASE, "agent"); asm volatile("s_waitcnt vmcnt(0)" ::: "memory"); __hip_atomic_fetch_add(hcnt4, 1u, __ATOMIC_RELAXED, __HIP_MEMORY_SCOPE_AGENT);
                unsigned spins = 0; while (__hip_atomic_load(hcnt4, __ATOMIC_RELAXED, __HIP_MEMORY_SCOPE_AGENT) < 64u && ++spins < (1u << 22)) __builtin_amdgcn_s_sleep(2);
                __builtin_amdgcn_fence(__ATOMIC_ACQUIRE, "agent"); asm volatile("s_waitcnt vmcnt(0)" ::: "memory"); }
            __syncthreads();
            const int L = pu.pn + 4 * (pu.pk >> 8);
            for (int i = tid; i < 1024; i += 512) { const size_t idx = (size_t)(4 * L + (i >> 8)) * 256 + (i & 255); f32x4 v = ((const f32x4*)(a.out + (size_t)MP * 1024))[idx];
#pragma unroll
                for (int k = 0; k < 16; ++k) v += ((const f32x4*)(ws + WS_PART11))[(size_t)k * (MS * 256) + idx];
                ((f32x4*)(a.out + (size_t)MP * 1024))[idx] = v; } } }
    }
    if (PROBE_LP && c == (PROBE_LP == 1 ? 64 : (PROBE_LP == 3 ? 8 : ((PROBE_LP == 4 || PROBE_LP == 5) ? 1 : 0))) && tid == 0) {
        const unsigned long long dA = ((lp1 - lp0) + 400) / 800, dB = ((lp2 - lp1) + 400) / 800;
        const unsigned long long wait = ((dA > 63 ? 63 : dA) + 64 * (dB > 63 ? 63 : dB)) * 3200ull, t0 = __builtin_amdgcn_s_memrealtime();
        while (__builtin_amdgcn_s_memrealtime() - t0 < wait) __builtin_amdgcn_s_sleep(32);
    }
    if (PROBE_A >= 0 && c == 0 && tid == 0) {
        const unsigned long long dA = ((tA1 - tA0) + 400) / 800, dB = PROBE_B >= 0 ? ((tB1 - tB0) + 400) / 800 : 0;
        const unsigned long long wait = ((dA > 63 ? 63 : dA) + 64 * (dB > 63 ? 63 : dB)) * 3200ull, t0 = __builtin_amdgcn_s_memrealtime();
        while (__builtin_amdgcn_s_memrealtime() - t0 < wait) __builtin_amdgcn_s_sleep(32);
    }
#undef IN
#undef SEAM
}

extern "C" void kernel_launch(void* const* d_in, const int* in_sizes, int n_in, void* d_out, int out_size, void* d_ws, size_t ws_size, hipStream_t stream) {
    static int grid = 0;
    if (grid == 0) {
        int dev = 0, cus = 0, per_cu = 0;
        hipGetDevice(&dev); hipDeviceGetAttribute(&cus, hipDeviceAttributeMultiprocessorCount, dev);
        hipFuncSetAttribute((const void*)mk_fwd, hipFuncAttributeMaxDynamicSharedMemorySize, LDS_BYTES);
        hipOccupancyMaxActiveBlocksPerMultiprocessor(&per_cu, (const void*)mk_fwd, 512, LDS_BYTES);
        if (per_cu < 1) per_cu = 1;
        grid = cus * per_cu; if (grid > 256) grid = 256;
        (void)hipGetLastError();
    }
    hipMemsetAsync((char*)d_ws + WS_CTL, 0, 64 * KiB, stream);
    Args a{};
    for (int i = 0; i < 28; ++i) a.in[i] = (const float*)d_in[i];
    a.out = (float*)d_out; a.ws = (unsigned char*)d_ws;
#if MK_SPLIT
    for (int p = 0; p < NPHASE; ++p) { a.ph_lo = p; a.ph_hi = p + 1; hipLaunchKernelGGL(mk_fwd, dim3(grid), dim3(512), LDS_BYTES, stream, a); }
#else
    a.ph_lo = 0; a.ph_hi = NPHASE;
    void* args[] = {&a};
    hipError_t e = hipLaunchCooperativeKernel((const void*)mk_fwd, dim3(grid), dim3(512), args, LDS_BYTES, stream);
    if (e != hipSuccess) fprintf(stderr, "cooperative launch failed: %s (grid %d)\n", hipGetErrorString(e), grid);
#endif
}
```

```cpp
#include <hip/hip_runtime.h>
#include <hip/hip_cooperative_groups.h>
#include <cstdio>
#include <cstdint>
namespace cg = cooperative_groups;

#ifndef REP_GEMM
#define REP_GEMM 0x111111111111ull
#endif
#define REPK(k) ((int)((REP_GEMM >> (4 * (k))) & 15))
#ifndef PROBE_A
#define PROBE_A -1
#endif
#ifndef PROBE_B
#define PROBE_B -1
#endif
#ifndef PROBE_LP
#define PROBE_LP 0
#endif
#ifndef MK_XSYNC
#define MK_XSYNC 0
#endif
#ifndef MK_PHMASK
#define MK_PHMASK 0x1FFF
#endif
#ifndef MK_SPLIT
#define MK_SPLIT 0
#endif

#define LAS __attribute__((address_space(3)))
typedef unsigned short bf16_t;
typedef short bf16x8 __attribute__((ext_vector_type(8)));
typedef float f32x4 __attribute__((ext_vector_type(4)));
typedef float f32x2 __attribute__((ext_vector_type(2)));
typedef float f32x16 __attribute__((ext_vector_type(16)));
typedef unsigned u32x4 __attribute__((ext_vector_type(4)));
typedef unsigned u32x2 __attribute__((ext_vector_type(2)));

constexpr int DM = 1024, BP = 8, SP = 2048, BS = 16, SS = 16, PAST = 2048;
constexpr int MP = BP * SP, MS = BS * SS, MR = MP + MS;
constexpr int SKV = PAST + SS;
constexpr int KR = MP + BS * SKV;
constexpr int NIN = 4784, NINP = 4864;
constexpr int DFF = 4096;
constexpr float EPS = 1e-6f;

constexpr size_t O_Y = 0, O_CKVP = 17039360, O_KRP = 21233664, O_STP = 21757952, O_CVP = 22020096,
                 O_CKVS = 22056960, O_KRS = 22122496, O_STS = 22130688, O_CVS = 22654976;

constexpr size_t KiB = 1024, MiB = 1024 * 1024;
constexpr size_t WS_CTL = 0;
constexpr size_t WS_MOD = 64 * KiB;
constexpr size_t WS_ROPE = 640 * KiB;
constexpr size_t WS_WIN = 960 * KiB;
constexpr size_t WS_WUQ = WS_WIN + (size_t)NINP * 1024 * 2;
constexpr size_t WS_WUK = WS_WUQ + 768 * 384 * 2;
constexpr size_t WS_WUV = WS_WUK + 512 * 256 * 2;
constexpr size_t WS_WGO = WS_WUV + 512 * 256 * 2;
constexpr size_t WS_WMO = WS_WGO + 1024 * 512 * 2;
constexpr size_t WS_WO = WS_WMO + 1024 * 512 * 2;
constexpr size_t WS_WF1 = WS_WO + 1024 * 1024 * 2;
constexpr size_t WS_WF2 = WS_WF1 + (size_t)4096 * 1024 * 2;
constexpr size_t WS_WEND = WS_WF2 + (size_t)4096 * 1024 * 2;
static_assert(WS_WEND <= 32 * MiB, "weights region");
constexpr size_t WS_H = 32 * MiB;
constexpr size_t WS_CKVROWS = 32 * MiB;
constexpr size_t WS_OMLA = 32 * MiB;
constexpr size_t WS_GQKV = 64 * MiB + 512 * KiB;
constexpr size_t WS_VT = WS_GQKV;
constexpr size_t WS_Z = 113 * MiB + 256 * KiB;
constexpr size_t WS_CQ = 129 * MiB + 512 * KiB;
constexpr size_t WS_CKVRAW = WS_CQ + (size_t)MR * 384 * 2;
constexpr size_t WS_KRRAW = WS_CKVRAW + (size_t)MR * 256 * 2;
constexpr size_t WS_AB = WS_KRRAW + (size_t)MR * 32 * 4;
static_assert(WS_AB + (size_t)MR * 16 * 4 <= 153 * MiB, "small proj outputs");
constexpr size_t WS_PREP = 153 * MiB;
constexpr size_t REC_BYTES = 41024;
static_assert(WS_PREP + (size_t)2048 * REC_BYTES <= 256 * MiB, "prep region");
constexpr size_t WS_KBUF = 153 * MiB;
constexpr size_t WS_QRAW = WS_KBUF + (size_t)KR * 768 * 2;
static_assert(WS_QRAW + (size_t)MR * 768 * 2 <= 256 * MiB, "qraw");
constexpr size_t WS_MERGED = 153 * MiB;
constexpr size_t WS_HID = 64 * MiB + 512 * KiB;
static_assert(WS_HID + (size_t)MR * DFF * 2 <= 256 * MiB, "hid");
constexpr size_t WS_GLS = 250 * MiB;
constexpr size_t WS_PART8 = 186 * MiB;
constexpr size_t WS_PART7 = 196 * MiB;
constexpr size_t WS_PART11 = 196 * MiB;
constexpr size_t WS_HACC = 251 * MiB;
constexpr size_t WS_MACC = 255 * MiB;
constexpr size_t WS_X1B = 212 * MiB;
static_assert(WS_X1B + (size_t)MP * 1024 * 2 <= 250 * MiB, "x1b");
constexpr size_t VT_SAMPLE_OFF = (size_t)BP * 8 * 64 * SP;

constexpr int LDS_BYTES = 147456 + 64;
constexpr int CW_BAR = 4096;
constexpr int NPHASE = 13;

__device__ __forceinline__ unsigned cvt_pk_bf16(float lo, float hi) { unsigned r; asm volatile("v_cvt_pk_bf16_f32 %0, %1, %2" : "=v"(r) : "v"(lo), "v"(hi)); return r; }
__device__ __forceinline__ float bflo(unsigned u) { return __uint_as_float(u << 16); }
__device__ __forceinline__ float bfhi(unsigned u) { return __uint_as_float(u & 0xffff0000u); }
__device__ __forceinline__ float bf2f(bf16_t b) { return __uint_as_float((unsigned)b << 16); }
__device__ __forceinline__ bf16_t f2bf(float f) { return (bf16_t)(cvt_pk_bf16(f, 0.f) & 0xffffu); }
__device__ __forceinline__ float wave_max(float v) {
#pragma unroll
    for (int o = 1; o < 64; o <<= 1) v = fmaxf(v, __shfl_xor(v, o));
    return v;
}
__device__ __forceinline__ void lds_barrier() { asm volatile("s_waitcnt lgkmcnt(0)\n\ts_barrier" ::: "memory"); }
__device__ __forceinline__ float dpp_add(float v, const int ctrl) { return v; }
#define DPP_ADD(v, ctrl) ((v) + __builtin_bit_cast(float, __builtin_amdgcn_update_dpp(0, __builtin_bit_cast(int, (v)), (ctrl), 0xF, 0xF, true)))
__device__ __forceinline__ float row16_sum(float v) { v = DPP_ADD(v, 0xB1); v = DPP_ADD(v, 0x4E); v = DPP_ADD(v, 0x141); v = DPP_ADD(v, 0x140); return v; }
__device__ __forceinline__ float wave_sum(float v) { v = row16_sum(v); v += __shfl_xor(v, 16); v += __shfl_xor(v, 32); return v; }
__device__ __forceinline__ float sigmoidf_(float x) { return 1.f / (1.f + __expf(-x)); }
__device__ __forceinline__ float siluf_(float x) { return x / (1.f + __expf(-x)); }
__device__ __forceinline__ u32x4 pack8(const float* v) { u32x4 w; w.x = cvt_pk_bf16(v[0], v[1]); w.y = cvt_pk_bf16(v[2], v[3]); w.z = cvt_pk_bf16(v[4], v[5]); w.w = cvt_pk_bf16(v[6], v[7]); return w; }
__device__ __forceinline__ int mod_row(int r) { return r < MP ? (r >> 11) : 8 + ((r - MP) >> 4); }

namespace pg8 {
constexpr int BM = 256, BK = 64, HALF = 128, HTB = HALF * BK * 2, STAGE_BYTES = 8 * HTB, NXCD = 8, WGM = 8;
__host__ __device__ __forceinline__ int lds_byte(int r, int c) { const int st = (r >> 4) * 2 + (c >> 5), rr = r & 15, cc = c & 31, ob = rr * 64 + cc * 2; return st * 1024 + (ob ^ (((ob >> 9) & 1) << 5)); }
__host__ __device__ __forceinline__ void stage_rc(int b, int& R, int& C) { const int st = b / 1024, sb = b % 1024, swz = sb ^ (((sb >> 9) & 1) << 5); R = (st >> 1) * 16 + swz / 64; C = (st & 1) * 32 + (swz % 64) / 2; }
__host__ __device__ __forceinline__ int perm32(int rho) { const int n = rho >> 4, i = rho & 15; return 8 * (i >> 2) + 4 * n + (i & 3); }

struct Unit { int pm, pn, sel, pk; };
struct Gemm { const bf16_t* A[2]; const bf16_t* Bt[2]; int lda, ldb, K; };

struct StaticOrder {
    int nM, nN, nwg, G, c, rep;
    __device__ void init(int nM_, int nN_, int G_, int c_, int rep_ = 1) { nM = nM_; nN = nN_; nwg = nM * nN; G = G_; c = c_; rep = rep_; }
    __device__ __forceinline__ bool next(int i, Unit& u) const {
        const long L = (long)(i / rep) * G + c; if (L >= nwg) return false;
        int wgid = (int)L; { const int q = nwg / NXCD, r = nwg % NXCD, xcd = wgid % NXCD, off = wgid / NXCD; wgid = (xcd < r ? xcd * (q + 1) : r * (q + 1) + (xcd - r) * q) + off; }
        const int nig = WGM * nN, gid = wgid / nig, fm = gid * WGM, gsz = (nM - fm) < WGM ? (nM - fm) : WGM;
        u.pm = fm + ((wgid % nig) % gsz); u.pn = (wgid % nig) / gsz; u.sel = 0; u.pk = 0; return true;
    }
};
struct PieceOrder {
    int npn, nks, G, c, stride, npieces, klen, off;
    __device__ __forceinline__ bool next(int i, Unit& u) const {
        const int q_ = (c >> 3) - off; if (i != 0 || q_ < 0 || (q_ % stride) != 0) return false; const int L = (c & 7) + 8 * (q_ / stride); if (L >= npieces) return false;
        u.pm = 64; u.pn = L % npn; const int r = L / npn; u.pk = (r % nks) * klen; u.sel = r / nks; return true;
    }
};
struct DualOrder {
    StaticOrder S;
    __device__ __forceinline__ bool next(int i, Unit& u) const { const bool ok = S.next(i >> 1, u); u.sel = i & 1; return ok; }
};

template <class Epi, class Sched>
__device__ __forceinline__ void gemm_phase(LAS unsigned char* lds, const Gemm g, const Sched& S, const Epi& E) {
    const int tid = threadIdx.x, wid = __builtin_amdgcn_readfirstlane(tid >> 6), lane = tid & 63, wr = wid >> 2, wc = wid & 3, fr = lane & 15, fq = lane >> 4;
    const int K = g.K, nt = K / BK;
    unsigned voffA[2], voffB[2];
#pragma unroll
    for (int i = 0; i < 2; ++i) { int R, C; stage_rc(tid * 16 + i * 8192, R, C); const int Rb = Epi::PERM ? ((R & ~31) + perm32(R & 31)) : R;
        voffA[i] = (unsigned)(R * g.lda + C) * 2u; voffB[i] = (unsigned)(Rb * g.ldb + C) * 2u; }
    const size_t kstep = (size_t)(BK * 2);
    const size_t hstepA = (size_t)HALF * g.lda * 2, hstepB = (size_t)HALF * g.ldb * 2;
    const size_t tstepA = 2 * hstepA, tstepB = 2 * hstepB;
    const unsigned ldsw = (unsigned)wid * 1024u;
    const int aoff = lds_byte(wr * 64 + fr, fq * 8), boff = lds_byte(wc * 32 + fr, fq * 8);
#define PG8_SA(b, h) (((b) * 2 + (h)) * HTB)
#define PG8_SB(b, h) ((4 + (b) * 2 + (h)) * HTB)
#define PG8_STAGE(bufoff, gbase, voff) do { _Pragma("unroll") for (int _i = 0; _i < 2; ++_i) \
        __builtin_amdgcn_global_load_lds((const unsigned*)((const char*)(gbase) + (voff)[_i]), (LAS unsigned*)(lds + (bufoff) + ldsw + _i * 8192), 16, 0, 0); } while (0)
#define PG8_LDA(dst, b, h) do { _Pragma("unroll") for (int m = 0; m < 4; ++m) _Pragma("unroll") for (int k = 0; k < 2; ++k) dst[m][k] = *(const LAS bf16x8*)(lds + PG8_SA(b, h) + aoff + m * 2048 + k * 1024); } while (0)
#define PG8_LDB(dst, b, h) do { _Pragma("unroll") for (int n = 0; n < 2; ++n) _Pragma("unroll") for (int k = 0; k < 2; ++k) dst[n][k] = *(const LAS bf16x8*)(lds + PG8_SB(b, h) + boff + n * 2048 + k * 1024); } while (0)
#define PG8_MMA(ai, bj, At, Bt) do { __builtin_amdgcn_s_setprio(1); _Pragma("unroll") for (int m = 0; m < 4; ++m) _Pragma("unroll") for (int n = 0; n < 2; ++n) _Pragma("unroll") for (int k = 0; k < 2; ++k) \
        acc[ai][bj][m][n] = __builtin_amdgcn_mfma_f32_16x16x32_bf16(Bt[n][k], At[m][k], acc[ai][bj][m][n], 0, 0, 0); __builtin_amdgcn_s_setprio(0); } while (0)
#define PG8_WAIT_V(n) asm volatile("s_waitcnt vmcnt(" #n ")" ::: "memory")
#define PG8_WAIT_L(n) asm volatile("s_waitcnt lgkmcnt(" #n ")" ::: "memory")
#define PG8_BAR __builtin_amdgcn_s_barrier()
#define PG8_SCHED __builtin_amdgcn_sched_barrier(0)
    Unit cur, nxt; int ui = 0;
    if (!S.next(0, cur)) return;
    f32x4 acc[2][2][4][2];
#pragma unroll
    for (int a = 0; a < 2; ++a)
#pragma unroll
        for (int b = 0; b < 2; ++b)
#pragma unroll
            for (int m = 0; m < 4; ++m)
#pragma unroll
                for (int n = 0; n < 2; ++n) acc[a][b][m][n] = (f32x4){0.f, 0.f, 0.f, 0.f};
    bf16x8 At[4][2], B0[2][2], B1[2][2];
    const char* cA = (const char*)(cur.sel ? g.A[1] : g.A[0]) + (size_t)cur.pm * tstepA + (size_t)cur.pk * 2; const char* cB = (const char*)(cur.sel ? g.Bt[1] : g.Bt[0]) + (size_t)cur.pn * tstepB + (size_t)cur.pk * 2;
    PG8_STAGE(PG8_SB(0, 0), cB, voffB); PG8_STAGE(PG8_SB(0, 1), cB + hstepB, voffB); PG8_STAGE(PG8_SA(0, 0), cA, voffA); PG8_STAGE(PG8_SA(0, 1), cA + hstepA, voffA);
    if (wr == 1) PG8_BAR;
    PG8_WAIT_V(2); PG8_BAR;
    PG8_STAGE(PG8_SB(1, 0), cB + kstep, voffB); PG8_STAGE(PG8_SA(1, 0), cA + kstep, voffA); PG8_STAGE(PG8_SB(1, 1), cB + hstepB + kstep, voffB);
    PG8_WAIT_V(6); PG8_BAR;
    for (;;) {
        const bool has_next = S.next(ui + 1, nxt);
        const char* nA = has_next ? (const char*)(nxt.sel ? g.A[1] : g.A[0]) + (size_t)nxt.pm * tstepA + (size_t)nxt.pk * 2 : cA; const char* nB = has_next ? (const char*)(nxt.sel ? g.Bt[1] : g.Bt[0]) + (size_t)nxt.pn * tstepB + (size_t)nxt.pk * 2 : cB;
#pragma unroll 1
        for (int t = 0; t < nt; t += 2) {
            const bool last = (t == nt - 2);
            const char* a1 = cA + (size_t)(t + 1) * kstep;
            const char* a2 = last ? nA : cA + (size_t)(t + 2) * kstep; const char* b2 = last ? nB : cB + (size_t)(t + 2) * kstep;
            const char* a3 = a2 + kstep; const char* b3 = b2 + kstep;
            PG8_LDB(B0, 0, 0); PG8_LDB(B1, 0, 1); PG8_SCHED; PG8_LDA(At, 0, 0); PG8_STAGE(PG8_SA(1, 1), a1 + hstepA, voffA);
            PG8_WAIT_V(8); PG8_WAIT_L(0); PG8_BAR; PG8_MMA(0, 0, At, B0); PG8_MMA(0, 1, At, B1); PG8_BAR; PG8_SCHED;
            PG8_LDA(At, 0, 1); PG8_STAGE(PG8_SB(0, 0), b2, voffB); PG8_STAGE(PG8_SB(0, 1), b2 + hstepB, voffB); PG8_STAGE(PG8_SA(0, 0), a2, voffA);
            PG8_WAIT_V(8); PG8_WAIT_L(0); PG8_BAR; PG8_MMA(1, 0, At, B0); PG8_MMA(1, 1, At, B1); PG8_BAR; PG8_SCHED;
            PG8_LDB(B0, 1, 0); PG8_LDB(B1, 1, 1); PG8_SCHED; PG8_LDA(At, 1, 0); PG8_STAGE(PG8_SA(0, 1), a2 + hstepA, voffA);
            PG8_WAIT_V(8); PG8_WAIT_L(0); PG8_BAR; PG8_MMA(0, 0, At, B0); PG8_MMA(0, 1, At, B1); PG8_BAR; PG8_SCHED;
            PG8_LDA(At, 1, 1); PG8_STAGE(PG8_SB(1, 0), b3, voffB); PG8_STAGE(PG8_SB(1, 1), b3 + hstepB, voffB); PG8_STAGE(PG8_SA(1, 0), a3, voffA);
            PG8_WAIT_V(8); PG8_WAIT_L(0); PG8_BAR; PG8_MMA(1, 0, At, B0); PG8_MMA(1, 1, At, B1); PG8_BAR; PG8_SCHED;
        }
        if (wr == 0) PG8_BAR;
        E(acc, cur, wr, wc, fr, fq);
        if (!has_next) break;
#pragma unroll
        for (int a = 0; a < 2; ++a)
#pragma unroll
            for (int b = 0; b < 2; ++b)
#pragma unroll
                for (int m = 0; m < 4; ++m)
#pragma unroll
                    for (int n = 0; n < 2; ++n) acc[a][b][m][n] = (f32x4){0.f, 0.f, 0.f, 0.f};
        cur = nxt; cA = nA; cB = nB; ++ui;
        if (wr == 1) PG8_BAR;
    }
    PG8_WAIT_V(0);
    PG8_BAR;
#undef PG8_SA
#undef PG8_SB
#undef PG8_STAGE
#undef PG8_LDA
#undef PG8_LDB
#undef PG8_MMA
#undef PG8_WAIT_V
#undef PG8_WAIT_L
#undef PG8_BAR
#undef PG8_SCHED
}
}
using pg8::Unit;

#define EPI_ARGS const f32x4 (&acc)[2][2][4][2], const Unit& u, int wr, int wc, int fr, int fq
__device__ __forceinline__ u32x4 pack_v(const f32x4 v0, const f32x4 v1) { u32x4 w; w.x = cvt_pk_bf16(v0[0], v0[1]); w.y = cvt_pk_bf16(v0[2], v0[3]); w.z = cvt_pk_bf16(v1[0], v1[1]); w.w = cvt_pk_bf16(v1[2], v1[3]); return w; }

struct EpiProj {
    static constexpr bool PERM = true;
    bf16_t *gqkv, *z, *gl, *gls, *ckvraw, *cq; float *krraw, *ab;
    __device__ __forceinline__ void operator()(EPI_ARGS) const {
        const int pn = u.pn; bf16_t* base; int pitch;
        if (pn < 6) { base = gqkv + pn * 256; pitch = 1536; } else if (pn < 8) { base = z + (pn - 6) * 256; pitch = 512; }
        else if (pn < 16) { base = (u.pm == 64 ? gls - (size_t)MP * 2048 : gl) + (pn - 8) * 256; pitch = 2048; } else if (pn == 16) { base = ckvraw; pitch = 256; }
        else if (pn == 17) { base = cq; pitch = 384; } else { base = cq + 256; pitch = 384; }
#pragma unroll
        for (int ai = 0; ai < 2; ++ai)
#pragma unroll
            for (int m = 0; m < 4; ++m) { const size_t row = (size_t)u.pm * 256 + ai * 128 + wr * 64 + m * 16 + fr;
#pragma unroll
                for (int bj = 0; bj < 2; ++bj) { const int ct = bj * 128 + wc * 32 + 8 * fq; const f32x4 v0 = acc[ai][bj][m][0], v1 = acc[ai][bj][m][1];
                    if (pn < 18 || bj == 0) { *(u32x4*)(base + row * pitch + ct) = pack_v(v0, v1); }
                    else if (wc == 0) { float* d = krraw + row * 32 + 8 * fq; *(f32x4*)d = v0; *(f32x4*)(d + 4) = v1; }
                    else if (wc == 1 && fq < 2) { float* d = ab + row * 16 + 8 * fq; *(f32x4*)d = v0; *(f32x4*)(d + 4) = v1; }
                } }
    }
};
template <int ACT> struct EpiBf16 {
    static constexpr bool PERM = true;
    bf16_t* O; int ldc;
    __device__ __forceinline__ void operator()(EPI_ARGS) const {
#pragma unroll
        for (int ai = 0; ai < 2; ++ai)
#pragma unroll
            for (int m = 0; m < 4; ++m) { const size_t row = (size_t)u.pm * 256 + ai * 128 + wr * 64 + m * 16 + fr;
#pragma unroll
                for (int bj = 0; bj < 2; ++bj) { const int col = u.pn * 256 + bj * 128 + wc * 32 + 8 * fq; f32x4 v0 = acc[ai][bj][m][0], v1 = acc[ai][bj][m][1];
                    if (ACT == 1) {
#pragma unroll
                        for (int e = 0; e < 4; ++e) { const float a = fmaxf(v0[e], 0.f), b = fmaxf(v1[e], 0.f); v0[e] = a * a; v1[e] = b * b; } }
                    *(u32x4*)(O + row * ldc + col) = pack_v(v0, v1); } }
    }
};
struct EpiK {
    static constexpr bool PERM = true;
    bf16_t* K; const float *gk, *krp, *krs, *krcache;
    __device__ __forceinline__ void operator()(EPI_ARGS) const {
        const int head = u.pn * 4 + wc;
        float g0[8], g1[8], g2[8];
#pragma unroll
        for (int e = 0; e < 8; ++e) { g0[e] = gk[8 * fq + e]; g1[e] = gk[32 + 8 * fq + e]; g2[e] = gk[64 + 8 * fq + e]; }
#pragma unroll
        for (int ai = 0; ai < 2; ++ai) {
            f32x4 r0[4], r1[4];
#pragma unroll
            for (int m = 0; m < 4; ++m) { const int R = u.pm * 256 + ai * 128 + wr * 64 + m * 16 + fr;
                const float* kr;
                if (R < MP) kr = krp + (size_t)R * 32;
                else { const int q = R - MP, s = q / SKV, j = q - s * SKV; kr = j < PAST ? krcache + ((size_t)s * PAST + j) * 32 : krs + ((size_t)s * SS + (j - PAST)) * 32; }
                r0[m] = *(const f32x4*)(kr + 8 * fq); r1[m] = *(const f32x4*)(kr + 8 * fq + 4); }
            asm volatile("" ::: "memory");
#pragma unroll
            for (int m = 0; m < 4; ++m) { const int R = u.pm * 256 + ai * 128 + wr * 64 + m * 16 + fr;
                const f32x4 a0 = acc[ai][0][m][0], a1 = acc[ai][0][m][1], b0 = acc[ai][1][m][0], b1 = acc[ai][1][m][1];
                float ss = 0.f;
#pragma unroll
                for (int e = 0; e < 4; ++e) ss += a0[e] * a0[e] + a1[e] * a1[e] + b0[e] * b0[e] + b1[e] * b1[e] + r0[m][e] * r0[m][e] + r1[m][e] * r1[m][e];
                ss += __shfl_xor(ss, 16); ss += __shfl_xor(ss, 32);
                const float rs = rsqrtf(ss * (1.f / 96.f) + EPS);
                float o0[8], o1[8], o2[8];
#pragma unroll
                for (int e = 0; e < 4; ++e) { o0[e] = a0[e] * rs * g0[e]; o0[4 + e] = a1[e] * rs * g0[4 + e]; o1[e] = b0[e] * rs * g1[e]; o1[4 + e] = b1[e] * rs * g1[4 + e];
                    o2[e] = r0[m][e] * rs * g2[e]; o2[4 + e] = r1[m][e] * rs * g2[4 + e]; }
                size_t krow;
                if (R < MP) krow = ((size_t)(R >> 11) * 8 + head) * SP + (R & 2047);
                else { const int q = R - MP, s = q / SKV, j = q - s * SKV; krow = (size_t)MP * 8 + ((size_t)s * 8 + head) * SKV + j; }
                bf16_t* d = K + krow * 96 + 8 * fq;
                *(u32x4*)d = pack8(o0); *(u32x4*)(d + 32) = pack8(o1); *(u32x4*)(d + 64) = pack8(o2); }
            asm volatile("" ::: "memory");
        }
    }
};
struct EpiVT {
    static constexpr bool PERM = true;
    bf16_t* VT;
    __device__ __forceinline__ void operator()(EPI_ARGS) const {
        size_t coff[2]; int pitch[2];
#pragma unroll
        for (int bj = 0; bj < 2; ++bj) { const int R0 = u.pn * 256 + bj * 128 + wc * 32 + 8 * fq;
            if (R0 < MP) { coff[bj] = (size_t)(R0 >> 11) * 8 * 64 * SP + (R0 & 2047); pitch[bj] = SP; }
            else { const int q = R0 - MP, s = q / SKV, j = q - s * SKV; coff[bj] = VT_SAMPLE_OFF + (size_t)s * 8 * 64 * SKV + j; pitch[bj] = SKV; } }
#pragma unroll
        for (int ai = 0; ai < 2; ++ai)
#pragma unroll
            for (int m = 0; m < 4; ++m) { const int f = u.pm * 256 + ai * 128 + wr * 64 + m * 16 + fr;
#pragma unroll
                for (int bj = 0; bj < 2; ++bj) *(u32x4*)(VT + coff[bj] + (size_t)f * pitch[bj]) = pack_v(acc[ai][bj][m][0], acc[ai][bj][m][1]); }
    }
};
struct EpiGate {
    static constexpr bool PERM = true;
    bf16_t* merged; const bf16_t* gl; const bf16_t* gls;
    __device__ __forceinline__ void operator()(EPI_ARGS) const {
#pragma unroll
        for (int ai = 0; ai < 2; ++ai) {
            u32x4 gw[4][2], tw[4][2];
#pragma unroll
            for (int m = 0; m < 4; ++m) { const size_t row = (size_t)u.pm * 256 + ai * 128 + wr * 64 + m * 16 + fr;
#pragma unroll
                for (int bj = 0; bj < 2; ++bj) { const int col = u.pn * 256 + bj * 128 + wc * 32 + 8 * fq;
                    gw[m][bj] = *(const u32x4*)(gl + row * 2048 + u.sel * 1024 + col);
                    tw[m][bj] = u.sel ? *(const u32x4*)(merged + row * 1024 + col) : (u32x4){0u, 0u, 0u, 0u}; } }
            asm volatile("" ::: "memory");
#pragma unroll
            for (int m = 0; m < 4; ++m) { const size_t row = (size_t)u.pm * 256 + ai * 128 + wr * 64 + m * 16 + fr;
#pragma unroll
                for (int bj = 0; bj < 2; ++bj) { const int col = u.pn * 256 + bj * 128 + wc * 32 + 8 * fq; const f32x4 v0 = acc[ai][bj][m][0], v1 = acc[ai][bj][m][1];
                    const u32x4 g = gw[m][bj], t = tw[m][bj];
                    float o[8];
                    o[0] = sigmoidf_(bflo(g.x)) * v0[0] + bflo(t.x); o[1] = sigmoidf_(bfhi(g.x)) * v0[1] + bfhi(t.x); o[2] = sigmoidf_(bflo(g.y)) * v0[2] + bflo(t.y); o[3] = sigmoidf_(bfhi(g.y)) * v0[3] + bfhi(t.y);
                    o[4] = sigmoidf_(bflo(g.z)) * v1[0] + bflo(t.z); o[5] = sigmoidf_(bfhi(g.z)) * v1[1] + bfhi(t.z); o[6] = sigmoidf_(bflo(g.w)) * v1[2] + bflo(t.w); o[7] = sigmoidf_(bfhi(g.w)) * v1[3] + bfhi(t.w);
                    *(u32x4*)(merged + row * 1024 + col) = pack8(o); } }
            asm volatile("" ::: "memory");
        }
    }
};
struct EpiGateS {
    static constexpr bool PERM = true;
    float* macc; const bf16_t* gls;
    __device__ __forceinline__ void operator()(EPI_ARGS) const {
#pragma unroll
        for (int ai = 0; ai < 2; ++ai) {
            u32x4 gw[4][2];
#pragma unroll
            for (int m = 0; m < 4; ++m) { const size_t r = ai * 128 + wr * 64 + m * 16 + fr;
#pragma unroll
                for (int bj = 0; bj < 2; ++bj) gw[m][bj] = *(const u32x4*)(gls + r * 2048 + u.sel * 1024 + u.pn * 256 + bj * 128 + wc * 32 + 8 * fq); }
            asm volatile("" ::: "memory");
#pragma unroll
            for (int m = 0; m < 4; ++m) { const size_t r = ai * 128 + wr * 64 + m * 16 + fr;
#pragma unroll
                for (int bj = 0; bj < 2; ++bj) { const int col = u.pn * 256 + bj * 128 + wc * 32 + 8 * fq; const f32x4 v0 = acc[ai][bj][m][0], v1 = acc[ai][bj][m][1]; const u32x4 g = gw[m][bj];
                    float* d = macc + (size_t)(u.sel * 2 + (u.pk >> 8)) * (MS * 1024) + r * 1024 + col;
                    *(f32x4*)d = (f32x4){sigmoidf_(bflo(g.x)) * v0[0], sigmoidf_(bfhi(g.x)) * v0[1], sigmoidf_(bflo(g.y)) * v0[2], sigmoidf_(bfhi(g.y)) * v0[3]};
                    *(f32x4*)(d + 4) = (f32x4){sigmoidf_(bflo(g.z)) * v1[0], sigmoidf_(bfhi(g.z)) * v1[1], sigmoidf_(bflo(g.w)) * v1[2], sigmoidf_(bfhi(g.w)) * v1[3]}; } }
            asm volatile("" ::: "memory");
        }
    }
};
struct EpiAtom {
    static constexpr bool PERM = false;
    float* dst; int ld; const float* mod; int goff, klen;
    __device__ __forceinline__ void operator()(EPI_ARGS) const {
#pragma unroll
        for (int ai = 0; ai < 2; ++ai) {
            f32x4 gt[4][2][2];
#pragma unroll
            for (int m = 0; m < 4; ++m) { const int r = ai * 128 + wr * 64 + m * 16 + fr;
#pragma unroll
                for (int bj = 0; bj < 2; ++bj)
#pragma unroll
                    for (int n = 0; n < 2; ++n) gt[m][bj][n] = mod ? *(const f32x4*)(mod + (8 + (r >> 4)) * 6144 + goff + u.pn * 256 + bj * 128 + wc * 32 + 16 * n + 4 * fq) : (f32x4){1.f, 1.f, 1.f, 1.f}; }
            asm volatile("" ::: "memory");
#pragma unroll
            for (int m = 0; m < 4; ++m) { const int r = ai * 128 + wr * 64 + m * 16 + fr;
#pragma unroll
                for (int bj = 0; bj < 2; ++bj)
#pragma unroll
                    for (int n = 0; n < 2; ++n) { const int col = u.pn * 256 + bj * 128 + wc * 32 + 16 * n + 4 * fq;
                        *(f32x4*)(dst + (size_t)(u.pk / klen) * (MS * 1024) + (size_t)r * ld + col) = acc[ai][bj][m][n] * gt[m][bj][n]; } }
            asm volatile("" ::: "memory");
        }
    }
};
template <int NP, int W8  > __device__ __forceinline__ void convert_slice(const float* part, int ld, bf16_t* dst, int k0, int tid) {
#pragma unroll 1
    for (int i0 = tid; i0 < 256 * W8; i0 += 4 * 512) {
        f32x4 v0[4], v1[4];
#pragma unroll
        for (int q = 0; q < 4; ++q) { const int i = i0 + q * 512, r = i / W8, c8 = i % W8; const float* pp = part + (size_t)r * ld + k0 + 8 * c8;
            v0[q] = *(const f32x4*)pp; v1[q] = *(const f32x4*)(pp + 4);
#pragma unroll
            for (int k = 1; k < NP; ++k) { v0[q] += *(const f32x4*)(pp + (size_t)k * 256 * ld); v1[q] += *(const f32x4*)(pp + (size_t)k * 256 * ld + 4); } }
#pragma unroll
        for (int q = 0; q < 4; ++q) { const int i = i0 + q * 512, r = i / W8, c8 = i % W8; *(u32x4*)(dst + (size_t)r * ld + k0 + 8 * c8) = pack_v(v0[q], v1[q]); }
    }
    asm volatile("s_waitcnt vmcnt(0)" ::: "memory");
    __syncthreads();
}
struct EpiRes {
    static constexpr bool PERM = false;
    const float *bp, *bs; float* out; const float* mod; int goff;
    __device__ __forceinline__ void operator()(EPI_ARGS) const {
        const float* gr = mod + (u.pm >> 3) * 6144 + goff + u.pn * 256 + wc * 32 + 4 * fq;
        f32x4 gt[2][2];
#pragma unroll
        for (int bj = 0; bj < 2; ++bj)
#pragma unroll
            for (int n = 0; n < 2; ++n) gt[bj][n] = *(const f32x4*)(gr + bj * 128 + 16 * n);
#pragma unroll
        for (int ai = 0; ai < 2; ++ai) {
            f32x4 b[4][2][2];
#pragma unroll
            for (int m = 0; m < 4; ++m) { const size_t off = (size_t)(u.pm * 256 + ai * 128 + wr * 64 + m * 16 + fr) * 1024 + u.pn * 256 + wc * 32 + 4 * fq;
#pragma unroll
                for (int bj = 0; bj < 2; ++bj)
#pragma unroll
                    for (int n = 0; n < 2; ++n) b[m][bj][n] = *(const f32x4*)(bp + off + bj * 128 + 16 * n); }
            asm volatile("" ::: "memory");
#pragma unroll
            for (int m = 0; m < 4; ++m) { const size_t off = (size_t)(u.pm * 256 + ai * 128 + wr * 64 + m * 16 + fr) * 1024 + u.pn * 256 + wc * 32 + 4 * fq;
#pragma unroll
                for (int bj = 0; bj < 2; ++bj)
#pragma unroll
                    for (int n = 0; n < 2; ++n) *(f32x4*)(out + off + bj * 128 + 16 * n) = b[m][bj][n] + gt[bj][n] * acc[ai][bj][m][n]; }
            asm volatile("" ::: "memory");
        }
    }
};

struct EpiRes1 {
    static constexpr bool PERM = true;
    const float* x; bf16_t* x1b; const float* mod;
    __device__ __forceinline__ void operator()(EPI_ARGS) const {
        const float* gr = mod + (u.pm >> 3) * 6144 + 2048 + u.pn * 256 + wc * 32 + 8 * fq;
        f32x4 gt[2][2];
#pragma unroll
        for (int bj = 0; bj < 2; ++bj) { gt[bj][0] = *(const f32x4*)(gr + bj * 128); gt[bj][1] = *(const f32x4*)(gr + bj * 128 + 4); }
#pragma unroll
        for (int ai = 0; ai < 2; ++ai) {
            f32x4 b[4][2][2];
#pragma unroll
            for (int m = 0; m < 4; ++m) { const size_t off = (size_t)(u.pm * 256 + ai * 128 + wr * 64 + m * 16 + fr) * 1024 + u.pn * 256 + wc * 32 + 8 * fq;
#pragma unroll
                for (int bj = 0; bj < 2; ++bj) { b[m][bj][0] = *(const f32x4*)(x + off + bj * 128); b[m][bj][1] = *(const f32x4*)(x + off + bj * 128 + 4); } }
            asm volatile("" ::: "memory");
#pragma unroll
            for (int m = 0; m < 4; ++m) { const size_t off = (size_t)(u.pm * 256 + ai * 128 + wr * 64 + m * 16 + fr) * 1024 + u.pn * 256 + wc * 32 + 8 * fq;
#pragma unroll
                for (int bj = 0; bj < 2; ++bj) *(u32x4*)(x1b + off + bj * 128) = pack_v(b[m][bj][0] + gt[bj][0] * acc[ai][bj][m][0], b[m][bj][1] + gt[bj][1] * acc[ai][bj][m][1]); }
            asm volatile("" ::: "memory");
        }
    }
};
struct EpiRes2 {
    static constexpr bool PERM = true;
    const bf16_t* x1b; float* out; const float* mod;
    __device__ __forceinline__ void operator()(EPI_ARGS) const {
        const float* gr = mod + (u.pm >> 3) * 6144 + 5120 + u.pn * 256 + wc * 32 + 8 * fq;
        f32x4 gt[2][2];
#pragma unroll
        for (int bj = 0; bj < 2; ++bj) { gt[bj][0] = *(const f32x4*)(gr + bj * 128); gt[bj][1] = *(const f32x4*)(gr + bj * 128 + 4); }
#pragma unroll
        for (int ai = 0; ai < 2; ++ai) {
            u32x4 b[4][2];
#pragma unroll
            for (int m = 0; m < 4; ++m) { const size_t off = (size_t)(u.pm * 256 + ai * 128 + wr * 64 + m * 16 + fr) * 1024 + u.pn * 256 + wc * 32 + 8 * fq;
#pragma unroll
                for (int bj = 0; bj < 2; ++bj) b[m][bj] = *(const u32x4*)(x1b + off + bj * 128); }
#pragma unroll
            for (int m = 0; m < 4; ++m) { const size_t off = (size_t)(u.pm * 256 + ai * 128 + wr * 64 + m * 16 + fr) * 1024 + u.pn * 256 + wc * 32 + 8 * fq;
#pragma unroll
                for (int bj = 0; bj < 2; ++bj) { const u32x4 w = b[m][bj];
                    *(f32x4*)(out + off + bj * 128) = (f32x4){bflo(w.x), bfhi(w.x), bflo(w.y), bfhi(w.y)} + gt[bj][0] * acc[ai][bj][m][0];
                    *(f32x4*)(out + off + bj * 128 + 4) = (f32x4){bflo(w.z), bfhi(w.z), bflo(w.w), bfhi(w.w)} + gt[bj][1] * acc[ai][bj][m][1]; } }
        }
    }
};

struct Args { const float* in[28]; float* out; unsigned char* ws; int ph_lo, ph_hi; };
enum { I_XP = 0, I_XS, I_CP, I_CS, I_CKV, I_CKR, I_ST, I_CONV, I_ADAW, I_ADAB, I_N1G, I_WIN, I_CONVW, I_ALOG, I_DTB, I_GNG, I_WGO, I_QNG, I_WUQ, I_KVNG, I_WUKV,
       I_QHG, I_KHG, I_WMO, I_WO, I_N2G, I_WF1, I_WF2 };

__device__ __forceinline__ int colmap(int which, int n) {
    switch (which) {
    case 0:
        if (n < 2048) return n; if (n < 4096) return 2736 + (n - 2048); if (n < 4352) return 2448 + (n - 4096); if (n < 4736) return 2064 + (n - 4352);
        if (n < 4768) return 2704 + (n - 4736); if (n < 4776) return 2048 + (n - 4768); if (n < 4784) return 2056 + (n - 4776); return -1;
    case 2: { const int pn = n >> 8, bj = (n >> 7) & 1, wc = (n >> 5) & 3, j = n & 31; return (4 * pn + wc) * 128 + bj * 32 + j; }
    case 3: return (n >> 6) * 128 + 64 + (n & 63);
    default: return n;
    }
}
__device__ __forceinline__ void transpose_item(const float* W, int K, int N, bf16_t* WT, LAS float* scr, int nblk, int which, int item, int lane) {
    const int kb = item / nblk, nb = item - kb * nblk, k0 = 64 * kb, n0 = 64 * nb;
    const int cq = lane & 15, rq = lane >> 4;
    const int sc = colmap(which, n0 + 4 * cq);
    f32x4 v[16];
#pragma unroll
    for (int i = 0; i < 16; ++i) v[i] = sc >= 0 ? *(const f32x4*)(W + (size_t)(k0 + rq + 4 * i) * N + sc) : (f32x4){0.f, 0.f, 0.f, 0.f};
#pragma unroll
    for (int i = 0; i < 16; ++i) { LAS float* d = scr + (rq + 4 * i) * 65 + 4 * cq; d[0] = v[i][0]; d[1] = v[i][1]; d[2] = v[i][2]; d[3] = v[i][3]; }
    asm volatile("s_waitcnt lgkmcnt(0)" ::: "memory");
#pragma unroll
    for (int j = 0; j < 8; ++j) { const int q = lane + 64 * j, n = q >> 3, ch = q & 7; const LAS float* sp = scr + (8 * ch) * 65 + n;
        u32x4 o; o.x = cvt_pk_bf16(sp[0 * 65], sp[1 * 65]); o.y = cvt_pk_bf16(sp[2 * 65], sp[3 * 65]); o.z = cvt_pk_bf16(sp[4 * 65], sp[5 * 65]); o.w = cvt_pk_bf16(sp[6 * 65], sp[7 * 65]);
        *(u32x4*)(WT + (size_t)(n0 + n) * K + k0 + 8 * ch) = o; }
    asm volatile("s_waitcnt lgkmcnt(0)" ::: "memory");
}
__device__ __forceinline__ void phase0(const Args& a, LAS unsigned char* lds, int tid, int lane, int wave, unsigned long long& tmid) {
    unsigned char* ws = a.ws;
    for (int idx = blockIdx.x * 512 + tid; idx < SKV * 16; idx += gridDim.x * 512) {
        const int pos = idx >> 4, i = idx & 15;
        const float inv = exp2f(-(float)i * (13.287712379549449f / 16.f));
        const float ang = (float)pos * inv;
        double t = (double)ang * 0.15915494309189535; t -= floor(t);
        const float rev = (float)t;
        ((f32x2*)(ws + WS_ROPE))[idx] = (f32x2){__builtin_amdgcn_cosf(rev), __builtin_amdgcn_sinf(rev)};
    }
    {
        LAS float* sc = (LAS float*)lds;
        LAS float* red = (LAS float*)(lds + 98304);
        { f32x4 cv[12];
#pragma unroll
            for (int q = 0; q < 12; ++q) { const int f = 4 * (tid + 512 * q), r = f >> 10, k = f & 1023; cv[q] = *(const f32x4*)(r < 8 ? a.in[I_CP] + r * 1024 + k : a.in[I_CS] + (r - 8) * 1024 + k); }
#pragma unroll
            for (int q = 0; q < 12; ++q) { const int f = 4 * (tid + 512 * q); *(LAS f32x4*)(sc + f) = (f32x4){siluf_(cv[q][0]), siluf_(cv[q][1]), siluf_(cv[q][2]), siluf_(cv[q][3])}; } }
        __syncthreads();
        for (int cb = blockIdx.x; cb < 256; cb += gridDim.x) {
            const int cl = lane % 24, kh = lane / 24, col = cb * 24 + cl;
            float acc[24];
#pragma unroll
            for (int r = 0; r < 24; ++r) acc[r] = 0.f;
            if (lane < 48) {
                const int kbase = wave * 128 + kh * 64; const float* wp = a.in[I_ADAW] + (size_t)kbase * 6144 + col;
#pragma unroll 1
                for (int kb = 0; kb < 4; ++kb) {
                    float w[16];
#pragma unroll
                    for (int i = 0; i < 16; ++i) w[i] = wp[(size_t)(16 * kb + i) * 6144];
#pragma unroll
                    for (int i4 = 0; i4 < 4; ++i4)
#pragma unroll
                        for (int r = 0; r < 24; ++r) { const f32x4 sv = *(const LAS f32x4*)(sc + r * 1024 + kbase + 16 * kb + 4 * i4);
                            acc[r] += sv[0] * w[4 * i4] + sv[1] * w[4 * i4 + 1] + sv[2] * w[4 * i4 + 2] + sv[3] * w[4 * i4 + 3]; }
                }
            }
#pragma unroll
            for (int r = 0; r < 24; ++r) { float v = acc[r]; const float o = __shfl(v, (lane + 24) & 63); if (lane < 24) red[(wave * 24 + r) * 24 + lane] = v + o; }
            __syncthreads();
            for (int i = tid; i < 24 * 24; i += 512) { const int r = i / 24, cc = i - r * 24; float sum = a.in[I_ADAB][cb * 24 + cc];
#pragma unroll
                for (int w = 0; w < 8; ++w) sum += red[(w * 24 + r) * 24 + cc];
                ((float*)(ws + WS_MOD))[r * 6144 + cb * 24 + cc] = sum; }
            __syncthreads();
        }
    }
    if (PROBE_LP == 3) tmid = __builtin_amdgcn_s_memrealtime();
    LAS float* scr = (LAS float*)(lds + wave * 16640);
    constexpr int N0 = 16 * 76, N1 = 6 * 12, N2 = 4 * 8, N3 = 4 * 8;
    constexpr int NT = N0 + N1 + N2 + N3;
    const int NW = (int)gridDim.x * 8, vw = (int)blockIdx.x * 8 + wave;
#pragma unroll 1
    for (int it0 = vw; it0 < NT * REPK(0); it0 += NW) {
        int it = it0 % NT;
        if (it < N0) { transpose_item(a.in[I_WIN], 1024, NIN, (bf16_t*)(ws + WS_WIN), scr, 76, 0, it, lane); continue; } it -= N0;
        if (it < N1) { transpose_item(a.in[I_WUQ], 384, 768, (bf16_t*)(ws + WS_WUQ), scr, 12, 1, it, lane); continue; } it -= N1;
        if (it < N2) { transpose_item(a.in[I_WUKV], 256, 1024, (bf16_t*)(ws + WS_WUK), scr, 8, 2, it, lane); continue; } it -= N2;
        transpose_item(a.in[I_WUKV], 256, 1024, (bf16_t*)(ws + WS_WUV), scr, 8, 3, it, lane);
    }
}
__device__ __forceinline__ void ffn_weight_transposes(const Args& a, LAS unsigned char* lds, int vw, int NW, int lane, int wave) {
    LAS float* scr = (LAS float*)(lds + wave * 16640);
    constexpr int N4 = 8 * 16, N5 = 8 * 16, N6 = 16 * 16, N7 = 16 * 64, N8 = 64 * 16;
#pragma unroll 1
    for (int it0 = vw; it0 < N4 + N5 + N6 + N7 + N8; it0 += NW) { int it = it0;
        if (it < N4) { transpose_item(a.in[I_WGO], 512, 1024, (bf16_t*)(a.ws + WS_WGO), scr, 16, 1, it, lane); continue; } it -= N4;
        if (it < N5) { transpose_item(a.in[I_WMO], 512, 1024, (bf16_t*)(a.ws + WS_WMO), scr, 16, 1, it, lane); continue; } it -= N5;
        if (it < N6) { transpose_item(a.in[I_WO], 1024, 1024, (bf16_t*)(a.ws + WS_WO), scr, 16, 1, it, lane); continue; } it -= N6;
        if (it < N7) { transpose_item(a.in[I_WF1], 1024, 4096, (bf16_t*)(a.ws + WS_WF1), scr, 64, 1, it, lane); continue; } it -= N7;
        transpose_item(a.in[I_WF2], 4096, 1024, (bf16_t*)(a.ws + WS_WF2), scr, 16, 1, it, lane);
    }
}

__device__ __forceinline__ void norm_load(int r, const float* xp, const float* xs, const float* part, float* ys, int lane, f32x4 (&v)[4]) {
    const float* xr = r < MP ? xp + (size_t)r * 1024 : xs + (size_t)(r - MP) * 1024;
#pragma unroll
    for (int j = 0; j < 4; ++j) {
        if (part && r < MP) { const u32x2 w = *(const u32x2*)((const bf16_t*)xp + (size_t)r * 1024 + 4 * (lane + 64 * j)); v[j] = (f32x4){bflo(w.x), bfhi(w.x), bflo(w.y), bfhi(w.y)}; }
        else v[j] = *(const f32x4*)(xr + 4 * (lane + 64 * j));
        if (part && r >= MP) {
#pragma unroll
            for (int k = 0; k < 8; ++k) v[j] += *(const f32x4*)(part + (size_t)k * (MS * 1024) + (size_t)(r - MP) * 1024 + 4 * (lane + 64 * j));
            *(f32x4*)(ys + (size_t)(r - MP) * 1024 + 4 * (lane + 64 * j)) = v[j]; } }
}
struct NormAux { f32x4 gg[4], sc[4], sh[4]; };
__device__ __forceinline__ void norm_aux(int r, const float* g, const float* mod, int shift_off, int scale_off, int lane, NormAux& x) {
    const float* mr = mod + mod_row(r) * 6144;
#pragma unroll
    for (int j = 0; j < 4; ++j) { const int col = 4 * (lane + 64 * j); x.gg[j] = *(const f32x4*)(g + col); x.sc[j] = *(const f32x4*)(mr + scale_off + col); x.sh[j] = *(const f32x4*)(mr + shift_off + col); }
}
__device__ __forceinline__ void norm_finish(int r, const f32x4 (&v)[4], const NormAux& x, bf16_t* out, int lane) {
    float ss = 0.f;
#pragma unroll
    for (int j = 0; j < 4; ++j) ss += v[j][0] * v[j][0] + v[j][1] * v[j][1] + v[j][2] * v[j][2] + v[j][3] * v[j][3];
    const float rs = rsqrtf(wave_sum(ss) * (1.f / 1024.f) + EPS);
#pragma unroll
    for (int j = 0; j < 4; ++j) { const int col = 4 * (lane + 64 * j);
        const f32x4 y = v[j] * rs * x.gg[j] * (x.sc[j] + 1.f) + x.sh[j];
        u32x2 w; w.x = cvt_pk_bf16(y[0], y[1]); w.y = cvt_pk_bf16(y[2], y[3]);
        *(u32x2*)(out + (size_t)r * 1024 + col) = w; }
}
__device__ __forceinline__ void norm_rows(const float* xp, const float* xs, const float* g, const float* mod, int shift_off, int scale_off, bf16_t* out, int gw, int lane, const float* part, float* ys) {
    for (int r = gw; r < MR; r += 4096) {
        const int r2 = r + 2048; const bool two = r2 < MR;
        f32x4 va[4], vb[4]; NormAux xa, xb;
        norm_load(r, xp, xs, part, ys, lane, va);
        if (two) norm_load(r2, xp, xs, part, ys, lane, vb);
        norm_aux(r, g, mod, shift_off, scale_off, lane, xa);
        if (two) norm_aux(r2, g, mod, shift_off, scale_off, lane, xb);
        norm_finish(r, va, xa, out, lane);
        if (two) norm_finish(r2, vb, xb, out, lane);
    }
}

__device__ __forceinline__ void unpack8(const u32x4 w, float* v) { v[0] = bflo(w.x); v[1] = bfhi(w.x); v[2] = bflo(w.y); v[3] = bfhi(w.y); v[4] = bflo(w.z); v[5] = bfhi(w.z); v[6] = bflo(w.w); v[7] = bfhi(w.w); }
__device__ __forceinline__ void mla_rows(const Args& a, int gw, int ngw, int lane) {
    unsigned char* ws = a.ws; float* out = a.out;
    bf16_t* cq = (bf16_t*)(ws + WS_CQ); const bf16_t* ckvraw = (const bf16_t*)(ws + WS_CKVRAW); const float* krraw = (const float*)(ws + WS_KRRAW);
    bf16_t* ckvrows = (bf16_t*)(ws + WS_CKVROWS); const f32x2* rope = (const f32x2*)(ws + WS_ROPE);
    float gq[8], gk[8];
#pragma unroll
    for (int e = 0; e < 8; ++e) { gq[e] = lane < 48 ? a.in[I_QNG][8 * lane + e] : 0.f; gk[e] = lane < 32 ? a.in[I_KVNG][8 * lane + e] : 0.f; }
    for (int r0 = gw * 4; r0 < MR; r0 += ngw * 4) {
        u32x4 wq[4], wk[4]; float x1[4], x2[4]; f32x2 cs[4];
#pragma unroll
        for (int j = 0; j < 4; ++j) { const int r = r0 + j; const int pos = r < MP ? (r & 2047) : PAST + ((r - MP) & 15);
            wq[j] = lane < 48 ? *(const u32x4*)(cq + (size_t)r * 384 + 8 * lane) : (u32x4){0u, 0u, 0u, 0u};
            wk[j] = lane < 32 ? *(const u32x4*)(ckvraw + (size_t)r * 256 + 8 * lane) : (u32x4){0u, 0u, 0u, 0u};
            x1[j] = krraw[(size_t)r * 32 + (lane & 15)]; x2[j] = krraw[(size_t)r * 32 + 16 + (lane & 15)]; cs[j] = rope[pos * 16 + (lane & 15)]; }
#pragma unroll
        for (int j = 0; j < 4; ++j) { const int r = r0 + j;
            float vq[8], vk[8]; unpack8(wq[j], vq); unpack8(wk[j], vk);
            float sq = 0.f, sk = 0.f;
#pragma unroll
            for (int e = 0; e < 8; ++e) { sq += vq[e] * vq[e]; sk += vk[e] * vk[e]; }
            const float rq = rsqrtf(wave_sum(sq) * (1.f / 384.f) + EPS), rk = rsqrtf(wave_sum(sk) * (1.f / 256.f) + EPS);
            if (lane < 48) {
#pragma unroll
                for (int e = 0; e < 8; ++e) vq[e] = vq[e] * rq * gq[e];
                *(u32x4*)(cq + (size_t)r * 384 + 8 * lane) = pack8(vq); }
            if (lane < 32) {
#pragma unroll
                for (int e = 0; e < 8; ++e) vk[e] = vk[e] * rk * gk[e];
                float* o = r < MP ? out + O_CKVP + (size_t)r * 256 : out + O_CKVS + (size_t)(r - MP) * 256;
                *(f32x4*)(o + 8 * lane) = (f32x4){vk[0], vk[1], vk[2], vk[3]}; *(f32x4*)(o + 8 * lane + 4) = (f32x4){vk[4], vk[5], vk[6], vk[7]};
                const size_t R = r < MP ? (size_t)r : (size_t)MP + (size_t)((r - MP) >> 4) * SKV + PAST + ((r - MP) & 15);
                *(u32x4*)(ckvrows + R * 256 + 8 * lane) = pack8(vk); }
            if (lane < 16) { float* o = r < MP ? out + O_KRP + (size_t)r * 32 : out + O_KRS + (size_t)(r - MP) * 32;
                o[lane] = x1[j] * cs[j].x - x2[j] * cs[j].y; o[16 + lane] = x2[j] * cs[j].x + x1[j] * cs[j].y; }
        }
    }
}

template <int I> struct SolveRow {
    static __device__ __forceinline__ void run(float (&x)[64], const LAS float* A, const LAS bf16_t* src, const LAS float* scp) {
        float s0 = scp[I] * bf2f(src[I * 72]), s1 = 0.f, s2 = 0.f, s3 = 0.f;
#pragma unroll
        for (int j4 = 0; j4 < (I + 3) / 4; ++j4) { const f32x4 av = *(const LAS f32x4*)(A + I * 64 + 4 * j4);
            if (4 * j4 + 0 < I) s0 -= av[0] * x[4 * j4 + 0]; if (4 * j4 + 1 < I) s1 -= av[1] * x[4 * j4 + 1]; if (4 * j4 + 2 < I) s2 -= av[2] * x[4 * j4 + 2]; if (4 * j4 + 3 < I) s3 -= av[3] * x[4 * j4 + 3]; }
        const float s = (s0 + s1) + (s2 + s3);
        x[I] = s;
        SolveRow<I + 1>::run(x, A, src, scp);
    }
};
template <> struct SolveRow<64> { static __device__ __forceinline__ void run(float (&)[64], const LAS float*, const LAS bf16_t*, const LAS float*) {} };

__device__ __forceinline__ void gdn_prep(const Args& a, LAS unsigned char* lds, int tid) {
    const int slot = tid >> 7, w2 = __builtin_amdgcn_readfirstlane((tid >> 6) & 1), lane = tid & 63;
    LAS unsigned char* sl = lds + slot * 35584;
    LAS bf16_t* q_lds = (LAS bf16_t*)sl; LAS float* A_lds = (LAS float*)sl;
    LAS bf16_t* k_lds = (LAS bf16_t*)(sl + 16384); LAS bf16_t* v_lds = (LAS bf16_t*)(sl + 25600);
    LAS float* gcs = (LAS float*)(sl + 34816); LAS float* bts = (LAS float*)(sl + 35072); LAS float* scw = (LAS float*)(sl + 35328);
    const bf16_t* gqkv = (const bf16_t*)(a.ws + WS_GQKV); const float* ab = (const float*)(a.ws + WS_AB); const float* cw = a.in[I_CONVW];
#pragma unroll 1
    for (int qi = blockIdx.x; qi < 512 * REPK(3); qi += gridDim.x) {
        const int item = (qi & 511) * 4 + slot, bh = item >> 5, n = item & 31, b = bh >> 3, h = bh & 7;
        const int r0 = b * SP + 64 * n, t = lane;
        unsigned char* rec = a.ws + WS_PREP + (size_t)item * REC_BYTES;
        LAS float* cwl = (LAS float*)(sl + 9216);
        for (int i = tid & 127; i < 768; i += 128) { const int tap = i / 192, cc = i - tap * 192; cwl[i] = cw[tap * 1536 + (cc >> 6) * 512 + h * 64 + (cc & 63)]; }
        __syncthreads();
        {
            const int cb0 = w2 * 512 + h * 64;
            float o[64];
#pragma unroll
            for (int c = 0; c < 64; ++c) o[c] = 0.f;
#pragma unroll 1
            for (int tap = 0; tap < 4; ++tap) { const int rr = t - 3 + tap; const bool valid = (n > 0) || (rr >= 0);
                const bf16_t* src = gqkv + (size_t)(r0 + (valid ? rr : 0)) * 1536 + cb0;
                u32x4 w[8];
#pragma unroll
                for (int c8 = 0; c8 < 8; ++c8) w[c8] = *(const u32x4*)(src + 8 * c8);
#pragma unroll
                for (int c8 = 0; c8 < 8; ++c8) { if (!valid) w[c8] = (u32x4){0u, 0u, 0u, 0u};
                    const LAS float* wl = cwl + tap * 192 + w2 * 64 + 8 * c8;
                    const f32x4 wa = *(const LAS f32x4*)wl, wb = *(const LAS f32x4*)(wl + 4);
                    o[8 * c8 + 0] += wa[0] * bflo(w[c8].x); o[8 * c8 + 1] += wa[1] * bfhi(w[c8].x); o[8 * c8 + 2] += wa[2] * bflo(w[c8].y); o[8 * c8 + 3] += wa[3] * bfhi(w[c8].y);
                    o[8 * c8 + 4] += wb[0] * bflo(w[c8].z); o[8 * c8 + 5] += wb[1] * bfhi(w[c8].z); o[8 * c8 + 6] += wb[2] * bflo(w[c8].w); o[8 * c8 + 7] += wb[3] * bfhi(w[c8].w); } }
            float ss = 0.f;
#pragma unroll
            for (int c = 0; c < 64; ++c) { o[c] = siluf_(o[c]); ss += o[c] * o[c]; }
            const float sc = rsqrtf(ss + EPS) * (w2 ? 1.f : 0.125f);
            LAS bf16_t* dst = (w2 ? k_lds : q_lds) + t * 72;
#pragma unroll
            for (int c8 = 0; c8 < 8; ++c8) { float v[8];
#pragma unroll
                for (int e = 0; e < 8; ++e) v[e] = o[8 * c8 + e] * sc;
                *(LAS u32x4*)(dst + 8 * c8) = pack8(v); }
        }
        {
            const int cb1 = 1024 + h * 64 + 32 * w2;
            u32x4 w[4][4];
#pragma unroll
            for (int tap = 0; tap < 4; ++tap) { const int rr = t - 3 + tap; const bool valid = (n > 0) || (rr >= 0);
                const bf16_t* src = gqkv + (size_t)(r0 + (valid ? rr : 0)) * 1536 + cb1;
#pragma unroll
                for (int c8 = 0; c8 < 4; ++c8) { w[tap][c8] = *(const u32x4*)(src + 8 * c8); if (!valid) w[tap][c8] = (u32x4){0u, 0u, 0u, 0u}; } }
#pragma unroll
            for (int c8 = 0; c8 < 4; ++c8) { float o[8];
#pragma unroll
                for (int e = 0; e < 8; ++e) o[e] = 0.f;
#pragma unroll
                for (int tap = 0; tap < 4; ++tap) { const LAS float* wl = cwl + tap * 192 + 128 + 32 * w2 + 8 * c8;
                    const f32x4 wa = *(const LAS f32x4*)wl, wb = *(const LAS f32x4*)(wl + 4); const u32x4 x = w[tap][c8];
                    o[0] += wa[0] * bflo(x.x); o[1] += wa[1] * bfhi(x.x); o[2] += wa[2] * bflo(x.y); o[3] += wa[3] * bfhi(x.y);
                    o[4] += wb[0] * bflo(x.z); o[5] += wb[1] * bfhi(x.z); o[6] += wb[2] * bflo(x.w); o[7] += wb[3] * bfhi(x.w); }
#pragma unroll
                for (int e = 0; e < 8; ++e) o[e] = siluf_(o[e]);
                *(LAS u32x4*)(v_lds + t * 72 + 32 * w2 + 8 * c8) = pack8(o); }
        }
        float gc, gcl;
        {
            const float av = ab[(size_t)(r0 + t) * 16 + h], bv = ab[(size_t)(r0 + t) * 16 + 8 + h];
            const float xg = av + a.in[I_DTB][h];
            const float sp = fmaxf(xg, 0.f) + __logf(1.f + __expf(-fabsf(xg)));
            gc = -__expf(a.in[I_ALOG][h]) * sp;
#pragma unroll
            for (int o = 1; o < 64; o <<= 1) { const float u = __shfl_up(gc, o); if (lane >= o) gc += u; }
            gcl = __shfl(gc, 63);
            if (w2 == 0) { const float be = sigmoidf_(bv); gcs[t] = gc; bts[t] = be; scw[t] = be * __expf(gc); if (lane == 0) *(float*)(rec + 40960) = __expf(gcl); }
        }
        __syncthreads();
#pragma unroll
        for (int it = 0; it < 8; ++it) { const int ri = (lane >> 3) + 8 * it, pg = lane & 7, d0 = 32 * (pg >> 2) + 4 * (pg & 3);
            float v[8];
            if (w2 == 0) { const u32x2 w0 = *(const LAS u32x2*)(q_lds + ri * 72 + d0), w1 = *(const LAS u32x2*)(q_lds + ri * 72 + d0 + 16); const float e = __expf(gcs[ri]);
                v[0] = bflo(w0.x) * e; v[1] = bfhi(w0.x) * e; v[2] = bflo(w0.y) * e; v[3] = bfhi(w0.y) * e; v[4] = bflo(w1.x) * e; v[5] = bfhi(w1.x) * e; v[6] = bflo(w1.y) * e; v[7] = bfhi(w1.y) * e;
                *(u32x4*)(rec + 8192 + (ri * 64 + 8 * pg) * 2) = pack8(v); }
            else {
#pragma unroll
                for (int j = 0; j < 8; ++j) { const int c = d0 + 16 * (j >> 2) + (j & 3); v[j] = bf2f(k_lds[c * 72 + ri]) * __expf(gcl - gcs[c]); }
                *(u32x4*)(rec + 24576 + (ri * 64 + 8 * pg) * 2) = pack8(v); } }
        const int m_ = lane & 15, g4 = lane >> 4;
        f32x4 acc[4][4];
        {
            bf16x8 ka[4][2], bb[4][2];
            const LAS bf16_t* bsrc = w2 ? k_lds : q_lds;
#pragma unroll
            for (int jt = 0; jt < 4; ++jt)
#pragma unroll
                for (int ks = 0; ks < 2; ++ks) { ka[jt][ks] = *(const LAS bf16x8*)(k_lds + (16 * jt + m_) * 72 + 32 * ks + 8 * g4); bb[jt][ks] = *(const LAS bf16x8*)(bsrc + (16 * jt + m_) * 72 + 32 * ks + 8 * g4); }
#pragma unroll
            for (int jt = 0; jt < 4; ++jt)
#pragma unroll
                for (int it = 0; it < 4; ++it) { f32x4 c = (f32x4){0.f, 0.f, 0.f, 0.f};
                    if (it >= jt) {
#pragma unroll
                        for (int ks = 0; ks < 2; ++ks) c = __builtin_amdgcn_mfma_f32_16x16x32_bf16(ka[jt][ks], bb[it][ks], c, 0, 0, 0); }
                    acc[jt][it] = c; }
        }
        __syncthreads();
#pragma unroll
        for (int jt = 0; jt < 4; ++jt)
#pragma unroll
            for (int it = 0; it < 4; ++it) { const int i = 16 * it + m_, j0 = 16 * jt + 4 * g4; const float gi = gcs[i]; const f32x4 gj = *(const LAS f32x4*)(gcs + j0);
                float v[4];
                if (w2 == 0) {
#pragma unroll
                    for (int e = 0; e < 4; ++e) { const bool keep = it > jt ? true : (it < jt ? false : m_ >= 4 * g4 + e); v[e] = keep ? acc[jt][it][e] * __expf(keep ? gi - gj[e] : 0.f) : 0.f; }
                    u32x2 w; w.x = cvt_pk_bf16(v[0], v[1]); w.y = cvt_pk_bf16(v[2], v[3]);
                    *(u32x2*)(rec + 16384 + (i * 64 + 32 * (jt >> 1) + 8 * g4 + 4 * (jt & 1)) * 2) = w; }
                else { const float bi = bts[i];
#pragma unroll
                    for (int e = 0; e < 4; ++e) { const bool keep = it > jt ? true : (it < jt ? false : m_ > 4 * g4 + e); v[e] = keep ? bi * acc[jt][it][e] * __expf(keep ? gi - gj[e] : 0.f) : 0.f; }
                    *(LAS f32x4*)(A_lds + i * 64 + j0) = (f32x4){v[0], v[1], v[2], v[3]}; } }
        __syncthreads();
        {
            const LAS bf16_t* src = w2 ? k_lds : v_lds; const LAS float* scp = w2 ? scw : bts;
            float x[64];
            SolveRow<0>::run(x, A_lds, src + lane, scp);
            if (w2 == 0) {
#pragma unroll
                for (int q = 0; q < 8; ++q) *(u32x4*)(rec + 32768 + (lane * 64 + 8 * q) * 2) = pack8(&x[8 * q]);
            } else { const int pinv = (lane & 32) | (((lane >> 2) & 3) << 3) | (((lane >> 4) & 1) << 2) | (lane & 3);
#pragma unroll
                for (int i = 0; i < 64; ++i) *(bf16_t*)(rec + (i * 64 + pinv) * 2) = f2bf(-x[i]); }
        }
        __syncthreads();
    }
}

__device__ __forceinline__ void misc_p3(const Args& a, int gt, int GT) {
    bf16_t* ckvrows = (bf16_t*)(a.ws + WS_CKVROWS); const float* cache = a.in[I_CKV];
    for (int i0 = gt; i0 < BS * PAST * 32; i0 += 4 * GT) {
        f32x4 v0[4], v1[4];
#pragma unroll
        for (int q = 0; q < 4; ++q) { const int i = i0 + q * GT; if (i < BS * PAST * 32) { const int row = i >> 5, c8 = i & 31;
            v0[q] = *(const f32x4*)(cache + (size_t)row * 256 + 8 * c8); v1[q] = *(const f32x4*)(cache + (size_t)row * 256 + 8 * c8 + 4); } }
#pragma unroll
        for (int q = 0; q < 4; ++q) { const int i = i0 + q * GT; if (i < BS * PAST * 32) { const int row = i >> 5, c8 = i & 31, s = row >> 11, j = row & 2047;
            *(u32x4*)(ckvrows + ((size_t)MP + (size_t)s * SKV + j) * 256 + 8 * c8) = pack_v(v0[q], v1[q]); } }
    }
    const bf16_t* gqkv = (const bf16_t*)(a.ws + WS_GQKV);
    for (int i = gt; i < BP * 3 * 1536; i += GT) { const int b = i / 4608, rem = i - b * 4608, r = rem / 1536, c = rem - r * 1536;
        a.out[O_CVP + i] = bf2f(gqkv[(size_t)(b * SP + SP - 3 + r) * 1536 + c]); }
    for (int i = gt; i < BS * 3 * 1536; i += GT) { const int s = i / 4608, rem = i - s * 4608, r = rem / 1536, c = rem - r * 1536;
        a.out[O_CVS + i] = bf2f(gqkv[(size_t)(MP + s * SS + SS - 3 + r) * 1536 + c]); }
}

__device__ __forceinline__ bf16x8 pack_frag(const f32x4 lo, const f32x4 hi) { u32x4 w = pack_v(lo, hi); return __builtin_bit_cast(bf16x8, w); }

__device__ __forceinline__ void scan_prompt(const Args& a, LAS unsigned char* lds, int bh, int tid, int lane, int wave, bool st) {
    const int b = bh >> 3, h = bh & 7;
    const unsigned char* recs = a.ws + WS_PREP + (size_t)bh * 32 * REC_BYTES;
    bf16_t* zo = (bf16_t*)(a.ws + WS_Z) + (size_t)b * SP * 512 + h * 64;
    constexpr int BUF = 46080, OT = 2 * BUF, OTB = 64 * 272, GLO = OT + 2 * OTB;
    LAS float* gls = (LAS float*)(lds + GLO);
    const int n_ = lane & 15, g4 = lane >> 4, dv = 16 * wave + n_;
    const int lt = tid - 256, prow = (lt & 255) >> 3, pc16 = lt & 7;
    f32x4 S[4];
#pragma unroll
    for (int kt = 0; kt < 4; ++kt) S[kt] = (f32x4){0.f, 0.f, 0.f, 0.f};
    u32x4 p[10], pz[2]; float pg = 0.f, gn8[8];
    if (wave >= 4) {
#pragma unroll
        for (int e = 0; e < 8; ++e) gn8[e] = a.in[I_GNG][8 * pc16 + e];
#pragma unroll
        for (int i = 0; i < 10; ++i) p[i] = *(const u32x4*)(recs + (i >> 1) * 8192 + ((i & 1) * 256 + lt) * 16);
        pg = *(const float*)(recs + 40960);
#pragma unroll
        for (int i = 0; i < 10; ++i) *(LAS u32x4*)(lds + (i >> 1) * 9216 + (prow + 32 * (i & 1)) * 144 + pc16 * 16) = p[i];
        if (lt == 0) gls[0] = pg;
#pragma unroll
        for (int i = 0; i < 10; ++i) p[i] = *(const u32x4*)(recs + (size_t)REC_BYTES + (i >> 1) * 8192 + ((i & 1) * 256 + lt) * 16);
        pg = *(const float*)(recs + (size_t)REC_BYTES + 40960);
#pragma unroll
        for (int i = 0; i < 2; ++i) pz[i] = *(const u32x4*)(zo + (size_t)(prow + 32 * i) * 512 + pc16 * 8);
    }
    lds_barrier();
    for (int n = 0; n <= 32; ++n) {
        LAS unsigned char* cur = lds + (n & 1) * BUF;
        if (wave >= 4) {
            if (n + 1 < 32) {
                LAS unsigned char* nxt = lds + ((n + 1) & 1) * BUF;
#pragma unroll
                for (int i = 0; i < 10; ++i) *(LAS u32x4*)(nxt + (i >> 1) * 9216 + (prow + 32 * (i & 1)) * 144 + pc16 * 16) = p[i];
                if (lt == 0) gls[(n + 1) & 1] = pg;
            }
            u32x4 zc[2] = {pz[0], pz[1]};
            if (n + 2 < 32) { const unsigned char* rp = recs + (size_t)(n + 2) * REC_BYTES;
#pragma unroll
                for (int i = 0; i < 10; ++i) p[i] = *(const u32x4*)(rp + (i >> 1) * 8192 + ((i & 1) * 256 + lt) * 16);
                pg = *(const float*)(rp + 40960); }
            if (n < 32) {
#pragma unroll
                for (int i = 0; i < 2; ++i) pz[i] = *(const u32x4*)(zo + (size_t)(64 * n + prow + 32 * i) * 512 + pc16 * 8); }
            if (n >= 1) {
#pragma unroll
                for (int i = 0; i < 2; ++i) { const int r = prow + 32 * i; const LAS float* op = (const LAS float*)(lds + OT + ((n - 1) & 1) * OTB + r * 272) + 8 * pc16;
                    const f32x4 o0 = *(const LAS f32x4*)op, o1 = *(const LAS f32x4*)(op + 4);
                    float ss = o0[0] * o0[0] + o0[1] * o0[1] + o0[2] * o0[2] + o0[3] * o0[3] + o1[0] * o1[0] + o1[1] * o1[1] + o1[2] * o1[2] + o1[3] * o1[3];
                    ss = DPP_ADD(ss, 0xB1); ss = DPP_ADD(ss, 0x4E); ss = DPP_ADD(ss, 0x141);
                    const float rs = rsqrtf(ss * (1.f / 64.f) + EPS);
                    float zf[8], v[8]; unpack8(zc[i], zf);
#pragma unroll
                    for (int e = 0; e < 4; ++e) { v[e] = o0[e] * rs * gn8[e] * siluf_(zf[e]); v[4 + e] = o1[e] * rs * gn8[4 + e] * siluf_(zf[4 + e]); }
                    if (st) *(u32x4*)(zo + (size_t)(64 * (n - 1) + r) * 512 + pc16 * 8) = pack8(v); }
            }
        } else if (n < 32) {
            const float gl = gls[n & 1];
            bf16x8 Bs[2];
            Bs[0] = pack_frag(S[0], S[1]); Bs[1] = pack_frag(S[2], S[3]);
            f32x4 VN[4], O[4];
#pragma unroll
            for (int mt = 0; mt < 4; ++mt) { const u32x2 w = *(const LAS u32x2*)(cur + 4 * 9216 + dv * 144 + (16 * mt + 4 * g4) * 2);
                f32x4 c = (f32x4){bflo(w.x), bfhi(w.x), bflo(w.y), bfhi(w.y)};
#pragma unroll
                for (int ks = 0; ks < 2; ++ks) c = __builtin_amdgcn_mfma_f32_16x16x32_bf16(*(const LAS bf16x8*)(cur + (16 * mt + n_) * 144 + (32 * ks + 8 * g4) * 2), Bs[ks], c, 0, 0, 0);
                VN[mt] = c;
                f32x4 o = (f32x4){0.f, 0.f, 0.f, 0.f};
#pragma unroll
                for (int ks = 0; ks < 2; ++ks) o = __builtin_amdgcn_mfma_f32_16x16x32_bf16(*(const LAS bf16x8*)(cur + 9216 + (16 * mt + n_) * 144 + (32 * ks + 8 * g4) * 2), Bs[ks], o, 0, 0, 0);
                O[mt] = o; }
            bf16x8 Bv[2];
            Bv[0] = pack_frag(VN[0], VN[1]); Bv[1] = pack_frag(VN[2], VN[3]);
#pragma unroll
            for (int mt = 0; mt < 4; ++mt) {
#pragma unroll
                for (int ks = 0; ks < 2; ++ks) O[mt] = __builtin_amdgcn_mfma_f32_16x16x32_bf16(*(const LAS bf16x8*)(cur + 2 * 9216 + (16 * mt + n_) * 144 + (32 * ks + 8 * g4) * 2), Bv[ks], O[mt], 0, 0, 0);
                f32x4 sN = S[mt] * gl;
#pragma unroll
                for (int ks = 0; ks < 2; ++ks) sN = __builtin_amdgcn_mfma_f32_16x16x32_bf16(*(const LAS bf16x8*)(cur + 3 * 9216 + (16 * mt + n_) * 144 + (32 * ks + 8 * g4) * 2), Bv[ks], sN, 0, 0, 0);
                S[mt] = sN; }
#pragma unroll
            for (int mt = 0; mt < 4; ++mt)
#pragma unroll
                for (int e = 0; e < 4; ++e) *((LAS float*)(lds + OT + (n & 1) * OTB + (16 * mt + 4 * g4 + e) * 272) + dv) = O[mt][e];
        }
        lds_barrier();
    }
    if (wave < 4 && st) { float* so = a.out + O_STP + (size_t)bh * 4096;
#pragma unroll
        for (int kt = 0; kt < 4; ++kt)
#pragma unroll
            for (int e = 0; e < 4; ++e) so[(16 * kt + 4 * g4 + e) * 64 + dv] = S[kt][e]; }
}

__device__ __forceinline__ void gdn_sample(const Args& a, LAS unsigned char* lds, int u, int tid, int lane, int wave, bool st) {
    const int s = u >> 3, h = u & 7;
    LAS float* raw = (LAS float*)lds;
    LAS float* qkv = raw + 19 * 192;
    LAS float* gs = qkv + 16 * 192;
    LAS float* pa = gs + 32;
    LAS float* pb = pa + 512;
    LAS float* ol = pb + 512;
    const bf16_t* gqkv = (const bf16_t*)(a.ws + WS_GQKV); const float* ab = (const float*)(a.ws + WS_AB);
    for (int i = tid; i < 19 * 192; i += 512) { const int r = i / 192, cc = i - r * 192, seg = cc >> 6, c = cc & 63, col = seg * 512 + h * 64 + c;
        raw[i] = r < 3 ? a.in[I_CONV][((size_t)s * 3 + r) * 1536 + col] : bf2f(gqkv[(size_t)(MP + s * SS + (r - 3)) * 1536 + col]); }
    if (tid < 16) { const size_t row = (size_t)MP + s * SS + tid; const float av = ab[row * 16 + h], bv = ab[row * 16 + 8 + h];
        const float xg = av + a.in[I_DTB][h]; const float sp = fmaxf(xg, 0.f) + __logf(1.f + __expf(-fabsf(xg)));
        gs[tid] = __expf(-__expf(a.in[I_ALOG][h]) * sp); gs[16 + tid] = sigmoidf_(bv); }
    __syncthreads();
    for (int i = tid; i < 16 * 192; i += 512) { const int t = i / 192, cc = i - t * 192, seg = cc >> 6, c = cc & 63, col = seg * 512 + h * 64 + c;
        float y = 0.f;
#pragma unroll
        for (int tap = 0; tap < 4; ++tap) y += a.in[I_CONVW][tap * 1536 + col] * raw[(t + tap) * 192 + cc];
        qkv[i] = siluf_(y); }
    __syncthreads();
    for (int v = wave; v < 32; v += 8) { const int t = v >> 1, seg = v & 1; const float x = qkv[t * 192 + seg * 64 + lane];
        const float ss = wave_sum(x * x); qkv[t * 192 + seg * 64 + lane] = x * rsqrtf(ss + EPS) * (seg ? 1.f : 0.125f); }
    __syncthreads();
    const int dv = tid & 63, dkg = tid >> 6;
    float S[8];
    const float* s0 = a.in[I_ST] + (size_t)u * 4096;
#pragma unroll
    for (int i = 0; i < 8; ++i) S[i] = s0[(8 * dkg + i) * 64 + dv];
    for (int t = 0; t < 16; ++t) {
        const float eg = gs[t], bt = gs[16 + t];
        const LAS float* qr = qkv + t * 192; const LAS float* kr = qr + 64; const float vv = qr[128 + dv];
        float part = 0.f;
#pragma unroll
        for (int i = 0; i < 8; ++i) { S[i] *= eg; part += kr[8 * dkg + i] * S[i]; }
        pa[dkg * 64 + dv] = part;
        __syncthreads();
        float ks = 0.f;
#pragma unroll
        for (int w = 0; w < 8; ++w) ks += pa[w * 64 + dv];
        const float dl = bt * (vv - ks);
        float po = 0.f;
#pragma unroll
        for (int i = 0; i < 8; ++i) { S[i] += kr[8 * dkg + i] * dl; po += qr[8 * dkg + i] * S[i]; }
        pb[dkg * 64 + dv] = po;
        __syncthreads();
        if (dkg == 0) { float o = 0.f;
#pragma unroll
            for (int w = 0; w < 8; ++w) o += pb[w * 64 + dv];
            ol[t * 64 + dv] = o; }
    }
    __syncthreads();
    float* so = a.out + O_STS + (size_t)u * 4096;
#pragma unroll
    for (int i = 0; i < 8; ++i) if (st) so[(8 * dkg + i) * 64 + dv] = S[i];
    bf16_t* zo = (bf16_t*)(a.ws + WS_Z);
    for (int t = wave; t < 16; t += 8) { const float o = ol[t * 64 + lane]; const float ss = wave_sum(o * o);
        const size_t idx = ((size_t)MP + s * SS + t) * 512 + h * 64 + lane;
        const bf16_t res = f2bf(o * rsqrtf(ss * (1.f / 64.f) + EPS) * a.in[I_GNG][lane] * siluf_(bf2f(zo[idx]))); if (st) zo[idx] = res; }
}

struct AttnWave { int qrow, pos, mylast; bool qvalid; };
__device__ __forceinline__ void attn_unit(const Args& a, LAS unsigned char* lds, const bf16_t* Kb, const bf16_t* VTb, int pitch, int head, int ntiles, int nkeys,
                                          const AttnWave w, float boff, int tid, int lane) {
    const int r = lane & 31, hh = lane >> 5;
    const bf16_t* qraw = (const bf16_t*)(a.ws + WS_QRAW); const f32x2* rope = (const f32x2*)(a.ws + WS_ROPE);
    bf16x8 Qf[6];
    {
        const bf16_t* qp = qraw + (size_t)w.qrow * 768 + head * 96 + 8 * hh;
        float v[6][8]; float ss = 0.f;
#pragma unroll
        for (int s = 0; s < 6; ++s) { const u32x4 u = *(const u32x4*)(qp + 16 * s);
            v[s][0] = bflo(u.x); v[s][1] = bfhi(u.x); v[s][2] = bflo(u.y); v[s][3] = bfhi(u.y); v[s][4] = bflo(u.z); v[s][5] = bfhi(u.z); v[s][6] = bflo(u.w); v[s][7] = bfhi(u.w); }
#pragma unroll
        for (int e = 0; e < 8; ++e) { const f32x2 cs = rope[w.pos * 16 + 8 * hh + e]; const float x1 = v[4][e], x2 = v[5][e]; v[4][e] = x1 * cs.x - x2 * cs.y; v[5][e] = x2 * cs.x + x1 * cs.y; }
#pragma unroll
        for (int s = 0; s < 6; ++s)
#pragma unroll
            for (int e = 0; e < 8; ++e) ss += v[s][e] * v[s][e];
        ss += __shfl_xor(ss, 32);
        const float rs = rsqrtf(ss * (1.f / 96.f) + EPS) * (1.4426950408889634f * 0.10206207261596575f);
#pragma unroll
        for (int s = 0; s < 6; ++s) { float o[8];
#pragma unroll
            for (int e = 0; e < 8; ++e) o[e] = v[s][e] * rs * a.in[I_QHG][16 * s + 8 * hh + e];
            Qf[s] = __builtin_bit_cast(bf16x8, pack8(o)); }
    }
    const int kp0row = tid / 12, kp0c = tid - kp0row * 12, kp1row = (tid + 512) / 12, kp1c = (tid + 512) - kp1row * 12, vrow = tid >> 3, vc = tid & 7;
    const int pr = (r & 19) | ((r & 4) << 1) | ((r & 8) >> 1);
    constexpr int TB = 22528;
    f32x16 oa[2], sa[2];
#pragma unroll
    for (int i = 0; i < 16; ++i) { oa[0][i] = 0.f; oa[1][i] = 0.f; sa[0][i] = 0.f; sa[1][i] = 0.f; }
    float lsum = 0.f;
    u32x4 k0, k1, vv;
#define ATT_LOAD(T) do { const bf16_t* kn_ = Kb + (size_t)(T) * 64 * 96; k0 = *(const u32x4*)(kn_ + (size_t)kp0row * 96 + kp0c * 8); if (tid < 256) k1 = *(const u32x4*)(kn_ + (size_t)kp1row * 96 + kp1c * 8); \
        vv = *(const u32x4*)(VTb + (size_t)vrow * pitch + (T) * 64 + vc * 8); } while (0)
#define ATT_PARK(B) do { LAS unsigned char* b_ = lds + (B) * TB; *(LAS u32x4*)(b_ + kp0row * 208 + kp0c * 16) = k0; if (tid < 256) *(LAS u32x4*)(b_ + kp1row * 208 + kp1c * 16) = k1; \
        *(LAS u32x4*)(b_ + 13312 + vrow * 144 + vc * 16) = vv; } while (0)
#define ATT_QK(B, ACC) do { LAS unsigned char* b_ = lds + (B) * TB; _Pragma("unroll") for (int t2 = 0; t2 < 2; ++t2) { _Pragma("unroll") for (int i = 0; i < 16; ++i) ACC[t2][i] = -boff; \
        _Pragma("unroll") for (int s_ = 0; s_ < 6; ++s_) ACC[t2] = __builtin_amdgcn_mfma_f32_32x32x16_bf16(*(const LAS bf16x8*)(b_ + (32 * t2 + pr) * 208 + (16 * s_ + 8 * hh) * 2), Qf[s_], ACC[t2], 0, 0, 0); } } while (0)
    ATT_LOAD(0); ATT_PARK(0);
    if (ntiles > 1) { ATT_LOAD(1); ATT_PARK(1); }
    if (ntiles > 2) ATT_LOAD(2);
    __syncthreads();
    if (w.mylast >= 0) ATT_QK(0, sa);
    for (int kt = 0; kt < ntiles; ++kt) {
        const int bcur = kt % 3, bnx = (kt + 1) % 3, bwr = (kt + 2) % 3;
        const int key0 = kt * 64;
        if (kt + 2 < ntiles) ATT_PARK(bwr);
        if (kt + 3 < ntiles) ATT_LOAD(kt + 3);
        if (kt <= w.mylast) {
            f32x16 sn[2];
            const bool more = kt + 1 <= w.mylast;
            if (more) ATT_QK(bnx, sn);
            const bool tail = key0 + 64 > nkeys;
            bf16x8 Pf[2][2];
#pragma unroll
            for (int t2 = 0; t2 < 2; ++t2) { float p[16];
#pragma unroll
                for (int jj = 0; jj < 16; ++jj) { float e = __builtin_amdgcn_exp2f(sa[t2][jj]);
                    if (tail) { const int key = key0 + 32 * t2 + (jj & 3) + 4 * ((jj >> 2) & 1) + 8 * hh + 16 * (jj >> 3); if (key >= nkeys) e = 0.f; }
                    p[jj] = e; lsum += e; }
                Pf[t2][0] = __builtin_bit_cast(bf16x8, pack8(&p[0])); Pf[t2][1] = __builtin_bit_cast(bf16x8, pack8(&p[8])); }
            LAS unsigned char* cur = lds + bcur * TB;
#pragma unroll
            for (int mt = 0; mt < 2; ++mt)
#pragma unroll
                for (int t2 = 0; t2 < 2; ++t2)
#pragma unroll
                    for (int s2 = 0; s2 < 2; ++s2)
                        oa[mt] = __builtin_amdgcn_mfma_f32_32x32x16_bf16(*(const LAS bf16x8*)(cur + 13312 + (32 * mt + r) * 144 + (32 * t2 + 16 * s2 + 8 * hh) * 2), Pf[t2][s2], oa[mt], 0, 0, 0);
            if (more) { sa[0] = sn[0]; sa[1] = sn[1]; }
        }
        lds_barrier();
    }
#undef ATT_LOAD
#undef ATT_PARK
#undef ATT_QK
    lsum += __shfl_xor(lsum, 32);
    if (w.qvalid && w.mylast >= 0) { const float inv = 1.f / lsum; bf16_t* op = (bf16_t*)(a.ws + WS_OMLA) + (size_t)w.qrow * 512 + head * 64 + 4 * hh;
#pragma unroll
        for (int mt = 0; mt < 2; ++mt)
#pragma unroll
            for (int q4 = 0; q4 < 4; ++q4) { u32x2 o; o.x = cvt_pk_bf16(oa[mt][4 * q4] * inv, oa[mt][4 * q4 + 1] * inv); o.y = cvt_pk_bf16(oa[mt][4 * q4 + 2] * inv, oa[mt][4 * q4 + 3] * inv);
                *(u32x2*)(op + 32 * mt + 8 * q4) = o; } }
}
__device__ __forceinline__ void attn_phase(const Args& a, LAS unsigned char* lds, int tid, int lane, int wave) {
    const int c = blockIdx.x, G = gridDim.x;
    float mq = fabsf(a.in[I_QHG][lane]), mk = fabsf(a.in[I_KHG][lane]);
    if (lane < 32) { mq = fmaxf(mq, fabsf(a.in[I_QHG][64 + lane])); mk = fmaxf(mk, fabsf(a.in[I_KHG][64 + lane])); }
    const float boff = 9.797958971132712f * wave_max(mq) * wave_max(mk) * 1.4426950408889634f;
    const bf16_t* Kbuf = (const bf16_t*)(a.ws + WS_KBUF); const bf16_t* VT = (const bf16_t*)(a.ws + WS_VT);
#pragma unroll 1
    for (int rep = 0; rep < REPK(6); ++rep) {
    const int vc = (G % 8 == 0) ? (c % 8) * (G / 8) + c / 8 : c;
    for (int p = vc; p < 256; p += G) { const int bh = p >> 2, b = bh >> 3, h = bh & 7;
#pragma unroll 1
        for (int half = 0; half < 2; ++half) { const int qb = half ? ((p & 3) ^ 2) : 7 - (p & 3);
            AttnWave w; w.pos = 256 * qb + 32 * wave + (lane & 31); w.qrow = b * SP + w.pos; w.mylast = 4 * qb + (wave >> 1); w.qvalid = true;
            attn_unit(a, lds, Kbuf + (size_t)bh * SP * 96, VT + (size_t)bh * 64 * SP, SP, h, 4 * qb + 4, SP, w, boff, tid, lane); } }
    for (int p = vc; p < 256; p += G) if (p & 2) { const int u = (p >> 2) * 2 + (p & 1), s = u >> 3, h = u & 7;
        AttnWave w; w.pos = PAST + (lane & 15); w.qrow = MP + s * SS + (lane & 15); w.mylast = wave == 0 ? 32 : -1; w.qvalid = (lane & 31) < 16;
        attn_unit(a, lds, Kbuf + ((size_t)MP * 8 + (size_t)u * SKV) * 96, VT + VT_SAMPLE_OFF + (size_t)u * 64 * SKV, SKV, h, 33, SKV, w, boff, tid, lane); }
    }
}

#define XB_TMO      128
#define XB_XCNT(j)  (256  + 64 * (j))
#define XB_XSUB(j)  (1280 + 64 * (j))
#define XB_XGEN(j)  (2304 + 64 * (j))
#define XB_TOP      3328
#define XB_TOPGEN   3392
#define XCD_BAR_WORDS 3456
#define XB_SPIN_CAP (1u << 18)

__device__ __forceinline__ unsigned xb_ld(unsigned* p)              { return __hip_atomic_load(p, __ATOMIC_RELAXED, __HIP_MEMORY_SCOPE_AGENT); }
__device__ __forceinline__ unsigned xb_add(unsigned* p, unsigned v) { return __hip_atomic_fetch_add(p, v, __ATOMIC_RELAXED, __HIP_MEMORY_SCOPE_AGENT); }
__device__ __forceinline__ unsigned xb_xcc_id() { return (unsigned)__builtin_amdgcn_s_getreg((3 << 11) | 20) & 0xFu; }
#define XB_SPIN(cond, bar) do { unsigned _sp = 0; while (cond) { __builtin_amdgcn_s_sleep(1); \
    if ((++_sp & 255u) == 0u) { if (xb_ld(&(bar)[XB_TMO])) break; if (_sp > XB_SPIN_CAP) { atomicAdd(&(bar)[XB_TMO], 1u); break; } } } } while (0)

struct XcdBarrier {
    unsigned* bar; unsigned x;
    volatile LAS unsigned* st;
};

__device__ __forceinline__ XcdBarrier xcd_barrier_post(unsigned* bar, volatile LAS unsigned* st) {
    XcdBarrier b; b.bar = bar; b.x = xb_xcc_id(); b.st = st;
    if (threadIdx.x == 0) (void)xb_add(&bar[XB_XCNT(b.x)], 1u);
    return b;
}
__device__ __forceinline__ void xcd_barrier_complete(unsigned* bar, unsigned x, unsigned& nloc, unsigned& nx) {
    const unsigned G = gridDim.x * gridDim.y * gridDim.z;
    unsigned sum, cnt, mine, sp = 0u;
    for (;;) {
        sum = 0u; cnt = 0u; mine = 0u;
#pragma unroll
        for (unsigned j = 0; j < 16; ++j) { const unsigned c = xb_ld(&bar[XB_XCNT(j)]); sum += c; cnt += (c > 0u) ? 1u : 0u; mine = (j == x) ? c : mine; }
        if (sum == G) break;
        __builtin_amdgcn_s_sleep(1);
        if ((++sp & 255u) == 0u) { if (xb_ld(&bar[XB_TMO])) break; if (sp > XB_SPIN_CAP) { atomicAdd(&bar[XB_TMO], 1u); break; } }
    }
    nloc = mine > 0u ? mine : 1u; nx = cnt > 0u ? cnt : 1u;
}

__device__ __forceinline__ void xcd_barrier(const XcdBarrier& b) {
    asm volatile("s_waitcnt vmcnt(0)" ::: "memory");
    __syncthreads();
    if (threadIdx.x == 0) {
        unsigned* bar = b.bar;
        __builtin_amdgcn_s_waitcnt(0);
        unsigned nloc = b.st[0], nx = b.st[1];
        if (nloc == 0u) { xcd_barrier_complete(bar, b.x, nloc, nx); b.st[0] = nloc; b.st[1] = nx; }
        const unsigned old = xb_add(&bar[XB_XSUB(b.x)], 1u);
        const unsigned gen = old / nloc;
        if (old + 1u == (gen + 1u) * nloc) {
            __builtin_amdgcn_fence(__ATOMIC_RELEASE, "agent");
            asm volatile("s_waitcnt vmcnt(0)" ::: "memory");
            const unsigned og = xb_add(&bar[XB_TOP], 1u);
            const unsigned tg = og / nx;
            if (og + 1u == (tg + 1u) * nx) xb_add(&bar[XB_TOPGEN], 1u);
            else XB_SPIN(xb_ld(&bar[XB_TOPGEN]) == tg, bar);
            __builtin_amdgcn_fence(__ATOMIC_ACQUIRE, "agent");
            xb_add(&bar[XB_XGEN(b.x)], 1u);
            asm volatile("s_waitcnt vmcnt(0)" ::: "memory");
        } else {
            XB_SPIN(xb_ld(&bar[XB_XGEN(b.x)]) == gen, bar);
            __builtin_amdgcn_fence(__ATOMIC_ACQUIRE, "agent");
            asm volatile("s_waitcnt vmcnt(0)" ::: "memory");
        }
    }
    __syncthreads();
}


__global__ void __launch_bounds__(512, 2) mk_fwd(Args a) {
    extern __shared__ __attribute__((aligned(16))) unsigned char lds_raw[];
    LAS unsigned char* lds = (LAS unsigned char*)lds_raw;
    const int tid = threadIdx.x, lane = tid & 63, wave = __builtin_amdgcn_readfirstlane(tid >> 6);
    const int c = blockIdx.x, G = gridDim.x, gw = c * 8 + wave;
    unsigned char* ws = a.ws;
    volatile LAS unsigned* bst = (volatile LAS unsigned*)(lds + 147456);
    if (tid < 16) bst[tid] = 0u;
    __syncthreads();
    XcdBarrier xbar = xcd_barrier_post((unsigned*)(ws + WS_CTL) + CW_BAR, bst);
    const int lo = a.ph_lo, hi = a.ph_hi;
    if (hi > 4096) cg::this_grid().sync();
#define IN(k) (((MK_PHMASK >> (k)) & 1) && lo <= (k) && (k) < hi)
#if MK_SPLIT
#define SEAM(k) do { } while (0)
#else
#define SEAM(k) do { if (IN(k) && IN((k) + 1)) xcd_barrier(xbar); if (PROBE_A >= 0) { const unsigned long long now_ = __builtin_amdgcn_s_memrealtime(); \
        if ((k) == PROBE_A - 1) tA0 = now_; if ((k) == PROBE_A) tA1 = now_; if ((k) == PROBE_B - 1) tB0 = now_; if ((k) == PROBE_B) tB1 = now_; } } while (0)
#endif
    const bf16_t* H = (const bf16_t*)(ws + WS_H);
    float* mod = (float*)(ws + WS_MOD);
    unsigned long long tA0 = 0, tA1 = 0, tB0 = 0, tB1 = 0;
    if (PROBE_A >= 0) { tA0 = tB0 = __builtin_amdgcn_s_memrealtime(); }
    unsigned long long lp0 = 0, lp1 = 0, lp2 = 0;
    if (PROBE_LP == 3) lp0 = __builtin_amdgcn_s_memrealtime();
    if (IN(0)) phase0(a, lds, tid, lane, wave, lp1);
    if (PROBE_LP == 3) { asm volatile("s_waitcnt vmcnt(0)" ::: "memory"); lp2 = __builtin_amdgcn_s_memrealtime(); }
    SEAM(0);
#if MK_XSYNC && !MK_SPLIT
#pragma unroll 1
    for (int x = 0; x < MK_XSYNC; ++x) cg::this_grid().sync();
#endif
    if (IN(1)) norm_rows(a.in[I_XP], a.in[I_XS], a.in[I_N1G], mod, 0, 1024, (bf16_t*)(ws + WS_H), gw, lane, nullptr, nullptr);
    SEAM(1);
    if (IN(2)) { pg8::Gemm g{{H, H}, {(const bf16_t*)(ws + WS_WIN), nullptr}, 1024, 1024, 1024}; pg8::StaticOrder S; S.init(MR / 256, NINP / 256, G, c, REPK(2));
        EpiProj E{(bf16_t*)(ws + WS_GQKV), (bf16_t*)(ws + WS_Z), (bf16_t*)a.out, (bf16_t*)(ws + WS_GLS), (bf16_t*)(ws + WS_CKVRAW), (bf16_t*)(ws + WS_CQ), (float*)(ws + WS_KRRAW), (float*)(ws + WS_AB)};
        pg8::gemm_phase(lds, g, S, E); }
    SEAM(2);
    if (IN(3)) { gdn_prep(a, lds, tid); if (G <= 64) { mla_rows(a, gw, G * 8, lane); misc_p3(a, c * 512 + tid, G * 512); } }
    SEAM(3);
    if (IN(4)) {
        if (PROBE_LP == 1 || PROBE_LP == 2) lp0 = __builtin_amdgcn_s_memrealtime();
#pragma unroll 1
        for (int rep = REPK(4) - 1; rep >= 0; --rep) for (int u = c; u < 192; u += G) { if (u < 64) scan_prompt(a, lds, u, tid, lane, wave, rep == 0); else gdn_sample(a, lds, u - 64, tid, lane, wave, rep == 0); __syncthreads(); }
        if (PROBE_LP == 1 && c == 64) { lp1 = __builtin_amdgcn_s_memrealtime(); }
        if (PROBE_LP == 2 && c == 0) { lp1 = __builtin_amdgcn_s_memrealtime(); }
        if (G > 64 && c >= 64) { mla_rows(a, (c - 64) * 8 + wave, (G - 64) * 8, lane); misc_p3(a, (c - 64) * 512 + tid, (G - 64) * 512); __syncthreads(); ffn_weight_transposes(a, lds, (c - 64) * 8 + wave, (G - 64) * 8, lane, wave); }
        else if (G <= 64) ffn_weight_transposes(a, lds, c * 8 + wave, G * 8, lane, wave);
        if (PROBE_LP == 1 && c == 64) { asm volatile("s_waitcnt vmcnt(0)" ::: "memory"); lp2 = __builtin_amdgcn_s_memrealtime(); } }
    SEAM(4);
    if (PROBE_LP == 2 && c == 0) lp2 = __builtin_amdgcn_s_memrealtime();
    if (IN(5)) {
        { pg8::Gemm g{{(const bf16_t*)(ws + WS_CQ), nullptr}, {(const bf16_t*)(ws + WS_WUQ), nullptr}, 384, 384, 384}; pg8::StaticOrder S; S.init(MR / 256, 3, G, c, REPK(5));
          EpiBf16<0> E{(bf16_t*)(ws + WS_QRAW), 768}; pg8::gemm_phase(lds, g, S, E); }
        { pg8::Gemm g{{(const bf16_t*)(ws + WS_CKVROWS), nullptr}, {(const bf16_t*)(ws + WS_WUK), nullptr}, 256, 256, 256}; pg8::StaticOrder S; S.init(KR / 256, 2, G, (c + G - 195 % G) % G, REPK(5));
          EpiK E{(bf16_t*)(ws + WS_KBUF), a.in[I_KHG], a.out + O_KRP, a.out + O_KRS, a.in[I_CKR]}; pg8::gemm_phase(lds, g, S, E); }
        { pg8::Gemm g{{(const bf16_t*)(ws + WS_WUV), nullptr}, {(const bf16_t*)(ws + WS_CKVROWS), nullptr}, 256, 256, 256}; pg8::StaticOrder S; S.init(2, KR / 256, G, (c + G - 69 % G) % G, REPK(5));
          EpiVT E{(bf16_t*)(ws + WS_VT)}; pg8::gemm_phase(lds, g, S, E); }
    }
    SEAM(5);
    if (IN(6)) attn_phase(a, lds, tid, lane, wave);
    SEAM(6);
    if (IN(7)) { pg8::Gemm g{{(const bf16_t*)(ws + WS_Z), (const bf16_t*)(ws + WS_OMLA)}, {(const bf16_t*)(ws + WS_WGO), (const bf16_t*)(ws + WS_WMO)}, 512, 512, 512};
        pg8::DualOrder S; S.S.init(MP / 256, 4, G, c, REPK(7)); EpiGate E{(bf16_t*)(ws + WS_MERGED), (const bf16_t*)a.out, (const bf16_t*)(ws + WS_GLS)};
        if (PROBE_LP == 5) lp0 = __builtin_amdgcn_s_memrealtime();
        pg8::gemm_phase(lds, g, S, E);
        if (PROBE_LP == 5) { asm volatile("s_waitcnt vmcnt(0)" ::: "memory"); lp1 = __builtin_amdgcn_s_memrealtime(); }
    }
    SEAM(7);
    if (PROBE_LP == 5) lp2 = __builtin_amdgcn_s_memrealtime();
    if (IN(8)) {
        unsigned* hcnt = (unsigned*)(ws + WS_CTL) + 8192;
        {
            pg8::Gemm gs{{(const bf16_t*)(ws + WS_Z), (const bf16_t*)(ws + WS_OMLA)}, {(const bf16_t*)(ws + WS_WGO), (const bf16_t*)(ws + WS_WMO)}, 512, 512, 256};
            pg8::PieceOrder P{4, 2, G, c, 16, 16, 256, 4}; EpiGateS Es{(float*)(ws + WS_PART7), (const bf16_t*)(ws + WS_GLS)}; Unit pu;
            if (P.next(0, pu)) { pg8::gemm_phase(lds, gs, P, Es);
                if (tid == 0) { __builtin_amdgcn_fence(__ATOMIC_RELEASE, "agent"); asm volatile("s_waitcnt vmcnt(0)" ::: "memory");
                    __hip_atomic_fetch_add(hcnt, 1u, __ATOMIC_RELAXED, __HIP_MEMORY_SCOPE_AGENT); } }
        }
        pg8::Gemm g{{(const bf16_t*)(ws + WS_MERGED), nullptr}, {(const bf16_t*)(ws + WS_WO), nullptr}, 1024, 1024, 1024}; pg8::StaticOrder S; S.init(MP / 256, 4, G, c, REPK(8));
        if (PROBE_LP == 4) lp0 = __builtin_amdgcn_s_memrealtime();
        EpiRes1 E{a.in[I_XP], (bf16_t*)(ws + WS_X1B), mod}; pg8::gemm_phase(lds, g, S, E);
        if (PROBE_LP == 4) { asm volatile("s_waitcnt vmcnt(0)" ::: "memory"); lp1 = __builtin_amdgcn_s_memrealtime(); }
        pg8::PieceOrder P{4, 8, G, c, 8, 32, 128, 0}; Unit pu;
        if (P.next(0, pu)) {
            if (tid == 0) { unsigned spins = 0; while (__hip_atomic_load(hcnt, __ATOMIC_RELAXED, __HIP_MEMORY_SCOPE_AGENT) < 16u && ++spins < (1u << 22)) __builtin_amdgcn_s_sleep(2);
                __builtin_amdgcn_fence(__ATOMIC_ACQUIRE, "agent"); asm volatile("s_waitcnt vmcnt(0)" ::: "memory"); }
            __syncthreads(); }
        if (P.next(0, pu)) convert_slice<4, 16>((const float*)(ws + WS_PART7), 1024, (bf16_t*)(ws + WS_MERGED) + (size_t)MP * 1024, pu.pk, tid);
        pg8::Gemm gs{{(const bf16_t*)(ws + WS_MERGED), nullptr}, {(const bf16_t*)(ws + WS_WO), nullptr}, 1024, 1024, 128}; EpiAtom Es{(float*)(ws + WS_PART8), 1024, mod, 2048, 128}; pg8::gemm_phase(lds, gs, P, Es); }
    SEAM(8);
    if (PROBE_LP == 4) lp2 = __builtin_amdgcn_s_memrealtime();
    if (IN(9)) norm_rows((const float*)(ws + WS_X1B), a.in[I_XS], a.in[I_N2G], mod, 3072, 4096, (bf16_t*)(ws + WS_H), gw, lane, (const float*)(ws + WS_PART8), a.out + (size_t)MP * 1024);
    SEAM(9);
    if (IN(10)) { pg8::Gemm g{{H, nullptr}, {(const bf16_t*)(ws + WS_WF1), nullptr}, 1024, 1024, 1024}; pg8::StaticOrder S; S.init(MR / 256, 16, G, c, REPK(10));
        EpiBf16<1> E{(bf16_t*)(ws + WS_HID), DFF}; pg8::gemm_phase(lds, g, S, E); }
    SEAM(10);
    if (IN(11)) { pg8::Gemm g{{(const bf16_t*)(ws + WS_HID), nullptr}, {(const bf16_t*)(ws + WS_WF2), nullptr}, DFF, DFF, DFF}; pg8::StaticOrder S; S.init(MP / 256, 4, G, c);
        EpiRes2 E{(const bf16_t*)(ws + WS_X1B), a.out, mod}; pg8::gemm_phase(lds, g, S, E);
        pg8::PieceOrder P{4, 16, G, c, 4, 64, 256, 0};
        pg8::Gemm gs{{(const bf16_t*)(ws + WS_HID), nullptr}, {(const bf16_t*)(ws + WS_WF2), nullptr}, DFF, DFF, 256}; EpiAtom Es{(float*)(ws + WS_PART11), 1024, mod, 5120, 256}; pg8::gemm_phase(lds, gs, P, Es); }
    SEAM(11);
    if (IN(12)) {
        for (int i = c * 512 + tid; i < MS * 256; i += G * 512) { f32x4 v = ((const f32x4*)(a.out + (size_t)MP * 1024))[i];
#pragma unroll
            for (int k = 0; k < 16; ++k) v += ((const f32x4*)(ws + WS_PART11))[(size_t)k * (MS * 256) + i];
            ((f32x4*)(a.out + (size_t)MP * 1024))[i] = v; } }
    if (PROBE_LP && c == (PROBE_LP == 1 ? 64 : (PROBE_LP == 3 ? 8 : ((PROBE_LP == 4 || PROBE_LP == 5) ? 1 : 0))) && tid == 0) {
        const unsigned long long dA = ((lp1 - lp0) + 400) / 800, dB = ((lp2 - lp1) + 400) / 800;
        const unsigned long long wait = ((dA > 63 ? 63 : dA) + 64 * (dB > 63 ? 63 : dB)) * 3200ull, t0 = __builtin_amdgcn_s_memrealtime();
        while (__builtin_amdgcn_s_memrealtime() - t0 < wait) __builtin_amdgcn_s_sleep(32);
    }
    if (PROBE_A >= 0 && c == 0 && tid == 0) {
        const unsigned long long dA = ((tA1 - tA0) + 400) / 800, dB = PROBE_B >= 0 ? ((tB1 - tB0) + 400) / 800 : 0;
        const unsigned long long wait = ((dA > 63 ? 63 : dA) + 64 * (dB > 63 ? 63 : dB)) * 3200ull, t0 = __builtin_amdgcn_s_memrealtime();
        while (__builtin_amdgcn_s_memrealtime() - t0 < wait) __builtin_amdgcn_s_sleep(32);
    }
#undef IN
#undef SEAM
}

extern "C" void kernel_launch(void* const* d_in, const int* in_sizes, int n_in, void* d_out, int out_size, void* d_ws, size_t ws_size, hipStream_t stream) {
    static int grid = 0;
    if (grid == 0) {
        int dev = 0, cus = 0, per_cu = 0;
        hipGetDevice(&dev); hipDeviceGetAttribute(&cus, hipDeviceAttributeMultiprocessorCount, dev);
        hipFuncSetAttribute((const void*)mk_fwd, hipFuncAttributeMaxDynamicSharedMemorySize, LDS_BYTES);
        hipOccupancyMaxActiveBlocksPerMultiprocessor(&per_cu, (const void*)mk_fwd, 512, LDS_BYTES);
        if (per_cu < 1) per_cu = 1;
        grid = cus * per_cu; if (grid > 256) grid = 256;
        (void)hipGetLastError();
    }
    hipMemsetAsync((char*)d_ws + WS_CTL, 0, 64 * KiB, stream);
    Args a{};
    for (int i = 0; i < 28; ++i) a.in[i] = (const float*)d_in[i];
    a.out = (float*)d_out; a.ws = (unsigned char*)d_ws;
#if MK_SPLIT
    for (int p = 0; p < NPHASE; ++p) { a.ph_lo = p; a.ph_hi = p + 1; hipLaunchKernelGGL(mk_fwd, dim3(grid), dim3(512), LDS_BYTES, stream, a); }
#else
    a.ph_lo = 0; a.ph_hi = NPHASE;
    void* args[] = {&a};
    hipError_t e = hipLaunchCooperativeKernel((const void*)mk_fwd, dim3(grid), dim3(512), args, LDS_BYTES, stream);
    if (e != hipSuccess) fprintf(stderr, "cooperative launch failed: %s (grid %d)\n", hipGetErrorString(e), grid);
#endif
}
```
